# Optimizing an MI355X kernel written in HIP

```python
import math
import jax, jax.numpy as jnp
from jax import lax
import numpy as np

D_MODEL = 1024
BATCH = 32
SEQ = 2048
DEPTH = 1

RWKV_HEAD = 64
RWKV_HEADS = 8
RWKV_DIM = RWKV_HEADS * RWKV_HEAD
W_LORA = 64
A_LORA = 64
G_LORA = 128
DECAY_SCALE = math.exp(-0.5)
LNX_EPS = 64e-5
ATT_HEADS = 8
ATT_KV_HEADS = 2
ATT_HEAD = 64
ATT_DIM = ATT_HEADS * ATT_HEAD
KV_DIM = ATT_KV_HEADS * ATT_HEAD
WINDOW = 128
BLOCK = 128
NEG_INF = -1e30
N_EXPERTS = 16
CAPACITY_FACTOR = 2
EXPERT_FF = 1024
NORM_EPS = 1e-6

RWKV_SPLITS = (RWKV_DIM, 2 * RWKV_DIM, 3 * RWKV_DIM, 3 * RWKV_DIM + G_LORA,
               3 * RWKV_DIM + G_LORA + W_LORA, 3 * RWKV_DIM + G_LORA + 2 * W_LORA,
               3 * RWKV_DIM + G_LORA + 2 * W_LORA + A_LORA)
RWKV_COLS = 3 * RWKV_DIM + G_LORA + 2 * W_LORA + 2 * A_LORA
ATT_SPLITS = (ATT_DIM, ATT_DIM + KV_DIM, ATT_DIM + 2 * KV_DIM, ATT_DIM + 2 * KV_DIM + D_MODEL)
IN_COLS = RWKV_COLS + ATT_DIM + 2 * KV_DIM + 2 * D_MODEL

kernel_name = 'hybrid_rwkv7_swa_ec_moe'


def rms_norm(x, g):
    xf = x.astype(jnp.float32)
    y = xf * lax.rsqrt(jnp.mean(xf * xf, axis=-1, keepdims=True) + NORM_EPS)
    return (y * g.astype(jnp.float32)).astype(x.dtype)


def centred_token_shift(u, mu_prev, mu_next):
    prev = jnp.pad(u, ((0, 0), (1, 0), (0, 0)))[:, :-1]
    nxt = jnp.pad(u, ((0, 0), (0, 1), (0, 0)))[:, 1:]
    return u + mu_prev * (prev - u) + mu_next * (nxt - u)


def wkv7_scan(r, decay, k, v, kk, a, reverse):
    B, T, H, N = r.shape
    xs = tuple(jnp.moveaxis(t.astype(jnp.float32), 1, 0) for t in (r, decay, k, v, kk, a))

    def step(S, inp):
        r_t, w_t, k_t, v_t, kk_t, a_t = inp
        s_kk = jnp.einsum('bhij,bhj->bhi', S, kk_t)
        S = (S * w_t[:, :, None, :]
             - s_kk[..., None] * (a_t * kk_t)[:, :, None, :]
             + v_t[..., None] * k_t[:, :, None, :])
        return S, jnp.einsum('bhij,bhj->bhi', S, r_t)

    S0 = jnp.zeros((B, H, N, N), jnp.float32)
    _, y = lax.scan(step, S0, xs, reverse=reverse)
    return jnp.moveaxis(y, 0, 1)


def rwkv7_bidir(u, w0_f, w_up_f, w0_b, w_up_b, a0_f, a_up_f, a0_b, a_up_b, g_up, k_k, k_a, r_k, ln_w, ln_b):
    f32 = jnp.float32
    B, T, _ = u.shape
    r, k, v, g_lo, wf_lo, wb_lo, af_lo, ab_lo = jnp.split(u, RWKV_SPLITS, axis=-1)

    def heads(t):
        return t.reshape(B, T, RWKV_HEADS, RWKV_HEAD)

    def decay(w0, lo, up):
        return jnp.exp(-DECAY_SCALE * jax.nn.sigmoid((w0 + jnp.tanh(lo) @ up).astype(f32)))

    def icl_rate(a0, lo, up):
        return jax.nn.sigmoid((a0 + lo @ up).astype(f32))

    kf = k.astype(f32)
    kk = heads(kf * k_k.astype(f32))
    kk = kk / jnp.maximum(jnp.sqrt(jnp.sum(kk * kk, axis=-1, keepdims=True)), 1e-12)
    a_f = icl_rate(a0_f, af_lo, a_up_f)
    a_b = icl_rate(a0_b, ab_lo, a_up_b)
    k_f = heads(kf * (1.0 + (a_f - 1.0) * k_a.astype(f32)))
    k_b = heads(kf * (1.0 + (a_b - 1.0) * k_a.astype(f32)))
    r4 = heads(r.astype(f32))
    v4 = heads(v.astype(f32))

    wkv = (wkv7_scan(r4, heads(decay(w0_f, wf_lo, w_up_f)), k_f, v4, kk, heads(a_f), False)
           + wkv7_scan(r4, heads(decay(w0_b, wb_lo, w_up_b)), k_b, v4, kk, heads(a_b), True))

    mean = jnp.mean(wkv, axis=-1, keepdims=True)
    var = jnp.mean(jnp.square(wkv - mean), axis=-1, keepdims=True)
    normed = ((wkv - mean) * lax.rsqrt(var + LNX_EPS)).reshape(B, T, RWKV_DIM)
    normed = normed * ln_w.astype(f32) + ln_b.astype(f32)

    rk = r_k.astype(f32)
    bonus = ((jnp.sum(r4 * k_f * rk, axis=-1, keepdims=True)
              + jnp.sum(r4 * k_b * rk, axis=-1, keepdims=True)) * v4).reshape(B, T, RWKV_DIM)
    g = (jax.nn.sigmoid(g_lo) @ g_up).astype(f32)
    return ((normed + bonus) * g).astype(u.dtype)


def alibi_slopes(n_heads):
    return 2.0 ** (-8.0 * np.arange(1, n_heads + 1) / n_heads)


def banded_gqa_attention(q, k, v, sink):
    f32 = jnp.float32
    B, T, HQ, DH = q.shape
    G = HQ // ATT_KV_HEADS
    nb = T // BLOCK
    span = BLOCK + 2 * WINDOW
    q = q.reshape(B, T, ATT_KV_HEADS, G, DH) * (DH ** -0.5)
    kp = jnp.pad(k, ((0, 0), (WINDOW, WINDOW), (0, 0), (0, 0)))
    vp = jnp.pad(v, ((0, 0), (WINDOW, WINDOW), (0, 0), (0, 0)))
    slopes = jnp.asarray(alibi_slopes(HQ), f32).reshape(ATT_KV_HEADS, G)
    sink_l = sink.astype(f32).reshape(1, ATT_KV_HEADS, G, 1, 1)
    l_idx = jnp.arange(BLOCK)
    j_idx = jnp.arange(span)
    rel = j_idx[None, :] - WINDOW - l_idx[:, None]
    in_window = jnp.abs(rel) <= WINDOW
    alibi = -slopes[:, :, None, None] * jnp.abs(rel).astype(f32)

    def one_block(i):
        start = i * BLOCK
        qb = lax.dynamic_slice_in_dim(q, start, BLOCK, axis=1)
        kb = lax.dynamic_slice_in_dim(kp, start, span, axis=1)
        vb = lax.dynamic_slice_in_dim(vp, start, span, axis=1)
        key_pos = start - WINDOW + j_idx
        valid = in_window & ((key_pos >= 0) & (key_pos < T))[None, :]
        s = jnp.einsum('blkgd,bjkd->bkglj', qb, kb).astype(f32) + alibi
        s = jnp.where(valid, s, NEG_INF)
        m = jnp.maximum(jnp.max(s, axis=-1, keepdims=True), sink_l)
        p = jnp.exp(s - m)
        denom = jnp.sum(p, axis=-1, keepdims=True) + jnp.exp(sink_l - m)
        return jnp.einsum('bkglj,bjkd->blkgd', (p / denom).astype(vb.dtype), vb)

    out = lax.map(one_block, jnp.arange(nb))
    return jnp.moveaxis(out, 0, 1).reshape(B, T, HQ * DH)


def expert_choice_moe(h, w_router, w_gate, w_up, w_down):
    B, T, D = h.shape
    cap = CAPACITY_FACTOR * T // N_EXPERTS
    affinity = jax.nn.softmax((h @ w_router).astype(jnp.float32), axis=-1)
    top_vals, top_idx = lax.top_k(jnp.swapaxes(affinity, 1, 2), cap)
    b_idx = jnp.arange(B)[:, None, None]
    xs = h[b_idx, top_idx]
    hid = jax.nn.silu(jnp.einsum('becd,edf->becf', xs, w_gate)) * jnp.einsum('becd,edf->becf', xs, w_up)
    ys = jnp.einsum('becf,efd->becd', hid, w_down) * top_vals[..., None].astype(h.dtype)
    return jnp.zeros_like(h).at[b_idx, top_idx].add(ys)


def setup_inputs(seed: int = 0) -> dict:
    key = jax.random.key(seed)
    ks = jax.random.split(key, 32)
    L, D, f32 = DEPTH, D_MODEL, jnp.float32
    nrm = lambda k, shape, s: (jax.random.normal(k, shape, f32) * s)
    return {
        'x': nrm(ks[0], (BATCH, SEQ, D), 1.0),
        'norm_mix_g': 1.0 + nrm(ks[1], (L, D), 0.1),
        'w_in': nrm(ks[2], (L, D, IN_COLS), D ** -0.5),
        'mu_prev': jax.random.uniform(ks[3], (L, RWKV_COLS), f32, 0.05, 0.45),
        'mu_next': jax.random.uniform(ks[4], (L, RWKV_COLS), f32, 0.05, 0.45),
        'w0_f': nrm(ks[5], (L, RWKV_DIM), 1.0),
        'w_up_f': nrm(ks[6], (L, W_LORA, RWKV_DIM), 0.5 * W_LORA ** -0.5),
        'w0_b': nrm(ks[7], (L, RWKV_DIM), 1.0),
        'w_up_b': nrm(ks[8], (L, W_LORA, RWKV_DIM), 0.5 * W_LORA ** -0.5),
        'a0_f': nrm(ks[9], (L, RWKV_DIM), 0.5),
        'a_up_f': nrm(ks[10], (L, A_LORA, RWKV_DIM), 0.5 * A_LORA ** -0.5),
        'a0_b': nrm(ks[11], (L, RWKV_DIM), 0.5),
        'a_up_b': nrm(ks[12], (L, A_LORA, RWKV_DIM), 0.5 * A_LORA ** -0.5),
        'g_up': nrm(ks[13], (L, G_LORA, RWKV_DIM), G_LORA ** -0.5),
        'k_k': 0.85 + nrm(ks[14], (L, RWKV_DIM), 0.05),
        'k_a': 1.0 + nrm(ks[15], (L, RWKV_DIM), 0.05),
        'r_k': nrm(ks[16], (L, RWKV_HEADS, RWKV_HEAD), 0.1),
        'ln_x_w': 1.0 + nrm(ks[17], (L, RWKV_DIM), 0.1),
        'ln_x_b': nrm(ks[18], (L, RWKV_DIM), 0.02),
        'attn_sink': nrm(ks[19], (L, ATT_HEADS), 0.5),
        'w_proj_rwkv': nrm(ks[20], (L, RWKV_DIM, D), RWKV_DIM ** -0.5),
        'w_proj_attn': nrm(ks[21], (L, ATT_DIM, D), ATT_DIM ** -0.5),
        'w_out': nrm(ks[22], (L, D, D), D ** -0.5),
        'norm_ffn_g': 1.0 + nrm(ks[23], (L, D), 0.1),
        'w_router': nrm(ks[24], (L, D, N_EXPERTS), D ** -0.5),
        'exp_w_gate': nrm(ks[25], (L, N_EXPERTS, D, EXPERT_FF), D ** -0.5),
        'exp_w_up': nrm(ks[26], (L, N_EXPERTS, D, EXPERT_FF), D ** -0.5),
        'exp_w_down': nrm(ks[27], (L, N_EXPERTS, EXPERT_FF, D), EXPERT_FF ** -0.5),
        'norm_final_g': 1.0 + nrm(ks[28], (D,), 0.1),
    }


def reference(x, norm_mix_g, w_in, mu_prev, mu_next, w0_f, w_up_f, w0_b, w_up_b, a0_f, a_up_f, a0_b, a_up_b,
              g_up, k_k, k_a, r_k, ln_x_w, ln_x_b, attn_sink, w_proj_rwkv, w_proj_attn, w_out, norm_ffn_g,
              w_router, exp_w_gate, exp_w_up, exp_w_down, norm_final_g):
    B, T, _ = x.shape
    for layer in range(DEPTH):
        h = rms_norm(x, norm_mix_g[layer])
        u = h @ w_in[layer]
        u_rwkv = centred_token_shift(u[..., :RWKV_COLS], mu_prev[layer], mu_next[layer])
        q, k_att, v_att, gl_rwkv, gl_attn = jnp.split(u[..., RWKV_COLS:], ATT_SPLITS, axis=-1)
        y_rwkv = rwkv7_bidir(u_rwkv, w0_f[layer], w_up_f[layer], w0_b[layer], w_up_b[layer],
                             a0_f[layer], a_up_f[layer], a0_b[layer], a_up_b[layer], g_up[layer],
                             k_k[layer], k_a[layer], r_k[layer], ln_x_w[layer], ln_x_b[layer])
        y_attn = banded_gqa_attention(q.reshape(B, T, ATT_HEADS, ATT_HEAD),
                                      k_att.reshape(B, T, ATT_KV_HEADS, ATT_HEAD),
                                      v_att.reshape(B, T, ATT_KV_HEADS, ATT_HEAD), attn_sink[layer])
        merged = (jax.nn.sigmoid(gl_rwkv) * (y_rwkv @ w_proj_rwkv[layer])
                  + jax.nn.sigmoid(gl_attn) * (y_attn @ w_proj_attn[layer]))
        x = x + merged @ w_out[layer]
        x = x + expert_choice_moe(rms_norm(x, norm_ffn_g[layer]), w_router[layer],
                                  exp_w_gate[layer], exp_w_up[layer], exp_w_down[layer])
    return rms_norm(x, norm_final_g)
```

```cpp
#include <hip/hip_runtime.h>
#include <hip/hip_cooperative_groups.h>
#include <cstdio>
#include <cstdint>
namespace cg = cooperative_groups;
namespace pg8 {
#define PG8_LAS __attribute__((address_space(3)))
typedef unsigned short bf16_t;
typedef short bf16x8 __attribute__((ext_vector_type(8)));
typedef float f32x4 __attribute__((ext_vector_type(4)));
typedef unsigned u32x4 __attribute__((ext_vector_type(4)));
constexpr int BM = 256, BK = 64, HALF = 128, HTB = HALF * BK * 2  , STAGE_BYTES = 8 * HTB, NXCD = 8, WGM = 8;

__host__ __device__ __forceinline__ int lds_byte(int r, int c) { const int st = (r >> 4) * 2 + (c >> 5), rr = r & 15, cc = c & 31, ob = rr * 64 + cc * 2; return st * 1024 + (ob ^ (((ob >> 9) & 1) << 5)); }
__host__ __device__ __forceinline__ void stage_rc(int b, int& R, int& C) { const int st = b / 1024, sb = b % 1024, swz = sb ^ (((sb >> 9) & 1) << 5); R = (st >> 1) * 16 + swz / 64; C = (st & 1) * 32 + (swz % 64) / 2; }
__host__ __device__ __forceinline__ int perm32(int rho) { const int n = rho >> 4, i = rho & 15; return 8 * (i >> 2) + 4 * n + (i & 3); }

struct Unit { int pm, pn; };
struct Gemm { const bf16_t* A; const bf16_t* Bt; int M, N, K, lda; int grp_tiles; size_t grp_stride; };

struct StaticOrder {
    int nM, nN, nwg, G, c;
    __host__ __device__ void init(int M, int N, int G_, int c_) { nM = M / BM; nN = N / BM; nwg = nM * nN; G = G_; c = c_; }
    __host__ __device__ bool next(int i, Unit& u) const {
        const long L = (long)i * G + c; if (L >= nwg) return false;
        int wgid = (int)L; { const int q = nwg / NXCD, r = nwg % NXCD, xcd = wgid % NXCD, off = wgid / NXCD; wgid = (xcd < r ? xcd * (q + 1) : r * (q + 1) + (xcd - r) * q) + off; }
        const int nig = WGM * nN, gid = wgid / nig, fm = gid * WGM, gsz = (nM - fm) < WGM ? (nM - fm) : WGM;
        u.pm = fm + ((wgid % nig) % gsz); u.pn = (wgid % nig) / gsz; return true;
    }
    __device__ __forceinline__ void a_ready(const Unit&) const {}
    __device__ __forceinline__ void done(const Unit&) const {}
};
template <class Epi, class Sched, bool ALIGN_EPI = false, bool SP2 = false>
__device__ __forceinline__ void gemm_phase(PG8_LAS unsigned char* lds, const Gemm g, const Sched& S, const Epi& E) {
    const int tid = threadIdx.x, wid = __builtin_amdgcn_readfirstlane(tid >> 6), lane = tid & 63, wr = wid >> 2, wc = wid & 3, fr = lane & 15, fq = lane >> 4;
    const int K = g.K, nt = K / BK;
    unsigned voffA[2], voffB[2];
#pragma unroll
    for (int i = 0; i < 2; ++i) { int R, C; stage_rc(tid * 16 + i * 8192, R, C); const int Rb = Epi::PERM ? ((R & ~31) + perm32(R & 31)) : R;
        voffA[i] = (unsigned)(R * g.lda + C) * 2u; voffB[i] = (unsigned)(Rb * K + C) * 2u; }
    const size_t kstep = (size_t)(BK * 2);
    const size_t hstepA = (size_t)HALF * g.lda * 2, hstepB = (size_t)HALF * K * 2;
    const size_t tstepA = 2 * hstepA, tstepB = 2 * hstepB;
    const unsigned ldsw = (unsigned)wid * 1024u;
    const int aoff = lds_byte(wr * 64 + fr, fq * 8), boff = lds_byte(wc * 32 + fr, fq * 8);
#define PG8_SA(b, h) (((b) * 2 + (h)) * HTB)
#define PG8_SB(b, h) ((4 + (b) * 2 + (h)) * HTB)
#define PG8_STAGE(bufoff, gbase, voff) do { _Pragma("unroll") for (int _i = 0; _i < 2; ++_i) \
        __builtin_amdgcn_global_load_lds((const unsigned*)((const char*)(gbase) + (voff)[_i]), (PG8_LAS unsigned*)(lds + (bufoff) + ldsw + _i * 8192), 16, 0, 0); } while (0)
#define PG8_LDA(dst, b, h) do { _Pragma("unroll") for (int m = 0; m < 4; ++m) _Pragma("unroll") for (int k = 0; k < 2; ++k) dst[m][k] = *(const PG8_LAS bf16x8*)(lds + PG8_SA(b, h) + aoff + m * 2048 + k * 1024); } while (0)
#define PG8_LDB(dst, b, h) do { _Pragma("unroll") for (int n = 0; n < 2; ++n) _Pragma("unroll") for (int k = 0; k < 2; ++k) dst[n][k] = *(const PG8_LAS bf16x8*)(lds + PG8_SB(b, h) + boff + n * 2048 + k * 1024); } while (0)
#define PG8_MMA(ai, bj, At, Bt) do { __builtin_amdgcn_s_setprio(1); _Pragma("unroll") for (int m = 0; m < 4; ++m) _Pragma("unroll") for (int n = 0; n < 2; ++n) _Pragma("unroll") for (int k = 0; k < 2; ++k) \
        acc[ai][bj][m][n] = __builtin_amdgcn_mfma_f32_16x16x32_bf16(Bt[n][k], At[m][k], acc[ai][bj][m][n], 0, 0, 0); __builtin_amdgcn_s_setprio(0); } while (0)
#define PG8_WAIT_V(n) asm volatile("s_waitcnt vmcnt(" #n ")" ::: "memory")
#define PG8_WAIT_L(n) asm volatile("s_waitcnt lgkmcnt(" #n ")" ::: "memory")
#define PG8_BAR __builtin_amdgcn_s_barrier()
#define PG8_SCHED __builtin_amdgcn_sched_barrier(0)
    Unit cur, nxt; int ui = 0;
    if (!S.next(0, cur)) return;
    f32x4 acc[2][2][4][2];
#pragma unroll
    for (int a = 0; a < 2; ++a)
#pragma unroll
        for (int b = 0; b < 2; ++b)
#pragma unroll
            for (int m = 0; m < 4; ++m)
#pragma unroll
                for (int n = 0; n < 2; ++n) acc[a][b][m][n] = (f32x4){0.f, 0.f, 0.f, 0.f};
    bf16x8 At[4][2], B0[2][2], B1[2][2];
    const char* cA = (const char*)g.A + (size_t)cur.pm * tstepA; const char* cB = (const char*)g.Bt + (size_t)(cur.pm / g.grp_tiles) * g.grp_stride + (size_t)cur.pn * tstepB;
    S.a_ready(cur);
    if constexpr (SP2) {
        PG8_STAGE(PG8_SB(0, 0), cB, voffB); PG8_STAGE(PG8_SB(0, 1), cB + hstepB, voffB); PG8_STAGE(PG8_SA(0, 0), cA, voffA); PG8_STAGE(PG8_SA(0, 1), cA + hstepA, voffA);
        if (wr == 1) PG8_BAR;
        PG8_WAIT_V(2); PG8_BAR;
        PG8_STAGE(PG8_SB(1, 0), cB + kstep, voffB); PG8_STAGE(PG8_SA(1, 0), cA + kstep, voffA); PG8_STAGE(PG8_SB(1, 1), cB + hstepB + kstep, voffB);
        PG8_WAIT_V(6); PG8_BAR;
    } else {
        PG8_STAGE(PG8_SB(0, 0), cB, voffB); PG8_STAGE(PG8_SA(0, 0), cA, voffA); PG8_STAGE(PG8_SB(0, 1), cB + hstepB, voffB); PG8_STAGE(PG8_SA(0, 1), cA + hstepA, voffA);
        if (wr == 1) PG8_BAR;
        PG8_WAIT_V(4); PG8_BAR;
        PG8_STAGE(PG8_SB(1, 0), cB + kstep, voffB); PG8_STAGE(PG8_SA(1, 0), cA + kstep, voffA); PG8_STAGE(PG8_SB(1, 1), cB + hstepB + kstep, voffB);
        PG8_WAIT_V(6); PG8_BAR;
    }
    for (;;) {
        const bool has_next = S.next(ui + 1, nxt);
        const char* nA = has_next ? (const char*)g.A + (size_t)nxt.pm * tstepA : cA; const char* nB = has_next ? (const char*)g.Bt + (size_t)(nxt.pm / g.grp_tiles) * g.grp_stride + (size_t)nxt.pn * tstepB : cB;
        for (int t = 0; t < nt; t += 2) {
            const bool last = (t == nt - 2);
            const char* a1 = cA + (size_t)(t + 1) * kstep;
            const char* a2 = last ? nA : cA + (size_t)(t + 2) * kstep; const char* b2 = last ? nB : cB + (size_t)(t + 2) * kstep;
            const char* a3 = a2 + kstep; const char* b3 = b2 + kstep;
            if (last && has_next) S.a_ready(nxt);
            if constexpr (SP2) {
            PG8_LDB(B0, 0, 0); PG8_LDB(B1, 0, 1); PG8_SCHED; PG8_LDA(At, 0, 0); PG8_STAGE(PG8_SA(1, 1), a1 + hstepA, voffA);
            PG8_WAIT_V(8); PG8_WAIT_L(0); PG8_BAR; PG8_MMA(0, 0, At, B0); PG8_MMA(0, 1, At, B1); PG8_BAR; PG8_SCHED;
            PG8_LDA(At, 0, 1); PG8_STAGE(PG8_SB(0, 0), b2, voffB); PG8_STAGE(PG8_SB(0, 1), b2 + hstepB, voffB); PG8_STAGE(PG8_SA(0, 0), a2, voffA);
            PG8_WAIT_V(8); PG8_WAIT_L(0); PG8_BAR; PG8_MMA(1, 0, At, B0); PG8_MMA(1, 1, At, B1); PG8_BAR; PG8_SCHED;
            PG8_LDB(B0, 1, 0); PG8_LDB(B1, 1, 1); PG8_SCHED; PG8_LDA(At, 1, 0); PG8_STAGE(PG8_SA(0, 1), a2 + hstepA, voffA);
            PG8_WAIT_V(8); PG8_WAIT_L(0); PG8_BAR; PG8_MMA(0, 0, At, B0); PG8_MMA(0, 1, At, B1); PG8_BAR; PG8_SCHED;
            PG8_LDA(At, 1, 1); PG8_STAGE(PG8_SB(1, 0), b3, voffB); PG8_STAGE(PG8_SB(1, 1), b3 + hstepB, voffB); PG8_STAGE(PG8_SA(1, 0), a3, voffA);
            PG8_WAIT_V(8); PG8_WAIT_L(0); PG8_BAR; PG8_MMA(1, 0, At, B0); PG8_MMA(1, 1, At, B1); PG8_BAR; PG8_SCHED;
            } else {
            PG8_LDB(B0, 0, 0); PG8_SCHED; PG8_LDA(At, 0, 0); PG8_STAGE(PG8_SA(1, 1), a1 + hstepA, voffA);
            PG8_WAIT_L(8); PG8_BAR; PG8_WAIT_L(0); PG8_MMA(0, 0, At, B0); PG8_BAR; PG8_SCHED;
            PG8_LDB(B1, 0, 1); PG8_STAGE(PG8_SB(0, 0), b2, voffB);
            PG8_BAR; PG8_WAIT_L(0); PG8_MMA(0, 1, At, B1); PG8_BAR;
            PG8_LDA(At, 0, 1); PG8_STAGE(PG8_SA(0, 0), a2, voffA);
            PG8_BAR; PG8_WAIT_L(0); PG8_MMA(1, 0, At, B0); PG8_BAR; PG8_SCHED;
            PG8_STAGE(PG8_SB(0, 1), b2 + hstepB, voffB);
            PG8_WAIT_V(6); PG8_BAR; PG8_MMA(1, 1, At, B1); PG8_BAR;
            PG8_LDB(B0, 1, 0); PG8_SCHED; PG8_LDA(At, 1, 0); PG8_STAGE(PG8_SA(0, 1), a2 + hstepA, voffA);
            PG8_WAIT_L(8); PG8_BAR; PG8_WAIT_L(0); PG8_MMA(0, 0, At, B0); PG8_BAR; PG8_SCHED;
            PG8_LDB(B1, 1, 1); PG8_STAGE(PG8_SB(1, 0), b3, voffB);
            PG8_BAR; PG8_WAIT_L(0); PG8_MMA(0, 1, At, B1); PG8_BAR;
            PG8_LDA(At, 1, 1); PG8_STAGE(PG8_SA(1, 0), a3, voffA);
            PG8_BAR; PG8_WAIT_L(0); PG8_MMA(1, 0, At, B0); PG8_BAR; PG8_SCHED;
            PG8_STAGE(PG8_SB(1, 1), b3 + hstepB, voffB);
            PG8_WAIT_V(6); PG8_BAR; PG8_MMA(1, 1, At, B1); PG8_BAR;
            }
        }
        if constexpr (ALIGN_EPI) { if (wr == 0) PG8_BAR; }
        if constexpr (!Epi::AFTER_DRAIN) { E(acc, cur, wr, wc, fr, fq); S.done(cur); }
        if (!has_next) break;
#pragma unroll
        for (int a = 0; a < 2; ++a)
#pragma unroll
            for (int b = 0; b < 2; ++b)
#pragma unroll
                for (int m = 0; m < 4; ++m)
#pragma unroll
                    for (int n = 0; n < 2; ++n) acc[a][b][m][n] = (f32x4){0.f, 0.f, 0.f, 0.f};
        cur = nxt; cA = nA; cB = nB; ++ui;
        if constexpr (ALIGN_EPI) { if (wr == 1) PG8_BAR; }
    }
    PG8_WAIT_V(0);
    if constexpr (!ALIGN_EPI) { if (wr == 0) PG8_BAR; }
    PG8_BAR;
    if constexpr (Epi::AFTER_DRAIN) { E.fused(acc, cur, wr, wc, fr, fq, lds, wid, lane); S.done(cur); }
#undef PG8_SA
#undef PG8_SB
#undef PG8_STAGE
#undef PG8_LDA
#undef PG8_LDB
#undef PG8_MMA
#undef PG8_WAIT_V
#undef PG8_WAIT_L
#undef PG8_BAR
#undef PG8_SCHED
}
}

#ifndef PG8_SP2
#define PG8_SP2 true
#endif
#ifndef PG8_ALIGN
#define PG8_ALIGN true
#endif

#define DI __device__ __forceinline__
#define LAS __attribute__((address_space(3)))
typedef unsigned short bf16;
typedef _Float16 f16;
typedef unsigned v4u __attribute__((ext_vector_type(4)));
typedef unsigned v2u __attribute__((ext_vector_type(2)));
typedef float f32x4 __attribute__((ext_vector_type(4)));
typedef float f32x2 __attribute__((ext_vector_type(2)));
typedef float f32x16 __attribute__((ext_vector_type(16)));
typedef short bf16x8 __attribute__((ext_vector_type(8)));
typedef _Float16 f16x8 __attribute__((ext_vector_type(8)));
typedef __bf16 bf16x2_t __attribute__((ext_vector_type(2)));

constexpr int NB = 32, T = 2048, D = 1024, M = NB * T;
constexpr int RC = 1920, NQKV = 768, NGATE = 2048, NIN = 4736, NINP = 4864;
constexpr int RD = 512, NH = 8, HS = 64;
constexpr int NLK = 384, NLN = 2560;
constexpr int NE = 16, CAP = 256, FF = 1024, MS = NB * NE * CAP;
constexpr float DECAY_SCALE = 0.60653065971263342f;
constexpr float LNX_EPS = 64e-5f, NORM_EPS = 1e-6f;
constexpr int NWAVES = 8, NTHREADS = 512;

constexpr size_t MiB = 1u << 20;
constexpr size_t WS_CTL = 0;
constexpr size_t WS_BON = 1 * MiB;
constexpr size_t WS_AFFT = 5 * MiB;
constexpr size_t WS_SEL = 9 * MiB;
constexpr size_t WS_VAL = 13 * MiB;
constexpr size_t WS_LBIAS = 13 * MiB + 512 * 1024;
constexpr size_t WS_VT = 14 * MiB;
constexpr size_t WS_WIN = 30 * MiB;
constexpr size_t WS_WPR = 40 * MiB;
constexpr size_t WS_WPA = 41 * MiB;
constexpr size_t WS_WOUT = 42 * MiB;
constexpr size_t WS_WLORA = 44 * MiB;
constexpr size_t WS_WGU = 46 * MiB;
constexpr size_t WS_WD = 110 * MiB;
constexpr size_t WS_UR = 142 * MiB;
constexpr size_t WS_G = 142 * MiB;
constexpr size_t WS_YF = 206 * MiB;
constexpr size_t WS_YB = 270 * MiB;
constexpr size_t WS_HID = 142 * MiB;
constexpr size_t WS_QKV = 382 * MiB;
constexpr size_t WS_GATES = 478 * MiB;
constexpr size_t WS_XG = 478 * MiB;
constexpr size_t WS_YS = 478 * MiB;
constexpr size_t WS_RKV = 734 * MiB;
constexpr size_t WS_AP = 926 * MiB;
constexpr size_t WS_MERGED = 734 * MiB;
constexpr size_t WS_H2 = 862 * MiB;
constexpr size_t WS_END = 1024 * MiB;
constexpr size_t OUT_AW = 64 * MiB;

constexpr int LDS_BYTES = 147456;

#define LDS_WAIT() asm volatile("s_waitcnt lgkmcnt(0)" ::: "memory")
DI unsigned f2bf(float f) { unsigned u = __builtin_bit_cast(unsigned, f); return (u + 0x7fffu + ((u >> 16) & 1u)) >> 16; }
DI unsigned pk2(float lo, float hi) { f32x2 v = {lo, hi}; bf16x2_t b = __builtin_convertvector(v, bf16x2_t); return __builtin_bit_cast(unsigned, b); }
DI float bflo(unsigned w) { return __builtin_bit_cast(float, w << 16); }
DI float bfhi(unsigned w) { return __builtin_bit_cast(float, w & 0xffff0000u); }
DI float bf2f(bf16 b) { return __builtin_bit_cast(float, (unsigned)b << 16); }
DI float sigmoidf_(float x) { return __builtin_amdgcn_rcpf(1.0f + __expf(-x)); }
DI float wave_sum(float v) {
#pragma unroll
    for (int o = 1; o < 64; o <<= 1) v += __shfl_xor(v, o);
    return v;
}
DI float wave_max(float v) {
#pragma unroll
    for (int o = 1; o < 64; o <<= 1) v = fmaxf(v, __shfl_xor(v, o));
    return v;
}

struct Args { const float* in[29]; float* out; unsigned char* ws; int ph_lo, ph_hi; };

enum { I_X = 0, I_NMG, I_WIN, I_MUP, I_MUN, I_W0F, I_WUPF, I_W0B, I_WUPB, I_A0F, I_AUPF, I_A0B, I_AUPB, I_GUP, I_KK, I_KA, I_RK, I_LNW, I_LNB, I_SINK,
       I_WPR, I_WPA, I_WOUT, I_NFG, I_WR, I_EG, I_EU, I_ED, I_NFINAL };

DI void transpose_item(const float* __restrict__ W, int ldw, int k0, int n0, bf16* WT, size_t drow0, int ldt, int dk0, LAS float* scr, int lane) {
#pragma unroll 8
    for (int i = 0; i < 32; ++i) { const int kk = 2 * i + (lane >> 5); scr[kk * 33 + (lane & 31)] = W[(size_t)(k0 + kk) * ldw + n0 + (lane & 31)]; }
    LDS_WAIT(); asm volatile("" ::: "memory");
    const int c = lane & 7;
#pragma unroll
    for (int j = 0; j < 4; ++j) { const int n = (lane >> 3) + 8 * j; const LAS float* s = scr + (8 * c) * 33 + n;
        v4u o; o.x = pk2(s[0 * 33], s[1 * 33]); o.y = pk2(s[2 * 33], s[3 * 33]); o.z = pk2(s[4 * 33], s[5 * 33]); o.w = pk2(s[6 * 33], s[7 * 33]);
        *(v4u*)(WT + (drow0 + n) * (size_t)ldt + dk0 + 8 * c) = o; }
    LDS_WAIT(); asm volatile("" ::: "memory");
}

DI void phase0(const Args& a, LAS unsigned char* lds, int G, int vcu) {
    const int tid = threadIdx.x, lane = tid & 63, wave = __builtin_amdgcn_readfirstlane(tid >> 6);
    LAS float* scr = (LAS float*)(lds + wave * 16384);
    const int gw = vcu * NWAVES + wave, NGW = G * NWAVES;
    unsigned char* ws = a.ws;
    constexpr int J1 = 16 * 148, J2 = 8 * 32, J3 = J2, J4 = 16 * 32, JE = 16 * 32, J5 = NE * JE;
    constexpr int NITEMS = J1 + J2 + J3 + J4 + 3 * J5;
    for (int it = gw; it < NITEMS; it += NGW) {
        int r = it;
        if (r < J1) { const int kb = r / 148, nb = r % 148; transpose_item(a.in[I_WIN], NIN, 64 * kb, 32 * nb, (bf16*)(ws + WS_WIN), 32 * nb, D, 64 * kb, scr, lane); continue; } r -= J1;
        if (r < J2) { const int kb = r / 32, nb = r % 32; transpose_item(a.in[I_WPR], D, 64 * kb, 32 * nb, (bf16*)(ws + WS_WPR), 32 * nb, 512, 64 * kb, scr, lane); continue; } r -= J2;
        if (r < J3) { const int kb = r / 32, nb = r % 32; transpose_item(a.in[I_WPA], D, 64 * kb, 32 * nb, (bf16*)(ws + WS_WPA), 32 * nb, 512, 64 * kb, scr, lane); continue; } r -= J3;
        if (r < J4) { const int kb = r / 32, nb = r % 32; transpose_item(a.in[I_WOUT], D, 64 * kb, 32 * nb, (bf16*)(ws + WS_WOUT), 32 * nb, D, 64 * kb, scr, lane); continue; } r -= J4;
        if (r < J5) { const int e = r / JE, q = r % JE, kb = q / 32, nb = q % 32, n0 = 32 * nb;
            transpose_item(a.in[I_EG] + (size_t)e * D * FF, FF, 64 * kb, n0, (bf16*)(ws + WS_WGU) + (size_t)e * 2048 * D, (n0 / 128) * 256 + (n0 % 128), D, 64 * kb, scr, lane); continue; } r -= J5;
        if (r < J5) { const int e = r / JE, q = r % JE, kb = q / 32, nb = q % 32, n0 = 32 * nb;
            transpose_item(a.in[I_EU] + (size_t)e * D * FF, FF, 64 * kb, n0, (bf16*)(ws + WS_WGU) + (size_t)e * 2048 * D, (n0 / 128) * 256 + 128 + (n0 % 128), D, 64 * kb, scr, lane); continue; } r -= J5;
        { const int e = r / JE, q = r % JE, kb = q / 32, nb = q % 32;
            transpose_item(a.in[I_ED] + (size_t)e * FF * D, D, 64 * kb, 32 * nb, (bf16*)(ws + WS_WD) + (size_t)e * D * FF, 32 * nb, FF, 64 * kb, scr, lane); }
    }
    {
        bf16* WL = (bf16*)(ws + WS_WLORA);
        const int gt = vcu * NTHREADS + tid, NGT = G * NTHREADS;
        for (int idx = gt; idx < NLN * (NLK / 8); idx += NGT) {
            const int n = idx / (NLK / 8), kc = idx % (NLK / 8), k = kc * 8, gi = n >> 9, nn = n & 511;
            const float* src = nullptr; int koff = 0, klen = 0;
            if (gi == 0) { src = a.in[I_GUP]; koff = 0; klen = 128; }
            else if (gi == 1) { src = a.in[I_WUPF]; koff = 128; klen = 64; }
            else if (gi == 2) { src = a.in[I_WUPB]; koff = 192; klen = 64; }
            else if (gi == 3) { src = a.in[I_AUPF]; koff = 256; klen = 64; }
            else { src = a.in[I_AUPB]; koff = 320; klen = 64; }
            float v[8];
#pragma unroll
            for (int j = 0; j < 8; ++j) { const int kk = k + j - koff; v[j] = (kk >= 0 && kk < klen) ? src[(size_t)kk * 512 + nn] : 0.f; }
            v4u o; o.x = pk2(v[0], v[1]); o.y = pk2(v[2], v[3]); o.z = pk2(v[4], v[5]); o.w = pk2(v[6], v[7]);
            *(v4u*)(WL + (size_t)n * NLK + k) = o;
        }
    }
    if (vcu == 0) {
        float* LB = (float*)(ws + WS_LBIAS);
        LB[tid] = a.in[I_W0F][tid]; LB[512 + tid] = a.in[I_W0B][tid]; LB[1024 + tid] = a.in[I_A0F][tid]; LB[1536 + tid] = a.in[I_A0B][tid];
    }
    {
        bf16* H = (bf16*)a.out; const float* x = a.in[I_X]; const float* g = a.in[I_NMG];
        f32x4 gv[4];
#pragma unroll
        for (int j = 0; j < 4; ++j) gv[j] = *(const f32x4*)(g + 4 * lane + 256 * j);
        for (int m = gw; m < M; m += NGW) {
            const f32x4* xr = (const f32x4*)(x + (size_t)m * D) + lane;
            f32x4 v[4]; float s = 0.f;
#pragma unroll
            for (int j = 0; j < 4; ++j) { v[j] = xr[64 * j]; s += (v[j].x * v[j].x + v[j].y * v[j].y) + (v[j].z * v[j].z + v[j].w * v[j].w); }
            const float rstd = rsqrtf(wave_sum(s) * (1.f / D) + NORM_EPS);
            v2u* o = (v2u*)(H + (size_t)m * D) + lane;
#pragma unroll
            for (int j = 0; j < 4; ++j) { v2u w; w.x = pk2(v[j].x * rstd * gv[j].x, v[j].y * rstd * gv[j].y); w.y = pk2(v[j].z * rstd * gv[j].z, v[j].w * rstd * gv[j].w); o[64 * j] = w; }
        }
    }
}

using pg8::Unit;
struct EpiA {
    static constexpr bool PERM = true, AFTER_DRAIN = false;
    bf16* UR; bf16* QKV; bf16* GATES;
    DI void operator()(const f32x4 (&acc)[2][2][4][2], const Unit& u, int wr, int wc, int fr, int fq) const {
        const int row0 = u.pm * 256 + wr * 64 + fr;
#pragma unroll
        for (int bj = 0; bj < 2; ++bj) {
            const int cb = u.pn * 2 + bj;
            if (cb >= 37) continue;
            bf16* base; int ld, colb, mode;
            if (cb < 15) { base = UR; ld = RC; colb = cb * 128; mode = 0; }
            else if (cb < 21) { base = QKV; ld = NQKV; colb = (cb - 15) * 128; mode = (cb < 19) ? 1 : 0; }
            else { base = GATES; ld = NGATE; colb = (cb - 21) * 128; mode = 2; }
            const int col = colb + wc * 32 + 8 * fq;
#pragma unroll
            for (int ai = 0; ai < 2; ++ai)
#pragma unroll
                for (int m = 0; m < 4; ++m) {
                    f32x4 v0 = acc[ai][bj][m][0], v1 = acc[ai][bj][m][1];
                    if (mode == 1) { v0 = v0 * 0.125f; v1 = v1 * 0.125f; }
                    else if (mode == 2) {
#pragma unroll
                        for (int i = 0; i < 4; ++i) { v0[i] = sigmoidf_(v0[i]); v1[i] = sigmoidf_(v1[i]); }
                    }
                    v4u w; w.x = pk2(v0[0], v0[1]); w.y = pk2(v0[2], v0[3]); w.z = pk2(v1[0], v1[1]); w.w = pk2(v1[2], v1[3]);
                    *(v4u*)(base + (size_t)(row0 + ai * 128 + m * 16) * ld + col) = w;
                }
        }
    }
};
struct EpiLora {
    static constexpr bool PERM = true, AFTER_DRAIN = false;
    bf16* Gout; f16* AW; const float* lbias;
    DI void operator()(const f32x4 (&acc)[2][2][4][2], const Unit& u, int wr, int wc, int fr, int fq) const {
        asm volatile("" : "+v"(fr), "+v"(fq));
        const int row0 = u.pm * 256 + wr * 64 + fr;
        const int gi = u.pn >> 1;
        const int ccb = (u.pn & 1) * 256 + wc * 32 + 8 * fq;
        if (gi == 0) {
#pragma unroll
            for (int bj = 0; bj < 2; ++bj)
#pragma unroll
                for (int ai = 0; ai < 2; ++ai)
#pragma unroll
                    for (int m = 0; m < 4; ++m) {
                        const f32x4 v0 = acc[ai][bj][m][0], v1 = acc[ai][bj][m][1];
                        v4u w; w.x = pk2(v0[0], v0[1]); w.y = pk2(v0[2], v0[3]); w.z = pk2(v1[0], v1[1]); w.w = pk2(v1[2], v1[3]);
                        *(v4u*)(Gout + (size_t)(row0 + ai * 128 + m * 16) * 512 + ccb + bj * 128) = w;
                    }
        } else {
            const int arr = (gi + 1) & 3;
            const float dsc = (gi <= 2) ? -DECAY_SCALE * 1.4426950408889634f : 0.f;
            f16* dst = (f16*)((unsigned char*)AW + (size_t)arr * OUT_AW);
            const float* bias = lbias + (gi - 1) * 512 + ccb;
#pragma unroll
            for (int bj = 0; bj < 2; ++bj) {
                const f32x4 b0 = *(const f32x4*)(bias + bj * 128), b1 = *(const f32x4*)(bias + bj * 128 + 4);
#pragma unroll
                for (int ai = 0; ai < 2; ++ai)
#pragma unroll
                    for (int m = 0; m < 4; ++m) {
                        const f32x4 v0 = acc[ai][bj][m][0] + b0, v1 = acc[ai][bj][m][1] + b1;
                        f16x8 h;
#pragma unroll
                        for (int i = 0; i < 4; ++i) {
                            float s0 = sigmoidf_(v0[i]), s1 = sigmoidf_(v1[i]);
                            if (gi <= 2) { s0 = __builtin_amdgcn_exp2f(dsc * s0); s1 = __builtin_amdgcn_exp2f(dsc * s1); }
                            h[i] = (f16)s0; h[4 + i] = (f16)s1;
                        }
                        *(f16x8*)(dst + (size_t)(row0 + ai * 128 + m * 16) * 512 + ccb + bj * 128) = h;
                    }
            }
        }
    }
};
template <int PASS> struct EpiMerge {
    static constexpr bool PERM = true, AFTER_DRAIN = false;
    bf16* MG; const bf16* GATES;
    DI void operator()(const f32x4 (&acc)[2][2][4][2], const Unit& u, int wr, int wc, int fr, int fq) const {
        const int row0 = u.pm * 256 + wr * 64 + fr;
#pragma unroll
        for (int bj = 0; bj < 2; ++bj) {
            const int col = u.pn * 256 + bj * 128 + wc * 32 + 8 * fq;
#pragma unroll
            for (int ai = 0; ai < 2; ++ai)
#pragma unroll
                for (int m = 0; m < 4; ++m) {
                    const size_t row = (size_t)(row0 + ai * 128 + m * 16);
                    const v4u gw = *(const v4u*)(GATES + row * NGATE + PASS * 1024 + col);
                    f32x4 v0 = acc[ai][bj][m][0], v1 = acc[ai][bj][m][1];
                    float o[8];
                    o[0] = v0[0] * bflo(gw.x); o[1] = v0[1] * bfhi(gw.x); o[2] = v0[2] * bflo(gw.y); o[3] = v0[3] * bfhi(gw.y);
                    o[4] = v1[0] * bflo(gw.z); o[5] = v1[1] * bfhi(gw.z); o[6] = v1[2] * bflo(gw.w); o[7] = v1[3] * bfhi(gw.w);
                    if (PASS == 1) {
                        const v4u pw = *(const v4u*)(MG + row * D + col);
                        o[0] += bflo(pw.x); o[1] += bfhi(pw.x); o[2] += bflo(pw.y); o[3] += bfhi(pw.y);
                        o[4] += bflo(pw.z); o[5] += bfhi(pw.z); o[6] += bflo(pw.w); o[7] += bfhi(pw.w);
                    }
                    v4u w; w.x = pk2(o[0], o[1]); w.y = pk2(o[2], o[3]); w.z = pk2(o[4], o[5]); w.w = pk2(o[6], o[7]);
                    *(v4u*)(MG + row * D + col) = w;
                }
        }
    }
};
struct EpiResid {
    static constexpr bool PERM = false, AFTER_DRAIN = false;
    const float* X; float* O;
    DI void operator()(const f32x4 (&acc)[2][2][4][2], const Unit& u, int wr, int wc, int fr, int fq) const {
        const int row0 = u.pm * 256 + wr * 64 + fr, col0 = u.pn * 256 + wc * 32 + 4 * fq;
#pragma unroll
        for (int ai = 0; ai < 2; ++ai)
#pragma unroll
            for (int m = 0; m < 4; ++m) { const size_t off = (size_t)(row0 + ai * 128 + m * 16) * D + col0;
#pragma unroll
                for (int bj = 0; bj < 2; ++bj)
#pragma unroll
                    for (int n = 0; n < 2; ++n) *(f32x4*)(O + off + bj * 128 + n * 16) = *(const f32x4*)(X + off + bj * 128 + n * 16) + acc[ai][bj][m][n]; }
    }
};
struct EpiSwiglu {
    static constexpr bool PERM = true, AFTER_DRAIN = false;
    bf16* HID;
    DI void operator()(const f32x4 (&acc)[2][2][4][2], const Unit& u, int wr, int wc, int fr, int fq) const {
        const int row0 = u.pm * 256 + wr * 64 + fr, col = u.pn * 128 + wc * 32 + 8 * fq;
#pragma unroll
        for (int ai = 0; ai < 2; ++ai)
#pragma unroll
            for (int m = 0; m < 4; ++m) {
                float o[8];
#pragma unroll
                for (int n = 0; n < 2; ++n)
#pragma unroll
                    for (int i = 0; i < 4; ++i) { const float gt = acc[ai][0][m][n][i], up = acc[ai][1][m][n][i]; o[4 * n + i] = gt * sigmoidf_(gt) * up; }
                v4u w; w.x = pk2(o[0], o[1]); w.y = pk2(o[2], o[3]); w.z = pk2(o[4], o[5]); w.w = pk2(o[6], o[7]);
                *(v4u*)(HID + (size_t)(row0 + ai * 128 + m * 16) * FF + col) = w;
            }
    }
};
struct EpiYs {
    static constexpr bool PERM = true, AFTER_DRAIN = false;
    bf16* YS; const float* VAL;
    DI void operator()(const f32x4 (&acc)[2][2][4][2], const Unit& u, int wr, int wc, int fr, int fq) const {
        const int row0 = u.pm * 256 + wr * 64 + fr;
#pragma unroll
        for (int ai = 0; ai < 2; ++ai)
#pragma unroll
            for (int m = 0; m < 4; ++m) {
                const size_t row = (size_t)(row0 + ai * 128 + m * 16);
                const float sv = VAL[row];
#pragma unroll
                for (int bj = 0; bj < 2; ++bj) {
                    const int col = u.pn * 256 + bj * 128 + wc * 32 + 8 * fq;
                    const f32x4 v0 = acc[ai][bj][m][0] * sv, v1 = acc[ai][bj][m][1] * sv;
                    v4u w; w.x = pk2(v0[0], v0[1]); w.y = pk2(v0[2], v0[3]); w.z = pk2(v1[0], v1[1]); w.w = pk2(v1[2], v1[3]);
                    *(v4u*)(YS + row * D + col) = w;
                }
            }
    }
};

DI void phaseP1(const Args& a, LAS unsigned char* lds, int G, int vcu) {
    const int tid = threadIdx.x, lane = tid & 63, wave = __builtin_amdgcn_readfirstlane(tid >> 6);
    const int gw = vcu * NWAVES + wave, NGW = G * NWAVES;
    unsigned char* ws = a.ws;
    const bf16* UR = (const bf16*)(ws + WS_UR);
    f16* RKV = (f16*)(ws + WS_RKV); bf16* AP = (bf16*)(ws + WS_AP);
    const float* mup = a.in[I_MUP]; const float* mun = a.in[I_MUN];
    for (int m = gw; m < M; m += NGW) {
        const int t = m & (T - 1);
        const bf16* cur = UR + (size_t)m * RC;
#pragma unroll
        for (int i = 0; i < 4; ++i) {
            const int c = lane + 64 * i;
            if (c < RC / 8) {
                const int col = c * 8;
                const v4u uc = *(const v4u*)(cur + col);
                v4u up = {0u, 0u, 0u, 0u}, un = {0u, 0u, 0u, 0u};
                if (t > 0) up = *(const v4u*)(cur - RC + col);
                if (t < T - 1) un = *(const v4u*)(cur + RC + col);
                const f32x4 mp0 = *(const f32x4*)(mup + col), mp1 = *(const f32x4*)(mup + col + 4), mn0 = *(const f32x4*)(mun + col), mn1 = *(const f32x4*)(mun + col + 4);
                float o[8];
                const unsigned ucw[4] = {uc.x, uc.y, uc.z, uc.w}, upw[4] = {up.x, up.y, up.z, up.w}, unw[4] = {un.x, un.y, un.z, un.w};
#pragma unroll
                for (int j = 0; j < 4; ++j) {
                    const float c0 = bflo(ucw[j]), c1 = bfhi(ucw[j]), p0 = bflo(upw[j]), p1 = bfhi(upw[j]), n0 = bflo(unw[j]), n1 = bfhi(unw[j]);
                    const float mpa = j < 2 ? mp0[2 * j] : mp1[2 * j - 4], mpb = j < 2 ? mp0[2 * j + 1] : mp1[2 * j - 3];
                    const float mna = j < 2 ? mn0[2 * j] : mn1[2 * j - 4], mnb = j < 2 ? mn0[2 * j + 1] : mn1[2 * j - 3];
                    o[2 * j] = c0 + mpa * (p0 - c0) + mna * (n0 - c0);
                    o[2 * j + 1] = c1 + mpb * (p1 - c1) + mnb * (n1 - c1);
                }
                if (col < 1536) {
                    f16x8 h;
#pragma unroll
                    for (int j = 0; j < 8; ++j) h[j] = (f16)o[j];
                    *(f16x8*)(RKV + (size_t)(col >> 9) * ((size_t)M * 512) + (size_t)m * 512 + (col & 511)) = h;
                } else {
                    const int ac = col - 1536;
                    if (ac < 128) {
#pragma unroll
                        for (int j = 0; j < 8; ++j) o[j] = sigmoidf_(o[j]);
                    } else if (ac < 256) {
#pragma unroll
                        for (int j = 0; j < 8; ++j) o[j] = tanhf(o[j]);
                    }
                    v4u w; w.x = pk2(o[0], o[1]); w.y = pk2(o[2], o[3]); w.z = pk2(o[4], o[5]); w.w = pk2(o[6], o[7]);
                    *(v4u*)(AP + (size_t)m * NLK + ac) = w;
                }
            }
        }
    }
    {
        const bf16* QKV = (const bf16*)(ws + WS_QKV); bf16* VT = (bf16*)(ws + WS_VT);
        LAS bf16* tile = (LAS bf16*)lds;
        for (int tl = vcu; tl < M / 64; tl += G) {
            const int m0 = tl * 64, b = m0 / T, t0 = m0 % T;
            __syncthreads();
#pragma unroll
            for (int i = 0; i < 2; ++i) { const int ch = tid + 512 * i, r = ch >> 4, c8 = (ch & 15) * 8;
                const v4u v = *(const v4u*)(QKV + (size_t)(m0 + r) * NQKV + 640 + c8);
                *(LAS v4u*)(tile + r * 136 + c8) = v; }
            __syncthreads();
#pragma unroll
            for (int i = 0; i < 2; ++i) { const int ch = tid + 512 * i, dcol = ch >> 3, tq = (ch & 7) * 8;
                unsigned short e[8];
#pragma unroll
                for (int j = 0; j < 8; ++j) e[j] = tile[(tq + j) * 136 + dcol];
                v4u w; w.x = e[0] | ((unsigned)e[1] << 16); w.y = e[2] | ((unsigned)e[3] << 16); w.z = e[4] | ((unsigned)e[5] << 16); w.w = e[6] | ((unsigned)e[7] << 16);
                *(v4u*)(VT + ((size_t)(b * 2 + (dcol >> 6)) * 64 + (dcol & 63)) * T + t0 + tq) = w; }
        }
        __syncthreads();
    }
}

DI void phaseScan(const Args& a, LAS unsigned char* lds, int G, int vcu) {
    const int tid = threadIdx.x, lane = tid & 63, wave = __builtin_amdgcn_readfirstlane(tid >> 6);
    if (wave >= 2) return;
    unsigned char* ws = a.ws;
    const f16* Rr = (const f16*)(ws + WS_RKV); const f16* Kr = Rr + (size_t)M * 512; const f16* Vr = Kr + (size_t)M * 512;
    f16* YF = (f16*)(ws + WS_YF); f16* YB = (f16*)(ws + WS_YB); float* BON = (float*)(ws + WS_BON);
    LAS float* vec = (LAS float*)(lds + wave * 4096);
    for (int chain = vcu * 2 + wave; chain < NB * NH * 2; chain += G * 2) {
        const int dir = chain & 1, h = (chain >> 1) & 7, b = chain >> 4;
        const f16* Aa = (const f16*)((const unsigned char*)a.out + (size_t)dir * OUT_AW);
        const f16* Wa = (const f16*)((const unsigned char*)a.out + (size_t)(2 + dir) * OUT_AW);
        f16* Y = dir ? YB : YF; float* bon = BON + (size_t)dir * M * 8;
        const int ch = h * 64 + lane;
        const float kkc = a.in[I_KK][ch], kac = a.in[I_KA][ch], rkc = a.in[I_RK][ch];
        float S[64];
#pragma unroll
        for (int j = 0; j < 64; ++j) S[j] = 0.f;
        const size_t rowbase = (size_t)b * T;
        size_t o0 = (rowbase + (dir ? T - 1 : 0)) * 512 + ch;
        float nr = (float)Rr[o0], nk = (float)Kr[o0], nv = (float)Vr[o0], na = (float)Aa[o0], nw = (float)Wa[o0];
        for (int step = 0; step < T; ++step) {
            const int t = dir ? T - 1 - step : step;
            const size_t row = rowbase + t;
            const float r = nr, k = nk, v = nv, av = na, w = nw;
            if (step + 1 < T) { const size_t o1 = (rowbase + (dir ? t - 1 : t + 1)) * 512 + ch; nr = (float)Rr[o1]; nk = (float)Kr[o1]; nv = (float)Vr[o1]; na = (float)Aa[o1]; nw = (float)Wa[o1]; }
            float kk = k * kkc;
            const float ss = wave_sum(kk * kk);
            kk = kk / fmaxf(sqrtf(ss), 1e-12f);
            const float kt = k * (1.0f + (av - 1.0f) * kac);
            const float bb = av * kk;
            const float bsum = wave_sum(r * kt * rkc);
            LAS float* vb = vec + (step & 1) * 320;
            vb[lane] = kk; vb[64 + lane] = w; vb[128 + lane] = bb; vb[192 + lane] = kt; vb[256 + lane] = r;
            LDS_WAIT(); asm volatile("" ::: "memory");
            float sk0 = 0.f, sk1 = 0.f, sk2 = 0.f, sk3 = 0.f;
#pragma unroll
            for (int q = 0; q < 16; ++q) { const f32x4 kq = *(const LAS f32x4*)(vb + 4 * q);
                sk0 = fmaf(S[4 * q], kq[0], sk0); sk1 = fmaf(S[4 * q + 1], kq[1], sk1); sk2 = fmaf(S[4 * q + 2], kq[2], sk2); sk3 = fmaf(S[4 * q + 3], kq[3], sk3); }
            const float nsk = -((sk0 + sk1) + (sk2 + sk3));
            float y0 = 0.f, y1 = 0.f, y2 = 0.f, y3 = 0.f;
#pragma unroll
            for (int q = 0; q < 16; ++q) {
                const f32x4 wq = *(const LAS f32x4*)(vb + 64 + 4 * q), bq = *(const LAS f32x4*)(vb + 128 + 4 * q), kq = *(const LAS f32x4*)(vb + 192 + 4 * q), rq = *(const LAS f32x4*)(vb + 256 + 4 * q);
                float s0 = fmaf(S[4 * q], wq[0], fmaf(nsk, bq[0], v * kq[0]));
                float s1 = fmaf(S[4 * q + 1], wq[1], fmaf(nsk, bq[1], v * kq[1]));
                float s2 = fmaf(S[4 * q + 2], wq[2], fmaf(nsk, bq[2], v * kq[2]));
                float s3 = fmaf(S[4 * q + 3], wq[3], fmaf(nsk, bq[3], v * kq[3]));
                S[4 * q] = s0; S[4 * q + 1] = s1; S[4 * q + 2] = s2; S[4 * q + 3] = s3;
                y0 = fmaf(s0, rq[0], y0); y1 = fmaf(s1, rq[1], y1); y2 = fmaf(s2, rq[2], y2); y3 = fmaf(s3, rq[3], y3);
            }
            Y[row * 512 + ch] = (f16)((y0 + y1) + (y2 + y3));
            if (lane == 0) bon[row * 8 + h] = bsum;
        }
    }
}

DI int crow(int reg, int hh) { return (reg & 3) + 8 * (reg >> 2) + 4 * hh; }
DI void phaseAttn(const Args& a, int G, int vcu) {
    const int tid = threadIdx.x, lane = tid & 63, wave = __builtin_amdgcn_readfirstlane(tid >> 6);
    const int gw = vcu * NWAVES + wave, NGW = G * NWAVES;
    unsigned char* ws = a.ws;
    bf16* QKV = (bf16*)(ws + WS_QKV); const bf16* VT = (const bf16*)(ws + WS_VT);
    const int r32 = lane & 31, hh = lane >> 5;
    for (int unit = gw; unit < NB * 8 * (T / 32); unit += NGW) {
        const int qt = unit & 63, hq = (unit >> 6) & 7, b = unit >> 9, kvh = hq >> 2, q0 = qt * 32;
        const float slope = exp2f(-(float)(hq + 1)), sink = a.in[I_SINK][hq];
        const size_t rowb = (size_t)b * T;
        bf16x8 qf[4];
        { const bf16* qp = QKV + (rowb + q0 + r32) * NQKV + hq * 64 + 8 * hh;
#pragma unroll
          for (int s = 0; s < 4; ++s) qf[s] = *(const bf16x8*)(qp + 16 * s); }
        float mrun = sink, lrun = 0.f;
        f32x16 o0, o1;
#pragma unroll
        for (int i = 0; i < 16; ++i) { o0[i] = 0.f; o1[i] = 0.f; }
        const int tq = q0 + r32;
        for (int kt = 0; kt < 9; ++kt) {
            const int k0 = q0 - 128 + 32 * kt;
            if (k0 < 0 || k0 >= T) continue;
            f32x16 st;
#pragma unroll
            for (int i = 0; i < 16; ++i) st[i] = 0.f;
            { const bf16* kp = QKV + (rowb + k0 + r32) * NQKV + 512 + kvh * 64 + 8 * hh;
#pragma unroll
              for (int s = 0; s < 4; ++s) { const bf16x8 kf = *(const bf16x8*)(kp + 16 * s); st = __builtin_amdgcn_mfma_f32_32x32x16_bf16(kf, qf[s], st, 0, 0, 0); } }
            float tmax = -1e30f;
#pragma unroll
            for (int i = 0; i < 16; ++i) { const int sk = k0 + crow(i, hh); int dd = sk - tq; dd = dd < 0 ? -dd : dd;
                const float sc = (dd <= 128) ? st[i] - slope * (float)dd : -1e30f; st[i] = sc; tmax = fmaxf(tmax, sc); }
            tmax = fmaxf(tmax, __shfl_xor(tmax, 32));
            const float mnew = fmaxf(mrun, tmax), alpha = __expf(mrun - mnew);
            mrun = mnew;
            float ps = 0.f;
#pragma unroll
            for (int i = 0; i < 16; ++i) { const float p = __expf(st[i] - mnew); st[i] = p; ps += p; }
            lrun = lrun * alpha + ps;
#pragma unroll
            for (int i = 0; i < 16; ++i) { o0[i] *= alpha; o1[i] *= alpha; }
#pragma unroll
            for (int s = 0; s < 2; ++s) {
                v4u pw; pw.x = pk2(st[8 * s], st[8 * s + 1]); pw.y = pk2(st[8 * s + 2], st[8 * s + 3]); pw.z = pk2(st[8 * s + 4], st[8 * s + 5]); pw.w = pk2(st[8 * s + 6], st[8 * s + 7]);
                const bf16x8 pf = __builtin_bit_cast(bf16x8, pw);
#pragma unroll
                for (int db = 0; db < 2; ++db) {
                    const bf16* vp = VT + ((size_t)(b * 2 + kvh) * 64 + 32 * db + r32) * T + k0 + 16 * s + 4 * hh;
                    const v2u lo = *(const v2u*)vp, hi = *(const v2u*)(vp + 8);
                    v4u vw; vw.x = lo.x; vw.y = lo.y; vw.z = hi.x; vw.w = hi.y;
                    const bf16x8 vf = __builtin_bit_cast(bf16x8, vw);
                    if (db == 0) o0 = __builtin_amdgcn_mfma_f32_32x32x16_bf16(vf, pf, o0, 0, 0, 0);
                    else o1 = __builtin_amdgcn_mfma_f32_32x32x16_bf16(vf, pf, o1, 0, 0, 0);
                }
            }
        }
        const float ltot = lrun + __shfl_xor(lrun, 32);
        const float inv = 1.0f / (ltot + __expf(sink - mrun));
        bf16* op = QKV + (rowb + q0 + r32) * NQKV + hq * 64;
#pragma unroll
        for (int g4 = 0; g4 < 4; ++g4) {
            v2u w0, w1;
            w0.x = pk2(o0[4 * g4] * inv, o0[4 * g4 + 1] * inv); w0.y = pk2(o0[4 * g4 + 2] * inv, o0[4 * g4 + 3] * inv);
            w1.x = pk2(o1[4 * g4] * inv, o1[4 * g4 + 1] * inv); w1.y = pk2(o1[4 * g4 + 2] * inv, o1[4 * g4 + 3] * inv);
            *(v2u*)(op + 8 * g4 + 4 * hh) = w0;
            *(v2u*)(op + 32 + 8 * g4 + 4 * hh) = w1;
        }
    }
}

DI void phasePost(const Args& a, int G, int vcu) {
    const int tid = threadIdx.x, lane = tid & 63, wave = __builtin_amdgcn_readfirstlane(tid >> 6);
    const int gw = vcu * NWAVES + wave, NGW = G * NWAVES;
    unsigned char* ws = a.ws;
    f16* YF = (f16*)(ws + WS_YF); const f16* YB = (const f16*)(ws + WS_YB); const float* BON = (const float*)(ws + WS_BON);
    const f16* Vr = (const f16*)(ws + WS_RKV) + (size_t)2 * M * 512; const bf16* Gg = (const bf16*)(ws + WS_G);
    const float* lnw = a.in[I_LNW]; const float* lnb = a.in[I_LNB];
    for (int m = gw; m < M; m += NGW) {
#pragma unroll
        for (int h = 0; h < 8; ++h) {
            const size_t o = (size_t)m * 512 + h * 64 + lane;
            const float wkv = (float)YF[o] + (float)YB[o];
            const float mean = wave_sum(wkv) * (1.f / 64.f);
            const float dv = wkv - mean;
            const float var = wave_sum(dv * dv) * (1.f / 64.f);
            const float nrm = dv * rsqrtf(var + LNX_EPS) * lnw[h * 64 + lane] + lnb[h * 64 + lane];
            const float bonus = (BON[(size_t)m * 8 + h] + BON[(size_t)M * 8 + (size_t)m * 8 + h]) * (float)Vr[o];
            const float y = (nrm + bonus) * bf2f(Gg[o]);
            ((bf16*)YF)[o] = (bf16)f2bf(y);
        }
    }
}

DI void phaseRouter(const Args& a, LAS unsigned char* lds, int G, int vcu) {
    const int tid = threadIdx.x, lane = tid & 63, wave = __builtin_amdgcn_readfirstlane(tid >> 6);
    const int gw = vcu * NWAVES + wave, NGW = G * NWAVES;
    unsigned char* ws = a.ws;
    LAS float* wr = (LAS float*)lds;
    __syncthreads();
    for (int i = tid; i < D * NE / 4; i += NTHREADS) *(LAS f32x4*)(wr + 4 * i) = *(const f32x4*)(a.in[I_WR] + 4 * i);
    __syncthreads();
    const float* x1 = a.out; bf16* H2 = (bf16*)(ws + WS_H2); float* AFFT = (float*)(ws + WS_AFFT);
    const float* g = a.in[I_NFG];
    for (int m = gw; m < M; m += NGW) {
        const f32x4* xr = (const f32x4*)(x1 + (size_t)m * D) + lane;
        float s = 0.f;
#pragma unroll
        for (int j = 0; j < 4; ++j) { const f32x4 t4 = xr[64 * j]; s += (t4.x * t4.x + t4.y * t4.y) + (t4.z * t4.z + t4.w * t4.w); }
        const float rstd = rsqrtf(wave_sum(s) * (1.f / D) + NORM_EPS);
        float lg[16];
#pragma unroll
        for (int e = 0; e < 16; ++e) lg[e] = 0.f;
        v2u* o = (v2u*)(H2 + (size_t)m * D) + lane;
#pragma unroll 1
        for (int j = 0; j < 4; ++j) {
            const f32x4 hv = xr[64 * j] * rstd * *(const f32x4*)(g + 4 * lane + 256 * j);
            v2u w; w.x = pk2(hv.x, hv.y); w.y = pk2(hv.z, hv.w); o[64 * j] = w;
            const LAS float* wbase = wr + (4 * lane + 256 * j) * 16;
#pragma unroll
            for (int i = 0; i < 4; ++i) {
                const LAS float* wrow = wbase + i * 16;
#pragma unroll
                for (int q = 0; q < 4; ++q) { const f32x4 wv = *(const LAS f32x4*)(wrow + 4 * q);
                    lg[4 * q] = fmaf(hv[i], wv[0], lg[4 * q]); lg[4 * q + 1] = fmaf(hv[i], wv[1], lg[4 * q + 1]); lg[4 * q + 2] = fmaf(hv[i], wv[2], lg[4 * q + 2]); lg[4 * q + 3] = fmaf(hv[i], wv[3], lg[4 * q + 3]); }
            }
        }
        float mx = -1e30f;
#pragma unroll
        for (int e = 0; e < 16; ++e) { lg[e] = wave_sum(lg[e]); mx = fmaxf(mx, lg[e]); }
        float den = 0.f;
#pragma unroll
        for (int e = 0; e < 16; ++e) { lg[e] = expf(lg[e] - mx); den += lg[e]; }
        const float inv = 1.0f / den;
        float mine = 0.f;
#pragma unroll
        for (int e = 0; e < 16; ++e) if (lane == e) mine = lg[e] * inv;
        const int b = m / T, t = m % T;
        if (lane < 16) AFFT[((size_t)b * NE + lane) * T + t] = mine;
    }
    __syncthreads();
}

DI void phaseTopk(const Args& a, LAS unsigned char* lds, int G, int vcu) {
    const int tid = threadIdx.x;
    unsigned char* ws = a.ws;
    const float* AFFT = (const float*)(ws + WS_AFFT); int* SEL = (int*)(ws + WS_SEL); float* VAL = (float*)(ws + WS_VAL);
    const bf16* H2 = (const bf16*)(ws + WS_H2); bf16* XG = (bf16*)(ws + WS_XG);
    LAS float* af = (LAS float*)lds;
    LAS int* lst = (LAS int*)(lds + 8192);
    for (int pr = vcu; pr < NB * NE; pr += G) {
        const int b = pr / NE, e = pr % NE;
        __syncthreads();
        for (int i = tid; i < T / 4; i += NTHREADS) *(LAS f32x4*)(af + 4 * i) = *(const f32x4*)(AFFT + (size_t)pr * T + 4 * i);
        __syncthreads();
        float mv[4]; int cnt[4];
#pragma unroll
        for (int i = 0; i < 4; ++i) { mv[i] = af[tid + 512 * i]; cnt[i] = 0; }
        for (int s4 = 0; s4 < T / 4; ++s4) {
            const f32x4 sv = *(const LAS f32x4*)(af + 4 * s4);
#pragma unroll
            for (int j = 0; j < 4; ++j) { const float x = sv[j]; const int s = 4 * s4 + j;
#pragma unroll
                for (int i = 0; i < 4; ++i) cnt[i] += (x > mv[i] || (x == mv[i] && s < tid + 512 * i)) ? 1 : 0; }
        }
        const size_t slot0 = (size_t)(e * NB + b) * CAP;
#pragma unroll
        for (int i = 0; i < 4; ++i) { const int t = tid + 512 * i; const bool sel = cnt[i] < CAP;
            SEL[((size_t)b * T + t) * NE + e] = sel ? cnt[i] : -1;
            if (sel) { lst[cnt[i]] = t; VAL[slot0 + cnt[i]] = mv[i]; } }
        __syncthreads();
        for (int ch = tid; ch < CAP * 128; ch += NTHREADS) { const int r = ch >> 7, c = (ch & 127) * 8;
            *(v4u*)(XG + (slot0 + r) * D + c) = *(const v4u*)(H2 + ((size_t)b * T + lst[r]) * D + c); }
    }
    __syncthreads();
}

DI void phaseFinal(const Args& a, int G, int vcu) {
    const int tid = threadIdx.x, lane = tid & 63, wave = __builtin_amdgcn_readfirstlane(tid >> 6);
    const int gw = vcu * NWAVES + wave, NGW = G * NWAVES;
    unsigned char* ws = a.ws;
    const int* SEL = (const int*)(ws + WS_SEL); const bf16* YS = (const bf16*)(ws + WS_YS);
    float* out = a.out; const float* g = a.in[I_NFINAL];
    f32x4 gv[4];
#pragma unroll
    for (int j = 0; j < 4; ++j) gv[j] = *(const f32x4*)(g + 4 * lane + 256 * j);
    for (int m = gw; m < M; m += NGW) {
        f32x4* xr = (f32x4*)(out + (size_t)m * D) + lane;
        f32x4 v[4];
#pragma unroll
        for (int j = 0; j < 4; ++j) v[j] = xr[64 * j];
        const int b = m / T;
        const int myr = (lane < 16) ? SEL[(size_t)m * NE + lane] : -1;
        for (int e = 0; e < NE; ++e) {
            const int rk = __shfl(myr, e);
            if (rk >= 0) {
                const v2u* yr = (const v2u*)(YS + ((size_t)(e * NB + b) * CAP + rk) * D) + lane;
#pragma unroll
                for (int j = 0; j < 4; ++j) { const v2u w = yr[64 * j]; v[j].x += bflo(w.x); v[j].y += bfhi(w.x); v[j].z += bflo(w.y); v[j].w += bfhi(w.y); }
            }
        }
        float s = 0.f;
#pragma unroll
        for (int j = 0; j < 4; ++j) s += (v[j].x * v[j].x + v[j].y * v[j].y) + (v[j].z * v[j].z + v[j].w * v[j].w);
        const float rstd = rsqrtf(wave_sum(s) * (1.f / D) + NORM_EPS);
#pragma unroll
        for (int j = 0; j < 4; ++j) xr[64 * j] = v[j] * rstd * gv[j];
    }
}

constexpr int NPHASE = 13;
#ifndef MK_ONE_LAUNCH
#define MK_ONE_LAUNCH 0
#endif
__global__ void __launch_bounds__(NTHREADS, 2) fwd_kernel(Args args) {
    extern __shared__ __attribute__((aligned(16))) unsigned char lds_raw[];
    LAS unsigned char* lds = (LAS unsigned char*)lds_raw;
    const int G = gridDim.x, bx = blockIdx.x;
    const int vcu = (G % 8 == 0) ? (bx % 8) * (G / 8) + bx / 8 : bx;
    const int lo = args.ph_lo, hi = args.ph_hi;
    unsigned char* ws = args.ws;
#define IN(k) (lo <= (k) && (k) < hi)
#if MK_ONE_LAUNCH
#define SEAM(k) do { if (IN(k) && IN((k) + 1)) { cg::this_grid().sync(); } } while (0)
#else
#define SEAM(k) do { } while (0)
#endif
    if (IN(0)) { phase0(args, lds, G, vcu); }
    SEAM(0);
    if (IN(1)) {
        pg8::Gemm g{(const bf16*)args.out, (const bf16*)(ws + WS_WIN), M, NINP, D, D, 1 << 30, 0};
        pg8::StaticOrder S; S.init(M, NINP, G, bx);
        EpiA E{(bf16*)(ws + WS_UR), (bf16*)(ws + WS_QKV), (bf16*)(ws + WS_GATES)};
        pg8::gemm_phase<EpiA, pg8::StaticOrder, PG8_ALIGN, PG8_SP2>(lds, g, S, E);
    }
    SEAM(1);
    if (IN(2)) { phaseP1(args, lds, G, vcu); }
    SEAM(2);
    if (IN(3)) {
        pg8::Gemm g{(const bf16*)(ws + WS_AP), (const bf16*)(ws + WS_WLORA), M, NLN, NLK, NLK, 1 << 30, 0};
        pg8::StaticOrder S; S.init(M, NLN, G, bx);
        EpiLora E{(bf16*)(ws + WS_G), (f16*)args.out, (const float*)(ws + WS_LBIAS)};
        pg8::gemm_phase<EpiLora, pg8::StaticOrder, PG8_ALIGN, PG8_SP2>(lds, g, S, E);
    }
    SEAM(3);
    if (IN(4)) { phaseAttn(args, G, vcu); phaseScan(args, lds, G, vcu); }
    SEAM(4);
    if (IN(5)) { phasePost(args, G, vcu); }
    SEAM(5);
    if (IN(6)) {
        { pg8::Gemm g{(const bf16*)(ws + WS_YF), (const bf16*)(ws + WS_WPR), M, D, 512, 512, 1 << 30, 0};
          pg8::StaticOrder S; S.init(M, D, G, bx);
          EpiMerge<0> E{(bf16*)(ws + WS_MERGED), (const bf16*)(ws + WS_GATES)};
          pg8::gemm_phase<EpiMerge<0>, pg8::StaticOrder, PG8_ALIGN, PG8_SP2>(lds, g, S, E); }
        { pg8::Gemm g{(const bf16*)(ws + WS_QKV), (const bf16*)(ws + WS_WPA), M, D, 512, NQKV, 1 << 30, 0};
          pg8::StaticOrder S; S.init(M, D, G, bx);
          EpiMerge<1> E{(bf16*)(ws + WS_MERGED), (const bf16*)(ws + WS_GATES)};
          pg8::gemm_phase<EpiMerge<1>, pg8::StaticOrder, PG8_ALIGN, PG8_SP2>(lds, g, S, E); }
    }
    SEAM(6);
    if (IN(7)) {
        pg8::Gemm g{(const bf16*)(ws + WS_MERGED), (const bf16*)(ws + WS_WOUT), M, D, D, D, 1 << 30, 0};
        pg8::StaticOrder S; S.init(M, D, G, bx);
        EpiResid E{args.in[I_X], args.out};
        pg8::gemm_phase<EpiResid, pg8::StaticOrder, PG8_ALIGN, PG8_SP2>(lds, g, S, E);
    }
    SEAM(7);
    if (IN(8)) { phaseRouter(args, lds, G, vcu); }
    SEAM(8);
    if (IN(9)) { phaseTopk(args, lds, G, vcu); }
    SEAM(9);
    if (IN(10)) {
        pg8::Gemm g{(const bf16*)(ws + WS_XG), (const bf16*)(ws + WS_WGU), MS, 2048, D, D, NB, (size_t)2048 * D * 2};
        pg8::StaticOrder S; S.init(MS, 2048, G, bx);
        EpiSwiglu E{(bf16*)(ws + WS_HID)};
        pg8::gemm_phase<EpiSwiglu, pg8::StaticOrder, PG8_ALIGN, PG8_SP2>(lds, g, S, E);
    }
    SEAM(10);
    if (IN(11)) {
        pg8::Gemm g{(const bf16*)(ws + WS_HID), (const bf16*)(ws + WS_WD), MS, D, FF, FF, NB, (size_t)D * FF * 2};
        pg8::StaticOrder S; S.init(MS, D, G, bx);
        EpiYs E{(bf16*)(ws + WS_YS), (const float*)(ws + WS_VAL)};
        pg8::gemm_phase<EpiYs, pg8::StaticOrder, PG8_ALIGN, PG8_SP2>(lds, g, S, E);
    }
    SEAM(11);
    if (IN(12)) { phaseFinal(args, G, vcu); }
#undef IN
#undef SEAM
}

extern "C" void kernel_launch(void* const* d_in, const int* in_sizes, int n_in, void* d_out, int out_size, void* d_ws, size_t ws_size, hipStream_t stream) {
    static int grid = 0;
    if (grid == 0) {
        if (n_in != 29 || out_size != M * D || ws_size < WS_END) { fprintf(stderr, "kernel_launch: unexpected shapes (n_in %d out %d ws %zu)\n", n_in, out_size, ws_size); grid = -1; return; }
        int dev = 0, cus = 0, per_cu = 0;
        hipGetDevice(&dev);
        hipDeviceGetAttribute(&cus, hipDeviceAttributeMultiprocessorCount, dev);
        hipFuncSetAttribute((const void*)fwd_kernel, hipFuncAttributeMaxDynamicSharedMemorySize, LDS_BYTES);
        hipOccupancyMaxActiveBlocksPerMultiprocessor(&per_cu, (const void*)fwd_kernel, NTHREADS, LDS_BYTES);
        (void)hipGetLastError();
        if (per_cu < 1) { fprintf(stderr, "kernel_launch: occupancy query says %d blocks per CU\n", per_cu); per_cu = 1; }
        grid = cus;
    }
    if (grid < 0) return;
    Args a{};
    for (int i = 0; i < 29; ++i) a.in[i] = (const float*)d_in[i];
    a.out = (float*)d_out; a.ws = (unsigned char*)d_ws;
#if MK_ONE_LAUNCH
    a.ph_lo = 0; a.ph_hi = NPHASE;
    void* kargs[] = {&a};
    hipError_t e = hipLaunchCooperativeKernel((const void*)fwd_kernel, dim3(grid), dim3(NTHREADS), kargs, LDS_BYTES, stream);
    if (e != hipSuccess) fprintf(stderr, "cooperative launch failed: %s (grid %d)\n", hipGetErrorString(e), grid);
#else
    for (int p = 0; p < NPHASE; ++p) {
        a.ph_lo = p; a.ph_hi = p + 1;
        hipLaunchKernelGGL(fwd_kernel, dim3(grid), dim3(NTHREADS), LDS_BYTES, stream, a);
    }
#endif
}
```

```cpp
#include <hip/hip_runtime.h>
#include <hip/hip_cooperative_groups.h>
#include <cstdio>
#include <cstdint>
namespace cg = cooperative_groups;
namespace pg8 {
#define PG8_LAS __attribute__((address_space(3)))
typedef unsigned short bf16_t;
typedef short bf16x8 __attribute__((ext_vector_type(8)));
typedef float f32x4 __attribute__((ext_vector_type(4)));
typedef unsigned u32x4 __attribute__((ext_vector_type(4)));
typedef int i32x8 __attribute__((ext_vector_type(8)));
typedef int i32x4 __attribute__((ext_vector_type(4)));
constexpr int BM = 256, BK = 64, HALF = 128, HTB = HALF * BK * 2  , STAGE_BYTES = 8 * HTB, NXCD = 8, WGM = 8;

__host__ __device__ __forceinline__ int lds_byte(int r, int c) { const int st = (r >> 4) * 2 + (c >> 5), rr = r & 15, cc = c & 31, ob = rr * 64 + cc * 2; return st * 1024 + (ob ^ (((ob >> 9) & 1) << 5)); }
__host__ __device__ __forceinline__ void stage_rc(int b, int& R, int& C) { const int st = b / 1024, sb = b % 1024, swz = sb ^ (((sb >> 9) & 1) << 5); R = (st >> 1) * 16 + swz / 64; C = (st & 1) * 32 + (swz % 64) / 2; }
__host__ __device__ __forceinline__ int lds_byte_mx(int r, int c) { const int st = (r >> 4) * 2 + (c >> 5), rr = r & 15, cc = c & 31, ob = rr * 64 + cc * 2; return st * 1024 + (ob ^ (((ob >> 9) & 1) << 4)); }
__host__ __device__ __forceinline__ void stage_rc_mx(int b, int& R, int& C) { const int st = b / 1024, sb = b % 1024, swz = sb ^ (((sb >> 9) & 1) << 4); R = (st >> 1) * 16 + swz / 64; C = (st & 1) * 32 + (swz % 64) / 2; }
__host__ __device__ __forceinline__ int perm32(int rho) { const int n = rho >> 4, i = rho & 15; return 8 * (i >> 2) + 4 * n + (i & 3); }

struct Unit { int pm, pn; };
struct Gemm { const bf16_t* A; const bf16_t* Bt; int M, N, K, lda; int grp_tiles; size_t grp_stride; const PG8_LAS unsigned short* glist; int gather_T; const bf16_t* A2; int lda2, ksplit; int mx_scale_a, mx_scale_b; };

struct StaticOrder {
    int nM, nN, nwg, G, c;
    __host__ __device__ void init(int M, int N, int G_, int c_) { nM = M / BM; nN = N / BM; nwg = nM * nN; G = G_; c = c_; }
    __host__ __device__ bool next(int i, Unit& u) const {
        const long L = (long)i * G + c; if (L >= nwg) return false;
        int wgid = (int)L; { const int q = nwg / NXCD, r = nwg % NXCD, xcd = wgid % NXCD, off = wgid / NXCD; wgid = (xcd < r ? xcd * (q + 1) : r * (q + 1) + (xcd - r) * q) + off; }
        const int nig = WGM * nN, gid = wgid / nig, fm = gid * WGM, gsz = (nM - fm) < WGM ? (nM - fm) : WGM;
        u.pm = fm + ((wgid % nig) % gsz); u.pn = (wgid % nig) / gsz; return true;
    }
    __device__ __forceinline__ void a_ready(const Unit&) const {}
    __device__ __forceinline__ void done(const Unit&) const {}
    __device__ __forceinline__ size_t a_off(const Unit&) const { return 0; }
};
struct OwnRowOrder {
    int pm0, pm1, npm, nN;
    __device__ __forceinline__ bool next(int i, Unit& u) const { const int r = i / nN; if (r >= npm) return false; u.pm = r == 0 ? pm0 : pm1; u.pn = i - r * nN; return true; }
    __device__ __forceinline__ void a_ready(const Unit&) const {}
    __device__ __forceinline__ void done(const Unit&) const {}
    __device__ __forceinline__ size_t a_off(const Unit&) const { return 0; }
};
struct OwnRowLoraOrder : OwnRowOrder {
    __device__ __forceinline__ size_t a_off(const Unit& u) const { return u.pn < 2 ? 0 : (u.pn < 6 ? 256 : 512); }
};
struct LoraOrder : StaticOrder {
    __device__ __forceinline__ size_t a_off(const Unit& u) const { return u.pn < 2 ? 0 : (u.pn < 6 ? 256 : 512); }
};
template <class Epi, class Sched, bool ALIGN_EPI = false, bool SP2 = false, bool GA = false, bool SA2 = false, bool MX = false>
__device__ __forceinline__ void gemm_phase(PG8_LAS unsigned char* lds, const Gemm g, const Sched& S, const Epi& E) {
    const int tid = threadIdx.x, wid = __builtin_amdgcn_readfirstlane(tid >> 6), lane = tid & 63, wr = wid >> 2, wc = wid & 3, fr = lane & 15, fq = lane >> 4;
    const int K = g.K, nt = K / BK;
    unsigned voffA[2], voffB[2], voffA2[2];
#pragma unroll
    for (int i = 0; i < 2; ++i) { int R, C; if constexpr (MX) stage_rc_mx(tid * 16 + i * 8192, R, C); else stage_rc(tid * 16 + i * 8192, R, C); const int Rb = Epi::PERM ? ((R & ~31) + perm32(R & 31)) : R;
        voffA[i] = (unsigned)(R * g.lda + C) * 2u; voffB[i] = (unsigned)(Rb * K + C) * 2u; voffA2[i] = (unsigned)(R * g.lda2 + C) * 2u; }
    const size_t kstep = (size_t)(BK * 2);
    const size_t hstepA = (size_t)HALF * g.lda * 2, hstepB = (size_t)HALF * K * 2;
    const size_t tstepA = GA ? 0 : 2 * hstepA, tstepB = 2 * hstepB;
    const size_t hstepA2 = (size_t)HALF * g.lda2 * 2; const int ks = g.ksplit;
    const unsigned ldsw = (unsigned)wid * 1024u;
    const int aoff = lds_byte(wr * 64 + fr, fq * 8), boff = lds_byte(wc * 32 + fr, fq * 8);
    const int aoffx0 = lds_byte_mx(wr * 64 + fr, 16 * fq), aoffx1 = lds_byte_mx(wr * 64 + fr, 16 * fq + 8), boffx0 = lds_byte_mx(wc * 32 + fr, 16 * fq), boffx1 = lds_byte_mx(wc * 32 + fr, 16 * fq + 8);
#define PG8_SA(b, h) (((b) * 2 + (h)) * HTB)
#define PG8_SB(b, h) ((4 + (b) * 2 + (h)) * HTB)
#define PG8_STAGE(bufoff, gbase, voff) do { _Pragma("unroll") for (int _i = 0; _i < 2; ++_i) { unsigned vo1_ = (voff)[_i]; if constexpr (MX) asm volatile("" : "+v"(vo1_));     \
        __builtin_amdgcn_global_load_lds((const unsigned*)((const char*)(gbase) + vo1_), (PG8_LAS unsigned*)(lds + (bufoff) + ldsw + _i * 8192), 16, 0, 0); } } while (0)
#define PG8_STAGE_A(bufoff, base, half, usenext, side) do { if constexpr (GA) { unsigned vo_[2]; _Pragma("unroll") for (int q_ = 0; q_ < 2; ++q_) vo_[q_] = (usenext) ? nG[half][q_] : cG[half][q_]; PG8_STAGE(bufoff, base, vo_); } \
        else if constexpr (SA2) { if (side) { PG8_STAGE(bufoff, (base) + (half) * hstepA2, voffA2); } else { PG8_STAGE(bufoff, (base) + (half) * hstepA, voffA); } } \
        else { PG8_STAGE(bufoff, (base) + (half) * hstepA, voffA); } } while (0)
#define PG8_LDA(dst, b, h) do { if constexpr (MX) { _Pragma("unroll") for (int m = 0; m < 4; ++m) { const i32x4 lo_ = *(const PG8_LAS i32x4*)(lds + PG8_SA(b, h) + aoffx0 + m * 2048), hi_ = *(const PG8_LAS i32x4*)(lds + PG8_SA(b, h) + aoffx1 + m * 2048); \
            dst##X[m] = __builtin_shufflevector(lo_, hi_, 0, 1, 2, 3, 4, 5, 6, 7); } } \
        else { _Pragma("unroll") for (int m = 0; m < 4; ++m) _Pragma("unroll") for (int k = 0; k < 2; ++k) dst[m][k] = *(const PG8_LAS bf16x8*)(lds + PG8_SA(b, h) + aoff + m * 2048 + k * 1024); } } while (0)
#define PG8_LDB(dst, b, h) do { if constexpr (MX) { _Pragma("unroll") for (int n = 0; n < 2; ++n) { const i32x4 lo_ = *(const PG8_LAS i32x4*)(lds + PG8_SB(b, h) + boffx0 + n * 2048), hi_ = *(const PG8_LAS i32x4*)(lds + PG8_SB(b, h) + boffx1 + n * 2048); \
            dst##X[n] = __builtin_shufflevector(lo_, hi_, 0, 1, 2, 3, 4, 5, 6, 7); } } \
        else { _Pragma("unroll") for (int n = 0; n < 2; ++n) _Pragma("unroll") for (int k = 0; k < 2; ++k) dst[n][k] = *(const PG8_LAS bf16x8*)(lds + PG8_SB(b, h) + boff + n * 2048 + k * 1024); } } while (0)
#define PG8_MMA(ai, bj, At, Bt) do { __builtin_amdgcn_s_setprio(1); if constexpr (MX) { _Pragma("unroll") for (int m = 0; m < 4; ++m) _Pragma("unroll") for (int n = 0; n < 2; ++n) \
        asm volatile("v_mfma_scale_f32_16x16x128_f8f6f4 %0, %1, %2, %0, %3, %3 op_sel_hi:[0,0,0]" : "+v"(acc[ai][bj][m][n]) : "v"(Bt##X[n]), "v"(At##X[m]), "v"(mxs)); }     \
        else { _Pragma("unroll") for (int m = 0; m < 4; ++m) _Pragma("unroll") for (int n = 0; n < 2; ++n) _Pragma("unroll") for (int k = 0; k < 2; ++k) \
        acc[ai][bj][m][n] = __builtin_amdgcn_mfma_f32_16x16x32_bf16(Bt[n][k], At[m][k], acc[ai][bj][m][n], 0, 0, 0); } __builtin_amdgcn_s_setprio(0); } while (0)
#define PG8_WAIT_V(n) asm volatile("s_waitcnt vmcnt(" #n ")" ::: "memory")
#define PG8_WAIT_L(n) asm volatile("s_waitcnt lgkmcnt(" #n ")" ::: "memory")
#define PG8_BAR __builtin_amdgcn_s_barrier()
#define PG8_SCHED __builtin_amdgcn_sched_barrier(0)
    Unit cur, nxt; int ui = 0;
    if (!S.next(0, cur)) return;
    f32x4 acc[2][2][4][2];
#pragma unroll
    for (int a = 0; a < 2; ++a)
#pragma unroll
        for (int b = 0; b < 2; ++b)
#pragma unroll
            for (int m = 0; m < 4; ++m)
#pragma unroll
                for (int n = 0; n < 2; ++n) acc[a][b][m][n] = (f32x4){0.f, 0.f, 0.f, 0.f};
    bf16x8 At[4][2], B0[2][2], B1[2][2];
    i32x8 AtX[4], B0X[2], B1X[2];
    int mxs = 0x7f7f7f7f; asm volatile("" : "+v"(mxs));
    unsigned cG[2][2], nG[2][2]; int gR[2], gC[2];
    if constexpr (GA) {
#pragma unroll
        for (int i = 0; i < 2; ++i) { int R, C; stage_rc(tid * 16 + i * 8192, R, C); gR[i] = R; gC[i] = C; }
#pragma unroll
        for (int h = 0; h < 2; ++h)
#pragma unroll
            for (int i = 0; i < 2; ++i) { const int tok = g.glist[h * HALF + gR[i]]; cG[h][i] = (unsigned)(((cur.pm % g.grp_tiles) * g.gather_T + tok) * g.lda + gC[i]) * 2u; nG[h][i] = cG[h][i]; }
    }
    const char* cA = (const char*)g.A + (size_t)cur.pm * tstepA + S.a_off(cur); const char* cB = (const char*)g.Bt + (size_t)(cur.pm / g.grp_tiles) * g.grp_stride + (size_t)cur.pn * tstepB;
    const char* cA2 = (const char*)g.A2 + (size_t)cur.pm * 2 * hstepA2;
    S.a_ready(cur);
    if constexpr (SP2) {
        PG8_STAGE(PG8_SB(0, 0), cB, voffB); PG8_STAGE(PG8_SB(0, 1), cB + hstepB, voffB); PG8_STAGE_A(PG8_SA(0, 0), cA, 0, false, false); PG8_STAGE_A(PG8_SA(0, 1), cA, 1, false, false);
        if (wr == 1) PG8_BAR;
        PG8_WAIT_V(2); PG8_BAR;
        PG8_STAGE(PG8_SB(1, 0), cB + kstep, voffB); PG8_STAGE_A(PG8_SA(1, 0), cA + kstep, 0, false, false); PG8_STAGE(PG8_SB(1, 1), cB + hstepB + kstep, voffB);
        PG8_WAIT_V(6); PG8_BAR;
    } else {
        PG8_STAGE(PG8_SB(0, 0), cB, voffB); PG8_STAGE_A(PG8_SA(0, 0), cA, 0, false, false); PG8_STAGE(PG8_SB(0, 1), cB + hstepB, voffB); PG8_STAGE_A(PG8_SA(0, 1), cA, 1, false, false);
        if (wr == 1) PG8_BAR;
        PG8_WAIT_V(4); PG8_BAR;
        PG8_STAGE(PG8_SB(1, 0), cB + kstep, voffB); PG8_STAGE_A(PG8_SA(1, 0), cA + kstep, 0, false, false); PG8_STAGE(PG8_SB(1, 1), cB + hstepB + kstep, voffB);
        PG8_WAIT_V(6); PG8_BAR;
    }
    for (;;) {
        const bool has_next = S.next(ui + 1, nxt);
        if constexpr (GA) { if (has_next) {
#pragma unroll
            for (int h = 0; h < 2; ++h)
#pragma unroll
                for (int i = 0; i < 2; ++i) { const int tok = g.glist[(ui + 1) * 256 + h * HALF + gR[i]]; nG[h][i] = (unsigned)(((nxt.pm % g.grp_tiles) * g.gather_T + tok) * g.lda + gC[i]) * 2u; } } }
        const char* nA = has_next ? (const char*)g.A + (size_t)nxt.pm * tstepA + S.a_off(nxt) : cA; const char* nB = has_next ? (const char*)g.Bt + (size_t)(nxt.pm / g.grp_tiles) * g.grp_stride + (size_t)nxt.pn * tstepB : cB;
        for (int t = 0; t < nt; t += 2) {
            const bool last = (t == nt - 2); const bool usen = last && has_next;
            const bool s1 = SA2 && t >= ks, s2 = SA2 && !last && (t + 2 >= ks);
            const char* a1 = s1 ? cA2 + (size_t)(t + 1 - ks) * kstep : cA + (size_t)(t + 1) * kstep;
            const char* a2 = last ? nA : (s2 ? cA2 + (size_t)(t + 2 - ks) * kstep : cA + (size_t)(t + 2) * kstep); const char* b2 = last ? nB : cB + (size_t)(t + 2) * kstep;
            const char* a3 = a2 + kstep; const char* b3 = b2 + kstep;
            if (last && has_next) S.a_ready(nxt);
            if constexpr (SA2) { if (t == ks) E.mid(acc, cur, wr, wc, fr, fq); }
            if constexpr (SP2) {
            PG8_LDB(B0, 0, 0); PG8_LDB(B1, 0, 1); PG8_SCHED; PG8_LDA(At, 0, 0); PG8_STAGE_A(PG8_SA(1, 1), a1, 1, false, s1);
            PG8_WAIT_V(8); PG8_WAIT_L(0); PG8_BAR; PG8_MMA(0, 0, At, B0); PG8_MMA(0, 1, At, B1); PG8_BAR; PG8_SCHED;
            PG8_LDA(At, 0, 1); PG8_STAGE(PG8_SB(0, 0), b2, voffB); PG8_STAGE(PG8_SB(0, 1), b2 + hstepB, voffB); PG8_STAGE_A(PG8_SA(0, 0), a2, 0, usen, s2);
            PG8_WAIT_V(8); PG8_WAIT_L(0); PG8_BAR; PG8_MMA(1, 0, At, B0); PG8_MMA(1, 1, At, B1); PG8_BAR; PG8_SCHED;
            PG8_LDB(B0, 1, 0); PG8_LDB(B1, 1, 1); PG8_SCHED; PG8_LDA(At, 1, 0); PG8_STAGE_A(PG8_SA(0, 1), a2, 1, usen, s2);
            PG8_WAIT_V(8); PG8_WAIT_L(0); PG8_BAR; PG8_MMA(0, 0, At, B0); PG8_MMA(0, 1, At, B1); PG8_BAR; PG8_SCHED;
            PG8_LDA(At, 1, 1); PG8_STAGE(PG8_SB(1, 0), b3, voffB); PG8_STAGE(PG8_SB(1, 1), b3 + hstepB, voffB); PG8_STAGE_A(PG8_SA(1, 0), a3, 0, usen, s2);
            PG8_WAIT_V(8); PG8_WAIT_L(0); PG8_BAR; PG8_MMA(1, 0, At, B0); PG8_MMA(1, 1, At, B1); PG8_BAR; PG8_SCHED;
            } else {
            PG8_LDB(B0, 0, 0); PG8_SCHED; PG8_LDA(At, 0, 0); PG8_STAGE_A(PG8_SA(1, 1), a1, 1, false, s1);
            PG8_WAIT_L(8); PG8_BAR; PG8_WAIT_L(0); PG8_MMA(0, 0, At, B0); PG8_BAR; PG8_SCHED;
            PG8_LDB(B1, 0, 1); PG8_STAGE(PG8_SB(0, 0), b2, voffB);
            PG8_BAR; PG8_WAIT_L(0); PG8_MMA(0, 1, At, B1); PG8_BAR;
            PG8_LDA(At, 0, 1); PG8_STAGE_A(PG8_SA(0, 0), a2, 0, usen, s2);
            PG8_BAR; PG8_WAIT_L(0); PG8_MMA(1, 0, At, B0); PG8_BAR; PG8_SCHED;
            PG8_STAGE(PG8_SB(0, 1), b2 + hstepB, voffB);
            PG8_WAIT_V(6); PG8_BAR; PG8_MMA(1, 1, At, B1); PG8_BAR;
            PG8_LDB(B0, 1, 0); PG8_SCHED; PG8_LDA(At, 1, 0); PG8_STAGE_A(PG8_SA(0, 1), a2, 1, usen, s2);
            PG8_WAIT_L(8); PG8_BAR; PG8_WAIT_L(0); PG8_MMA(0, 0, At, B0); PG8_BAR; PG8_SCHED;
            PG8_LDB(B1, 1, 1); PG8_STAGE(PG8_SB(1, 0), b3, voffB);
            PG8_BAR; PG8_WAIT_L(0); PG8_MMA(0, 1, At, B1); PG8_BAR;
            PG8_LDA(At, 1, 1); PG8_STAGE_A(PG8_SA(1, 0), a3, 0, usen, s2);
            PG8_BAR; PG8_WAIT_L(0); PG8_MMA(1, 0, At, B0); PG8_BAR; PG8_SCHED;
            PG8_STAGE(PG8_SB(1, 1), b3 + hstepB, voffB);
            PG8_WAIT_V(6); PG8_BAR; PG8_MMA(1, 1, At, B1); PG8_BAR;
            }
        }
        if constexpr (ALIGN_EPI) { if (wr == 0) PG8_BAR; }
        if constexpr (MX) asm volatile("s_nop 15\n\ts_nop 15" ::: "memory");
#ifdef PG8_EPI_TWICE
        if constexpr (!Epi::AFTER_DRAIN) { E(acc, cur, wr, wc, fr, fq); asm volatile("" ::: "memory"); }
#endif
        if constexpr (!Epi::AFTER_DRAIN) { E(acc, cur, wr, wc, fr, fq); S.done(cur); }
        if (!has_next) break;
#pragma unroll
        for (int a = 0; a < 2; ++a)
#pragma unroll
            for (int b = 0; b < 2; ++b)
#pragma unroll
                for (int m = 0; m < 4; ++m)
#pragma unroll
                    for (int n = 0; n < 2; ++n) acc[a][b][m][n] = (f32x4){0.f, 0.f, 0.f, 0.f};
        cur = nxt; cA = nA; cB = nB; ++ui; cA2 = (const char*)g.A2 + (size_t)cur.pm * 2 * hstepA2;
        if constexpr (GA) { _Pragma("unroll") for (int h = 0; h < 2; ++h) _Pragma("unroll") for (int i = 0; i < 2; ++i) cG[h][i] = nG[h][i]; }
        if constexpr (ALIGN_EPI) { if (wr == 1) PG8_BAR; }
    }
    PG8_WAIT_V(0);
    if constexpr (!ALIGN_EPI) { if (wr == 0) PG8_BAR; }
    PG8_BAR;
    if constexpr (Epi::AFTER_DRAIN) { E.fused(acc, cur, wr, wc, fr, fq, lds, wid, lane); S.done(cur); }
#undef PG8_SA
#undef PG8_SB
#undef PG8_STAGE
#undef PG8_LDA
#undef PG8_LDB
#undef PG8_MMA
#undef PG8_WAIT_V
#undef PG8_WAIT_L
#undef PG8_BAR
#undef PG8_SCHED
}
}

#ifndef PG8_SP2
#define PG8_SP2 true
#endif
#ifndef PG8_ALIGN
#define PG8_ALIGN true
#endif

#define DI __device__ __forceinline__
#define LAS __attribute__((address_space(3)))
typedef unsigned short bf16;
typedef _Float16 f16;
typedef unsigned v4u __attribute__((ext_vector_type(4)));
typedef unsigned v2u __attribute__((ext_vector_type(2)));
typedef float f32x4 __attribute__((ext_vector_type(4)));
typedef float f32x2 __attribute__((ext_vector_type(2)));
typedef float f32x16 __attribute__((ext_vector_type(16)));
typedef short bf16x8 __attribute__((ext_vector_type(8)));
typedef _Float16 f16x8 __attribute__((ext_vector_type(8)));
typedef _Float16 f16x4 __attribute__((ext_vector_type(4)));
typedef __bf16 bf16x2_t __attribute__((ext_vector_type(2)));

constexpr int NB = 32, T = 2048, D = 1024, M = NB * T;
constexpr int RC = 1920, NQKV = 768, NGATE = 2048, NIN = 4736, NINP = 4864;
constexpr int RD = 512, NH = 8, HS = 64;
constexpr int NLK = 384, NLN = 2560;
constexpr int NE = 16, CAP = 256, FF = 1024, MS = NB * NE * CAP;
constexpr float DECAY_SCALE = 0.60653065971263342f;
constexpr float LNX_EPS = 64e-5f, NORM_EPS = 1e-6f;
constexpr int NWAVES = 8, NTHREADS = 512;

constexpr size_t MiB = 1u << 20;
constexpr size_t WS_CTL = 0;
constexpr size_t WS_KN = 1 * MiB;
constexpr size_t WS_AFFT = 5 * MiB;
constexpr size_t WS_SEL = 9 * MiB;
constexpr size_t WS_VAL = 13 * MiB;
constexpr size_t WS_RSTD = 13 * MiB + 768 * 1024;
constexpr size_t WS_LBIAS = 13 * MiB + 512 * 1024;
constexpr size_t WS_VT = 14 * MiB;
constexpr size_t WS_WIN = 30 * MiB;
constexpr size_t WS_WG8 = 36 * MiB;
constexpr size_t WS_WPR = 40 * MiB;
constexpr size_t WS_WPA = 41 * MiB;
constexpr size_t WS_WOUT = 42 * MiB;
constexpr size_t WS_WLORA = 44 * MiB;
constexpr size_t WS_WGU = 46 * MiB;
constexpr size_t WS_WD = 110 * MiB;
constexpr size_t WS_UR = 142 * MiB;
constexpr size_t WS_G = 606 * MiB;
constexpr size_t WS_YF = 206 * MiB;
constexpr size_t WS_YB = 270 * MiB;
constexpr size_t WS_HID = 142 * MiB;
constexpr size_t WS_QKV = 382 * MiB;
constexpr size_t WS_GATES = 478 * MiB;
constexpr size_t WS_XG = 478 * MiB;
constexpr size_t WS_YS = 478 * MiB;
constexpr size_t WS_RKV = 734 * MiB;
constexpr size_t WS_AP = 926 * MiB;
constexpr size_t WS_MERGED = 734 * MiB;
constexpr size_t WS_X1B = 862 * MiB;
constexpr size_t WS_END = 1024 * MiB;
constexpr size_t OUT_AW = 64 * MiB;

constexpr int LDS_BYTES = 151552;

#define LDS_WAIT() asm volatile("s_waitcnt lgkmcnt(0)" ::: "memory")
DI unsigned f2bf(float f) { unsigned u = __builtin_bit_cast(unsigned, f); return (u + 0x7fffu + ((u >> 16) & 1u)) >> 16; }
DI unsigned pk2(float lo, float hi) { f32x2 v = {lo, hi}; bf16x2_t b = __builtin_convertvector(v, bf16x2_t); return __builtin_bit_cast(unsigned, b); }
DI float bflo(unsigned w) { return __builtin_bit_cast(float, w << 16); }
DI float bfhi(unsigned w) { return __builtin_bit_cast(float, w & 0xffff0000u); }
DI float bf2f(bf16 b) { return __builtin_bit_cast(float, (unsigned)b << 16); }
DI float sigmoidf_(float x) { return __builtin_amdgcn_rcpf(1.0f + __expf(-x)); }
DI float wave_sum(float v) {
#pragma unroll
    for (int o = 1; o < 64; o <<= 1) v += __shfl_xor(v, o);
    return v;
}
DI float wave_max(float v) {
#pragma unroll
    for (int o = 1; o < 64; o <<= 1) v = fmaxf(v, __shfl_xor(v, o));
    return v;
}

struct Args { const float* in[29]; float* out; unsigned char* ws; int ph_lo, ph_hi; };
struct KIn { DI const float* operator[](int i) const { return ((const float* const*)__builtin_amdgcn_kernarg_segment_ptr())[i]; } };
struct DArgs { KIn in; float* out; unsigned char* ws; };

enum { I_X = 0, I_NMG, I_WIN, I_MUP, I_MUN, I_W0F, I_WUPF, I_W0B, I_WUPB, I_A0F, I_AUPF, I_A0B, I_AUPB, I_GUP, I_KK, I_KA, I_RK, I_LNW, I_LNB, I_SINK,
       I_WPR, I_WPA, I_WOUT, I_NFG, I_WR, I_EG, I_EU, I_ED, I_NFINAL };

DI void transpose_item(const float* __restrict__ W, int ldw, int k0, int n0, bf16* WT, size_t drow0, int ldt, int dk0, LAS float* scr, int lane) {
    f32x4 t[8];
#pragma unroll
    for (int i = 0; i < 8; ++i) t[i] = *(const f32x4*)(W + (size_t)(k0 + 8 * i + (lane >> 3)) * ldw + n0 + 4 * (lane & 7));
#pragma unroll
    for (int i = 0; i < 8; ++i) { LAS float* d = scr + (8 * i + (lane >> 3)) * 33 + 4 * (lane & 7); d[0] = t[i][0]; d[1] = t[i][1]; d[2] = t[i][2]; d[3] = t[i][3]; }
    LDS_WAIT(); asm volatile("" ::: "memory");
    const int c = lane & 7;
#pragma unroll
    for (int j = 0; j < 4; ++j) { const int n = (lane >> 3) + 8 * j; const LAS float* s = scr + (8 * c) * 33 + n;
        v4u o; o.x = pk2(s[0 * 33], s[1 * 33]); o.y = pk2(s[2 * 33], s[3 * 33]); o.z = pk2(s[4 * 33], s[5 * 33]); o.w = pk2(s[6 * 33], s[7 * 33]);
        *(v4u*)(WT + (drow0 + n) * (size_t)ldt + dk0 + 8 * c) = o; }
    LDS_WAIT(); asm volatile("" ::: "memory");
}

DI unsigned pk4_fp8(float a, float b, float c, float d) { unsigned w = 0; w = __builtin_amdgcn_cvt_pk_fp8_f32(a, b, w, false); w = __builtin_amdgcn_cvt_pk_fp8_f32(c, d, w, true); return w; }
DI void transpose_item_f8(const float* __restrict__ W, int ldw, int k0, int n0, unsigned char* WT, size_t drow0, int ldt, int dk0, LAS float* scr, int lane, float scale) {
    f32x4 t[8];
#pragma unroll
    for (int i = 0; i < 8; ++i) t[i] = *(const f32x4*)(W + (size_t)(k0 + 8 * i + (lane >> 3)) * ldw + n0 + 4 * (lane & 7));
#pragma unroll
    for (int i = 0; i < 8; ++i) { LAS float* d = scr + (8 * i + (lane >> 3)) * 33 + 4 * (lane & 7); d[0] = t[i][0] * scale; d[1] = t[i][1] * scale; d[2] = t[i][2] * scale; d[3] = t[i][3] * scale; }
    LDS_WAIT(); asm volatile("" ::: "memory");
    const int c = lane & 7;
#pragma unroll
    for (int j = 0; j < 4; ++j) { const int n = (lane >> 3) + 8 * j; const LAS float* s = scr + (8 * c) * 33 + n;
        v2u o; o.x = pk4_fp8(s[0 * 33], s[1 * 33], s[2 * 33], s[3 * 33]); o.y = pk4_fp8(s[4 * 33], s[5 * 33], s[6 * 33], s[7 * 33]);
        *(v2u*)(WT + (drow0 + n) * (size_t)ldt + dk0 + 8 * c) = o; }
    LDS_WAIT(); asm volatile("" ::: "memory");
}

DI void phase0(const DArgs& a, LAS unsigned char* lds, int G, int vcu) {
    const int tid = threadIdx.x, lane = tid & 63, wave = __builtin_amdgcn_readfirstlane(tid >> 6);
    LAS float* scr = (LAS float*)(lds + wave * 16384);
    const int gw = vcu * NWAVES + wave, NGW = G * NWAVES;
    unsigned char* ws = a.ws;
    constexpr int J1 = 16 * 148, J2 = 8 * 32, J3 = J2, J4 = 16 * 32, JE = 16 * 32, J5 = NE * JE;
    constexpr int NITEMS = J1 + J2 + J3 + J4 + 3 * J5;
    for (int it = gw; it < NITEMS; it += NGW) {
        int r = it;
        if (r < J1) { const int kb = r / 148, nb = r % 148;
            if (nb < 84) transpose_item(a.in[I_WIN], NIN, 64 * kb, 32 * nb, (bf16*)(ws + WS_WIN), 32 * nb, D, 64 * kb, scr, lane);
            else transpose_item_f8(a.in[I_WIN], NIN, 64 * kb, 32 * nb, (unsigned char*)(ws + WS_WG8), 32 * nb - 2688, D, 64 * kb, scr, lane, 32.0f);
            continue; } r -= J1;
        if (r < J2) { const int kb = r / 32, nb = r % 32; transpose_item(a.in[I_WPR], D, 64 * kb, 32 * nb, (bf16*)(ws + WS_WPR), 32 * nb, D, 64 * kb, scr, lane); continue; } r -= J2;
        if (r < J3) { const int kb = r / 32, nb = r % 32; transpose_item(a.in[I_WPA], D, 64 * kb, 32 * nb, (bf16*)(ws + WS_WPR), 32 * nb, D, 512 + 64 * kb, scr, lane); continue; } r -= J3;
        if (r < J4) { const int kb = r / 32, nb = r % 32; transpose_item(a.in[I_WOUT], D, 64 * kb, 32 * nb, (bf16*)(ws + WS_WOUT), 32 * nb, D, 64 * kb, scr, lane); continue; } r -= J4;
        if (r < J5) { const int e = r / JE, q = r % JE, kb = q / 32, nb = q % 32, n0 = 32 * nb;
            transpose_item_f8(a.in[I_EG] + (size_t)e * D * FF, FF, 64 * kb, n0, (unsigned char*)(ws + WS_WGU) + (size_t)e * 2048 * D, (n0 / 128) * 256 + (n0 % 128), D, 64 * kb, scr, lane, 32.0f); continue; } r -= J5;
        if (r < J5) { const int e = r / JE, q = r % JE, kb = q / 32, nb = q % 32, n0 = 32 * nb;
            transpose_item_f8(a.in[I_EU] + (size_t)e * D * FF, FF, 64 * kb, n0, (unsigned char*)(ws + WS_WGU) + (size_t)e * 2048 * D, (n0 / 128) * 256 + 128 + (n0 % 128), D, 64 * kb, scr, lane, 32.0f); continue; } r -= J5;
        { const int e = r / JE, q = r % JE, kb = q / 32, nb = q % 32;
            transpose_item_f8(a.in[I_ED] + (size_t)e * FF * D, D, 64 * kb, 32 * nb, (unsigned char*)(ws + WS_WD) + (size_t)e * D * FF, 32 * nb, FF, 64 * kb, scr, lane, 32.0f); }
    }
    {
        bf16* WL = (bf16*)(ws + WS_WLORA);
        const int gt = vcu * NTHREADS + tid, NGT = G * NTHREADS;
        for (int idx = gt; idx < 2560 * 16; idx += NGT) {
            const int n = idx >> 4, k = (idx & 15) * 8;
            const float* src = nullptr; int nn = n, koff = 0, klen = 128;
            if (n < 512) { src = a.in[I_GUP]; }
            else if (n < 1024) { src = a.in[I_WUPF]; nn = n - 512; klen = 64; }
            else if (n < 1536) { src = a.in[I_WUPB]; nn = n - 1024; koff = 64; klen = 64; }
            else if (n < 2048) { src = a.in[I_AUPF]; nn = n - 1536; klen = 64; }
            else { src = a.in[I_AUPB]; nn = n - 2048; koff = 64; klen = 64; }
            float v[8];
#pragma unroll
            for (int j = 0; j < 8; ++j) { const int kk = k + j - koff; v[j] = (kk >= 0 && kk < klen) ? src[(size_t)kk * 512 + nn] : 0.f; }
            v4u o; o.x = pk2(v[0], v[1]); o.y = pk2(v[2], v[3]); o.z = pk2(v[4], v[5]); o.w = pk2(v[6], v[7]);
            *(v4u*)(WL + (size_t)n * 128 + k) = o;
        }
    }
    if (vcu == 0) {
        float* LB = (float*)(ws + WS_LBIAS);
        LB[tid] = a.in[I_W0F][tid]; LB[512 + tid] = a.in[I_W0B][tid]; LB[1024 + tid] = a.in[I_A0F][tid]; LB[1536 + tid] = a.in[I_A0B][tid];
    }
    {
        bf16* H = (bf16*)a.out; unsigned char* H8 = (unsigned char*)a.out + 128 * MiB; const float* x = a.in[I_X]; const float* g = a.in[I_NMG];
        f32x4 gv[4];
#pragma unroll
        for (int j = 0; j < 4; ++j) gv[j] = *(const f32x4*)(g + 4 * lane + 256 * j);
        for (int m = gw * 2; m < M; m += NGW * 2) {
            const f32x4* xr = (const f32x4*)(x + (size_t)m * D) + lane;
            f32x4 v[4], u[4]; float s = 0.f, s2 = 0.f;
#pragma unroll
            for (int j = 0; j < 4; ++j) { v[j] = xr[64 * j]; u[j] = xr[64 * j + D / 4]; }
#pragma unroll
            for (int j = 0; j < 4; ++j) { s += (v[j].x * v[j].x + v[j].y * v[j].y) + (v[j].z * v[j].z + v[j].w * v[j].w); s2 += (u[j].x * u[j].x + u[j].y * u[j].y) + (u[j].z * u[j].z + u[j].w * u[j].w); }
            const float rstd = rsqrtf(wave_sum(s) * (1.f / D) + NORM_EPS), rstd2 = rsqrtf(wave_sum(s2) * (1.f / D) + NORM_EPS);
            v2u* o = (v2u*)(H + (size_t)m * D) + lane; unsigned* o8 = (unsigned*)(H8 + (size_t)m * D) + lane;
#pragma unroll
            for (int j = 0; j < 4; ++j) { const f32x4 h1 = v[j] * rstd * gv[j], h2 = u[j] * rstd2 * gv[j];
                v2u w; w.x = pk2(h1.x, h1.y); w.y = pk2(h1.z, h1.w); o[64 * j] = w; o8[64 * j] = pk4_fp8(h1.x, h1.y, h1.z, h1.w);
                v2u w2; w2.x = pk2(h2.x, h2.y); w2.y = pk2(h2.z, h2.w); o[64 * j + D / 4] = w2; o8[64 * j + D / 4] = pk4_fp8(h2.x, h2.y, h2.z, h2.w); }
        }
    }
}

using pg8::Unit;
struct EpiA {
    static constexpr bool PERM = true, AFTER_DRAIN = false;
    bf16* UR; bf16* QKV; bf16* GATES;
    DI void operator()(const f32x4 (&acc)[2][2][4][2], const Unit& u, int wr, int wc, int fr, int fq) const {
        const int row0 = u.pm * 256 + wr * 64 + fr;
#pragma unroll
        for (int bj = 0; bj < 2; ++bj) {
            const int cb = u.pn * 2 + bj;
            if (cb >= 21) continue;
            bf16* base; int ld, colb, mode;
            if (cb < 15) { base = UR; ld = RC; colb = cb * 128; mode = 0; }
            else if (cb < 21) { base = QKV; ld = NQKV; colb = (cb - 15) * 128; mode = (cb < 19) ? 1 : 0; }
            else { base = GATES; ld = NGATE; colb = (cb - 21) * 128; mode = 2; }
            const int col = colb + wc * 32 + 8 * fq;
#pragma unroll
            for (int ai = 0; ai < 2; ++ai)
#pragma unroll
                for (int m = 0; m < 4; ++m) {
                    f32x4 v0 = acc[ai][bj][m][0], v1 = acc[ai][bj][m][1];
                    if (mode == 1) { v0 = v0 * 0.125f; v1 = v1 * 0.125f; }
                    else if (mode == 2) {
#pragma unroll
                        for (int i = 0; i < 4; ++i) { v0[i] = sigmoidf_(v0[i]); v1[i] = sigmoidf_(v1[i]); }
                    }
                    if (mode == 2) {
                        unsigned q[8];
#pragma unroll
                        for (int i = 0; i < 4; ++i) { q[i] = (unsigned)(v0[i] * 255.0f + 0.5f); q[4 + i] = (unsigned)(v1[i] * 255.0f + 0.5f); }
                        v2u w; w.x = q[0] | (q[1] << 8) | (q[2] << 16) | (q[3] << 24); w.y = q[4] | (q[5] << 8) | (q[6] << 16) | (q[7] << 24);
                        *(v2u*)((unsigned char*)GATES + (size_t)(row0 + ai * 128 + m * 16) * NGATE + col) = w;
                    } else {
                        v4u w; w.x = pk2(v0[0], v0[1]); w.y = pk2(v0[2], v0[3]); w.z = pk2(v1[0], v1[1]); w.w = pk2(v1[2], v1[3]);
                        *(v4u*)(base + (size_t)(row0 + ai * 128 + m * 16) * ld + col) = w;
                    }
                }
        }
    }
};
struct EpiGates {
    static constexpr bool PERM = true, AFTER_DRAIN = false;
    unsigned char* GATES;
    DI void operator()(const f32x4 (&acc)[2][2][4][2], const Unit& u, int wr, int wc, int fr, int fq) const {
        asm volatile("" : "+v"(fr), "+v"(fq));
        const int row0 = u.pm * 256 + wr * 64 + fr;
#pragma unroll
        for (int bj = 0; bj < 2; ++bj) {
            const int col = u.pn * 256 + bj * 128 + wc * 32 + 8 * fq;
#pragma unroll
            for (int ai = 0; ai < 2; ++ai)
#pragma unroll
                for (int m = 0; m < 4; ++m) {
                    unsigned q[8];
#pragma unroll
                    for (int i = 0; i < 4; ++i) { q[i] = (unsigned)(sigmoidf_(acc[ai][bj][m][0][i] * 0.03125f) * 255.0f + 0.5f); q[4 + i] = (unsigned)(sigmoidf_(acc[ai][bj][m][1][i] * 0.03125f) * 255.0f + 0.5f); }
                    v2u w; w.x = q[0] | (q[1] << 8) | (q[2] << 16) | (q[3] << 24); w.y = q[4] | (q[5] << 8) | (q[6] << 16) | (q[7] << 24);
                    *(v2u*)(GATES + (size_t)(row0 + ai * 128 + m * 16) * NGATE + col) = w;
                }
        }
    }
};
struct EpiLoraZ {
    static constexpr bool PERM = true, AFTER_DRAIN = false;
    bf16* Gout; f16* AW; const float* lbias;
    DI void operator()(const f32x4 (&acc)[2][2][4][2], const Unit& u, int wr, int wc, int fr, int fq) const {
        const int row0 = u.pm * 256 + wr * 64 + fr;
        if (u.pn < 2) {
#pragma unroll
            for (int bj = 0; bj < 2; ++bj)
#pragma unroll
                for (int ai = 0; ai < 2; ++ai)
#pragma unroll
                    for (int m = 0; m < 4; ++m) {
                        const f32x4 v0 = acc[ai][bj][m][0], v1 = acc[ai][bj][m][1];
                        v4u w; w.x = pk2(v0[0], v0[1]); w.y = pk2(v0[2], v0[3]); w.z = pk2(v1[0], v1[1]); w.w = pk2(v1[2], v1[3]);
                        *(v4u*)(Gout + (size_t)(row0 + ai * 128 + m * 16) * 512 + u.pn * 256 + bj * 128 + wc * 32 + 8 * fq) = w;
                    }
        } else {
            const int q = u.pn - 2, grp = q >> 2, half = (q >> 1) & 1, cc = (q & 1) * 256 + wc * 32 + 8 * fq;
            f16* dst = (f16*)((unsigned char*)AW + (size_t)((grp == 0 ? 2 : 0) + half) * OUT_AW);
            const float* bias = lbias + (grp * 2 + half) * 512 + cc;
            const float dsc = -DECAY_SCALE * 1.4426950408889634f;
#pragma unroll
            for (int bj = 0; bj < 2; ++bj) {
                const f32x4 b0 = *(const f32x4*)(bias + bj * 128), b1 = *(const f32x4*)(bias + bj * 128 + 4);
#pragma unroll
                for (int ai = 0; ai < 2; ++ai)
#pragma unroll
                    for (int m = 0; m < 4; ++m) {
                        f32x4 v0 = acc[ai][bj][m][0] + b0, v1 = acc[ai][bj][m][1] + b1;
                        asm volatile("" : "+v"(v0), "+v"(v1));
                        f16x8 h;
#pragma unroll
                        for (int i = 0; i < 4; ++i) {
                            float s0 = sigmoidf_(v0[i]), s1 = sigmoidf_(v1[i]);
                            if (grp == 0) { s0 = __builtin_amdgcn_exp2f(dsc * s0); s1 = __builtin_amdgcn_exp2f(dsc * s1); }
                            h[i] = (f16)s0; h[4 + i] = (f16)s1;
                        }
                        *(f16x8*)(dst + (size_t)(row0 + ai * 128 + m * 16) * 512 + cc + bj * 128) = h;
                    }
            }
        }
    }
};
struct EpiMerge2 {
    static constexpr bool PERM = true, AFTER_DRAIN = false;
    bf16* MG; const unsigned char* GATES;
#define EPI_MEMBAR asm volatile("" ::: "memory")
    DI void mid(f32x4 (&acc)[2][2][4][2], const Unit& u, int wr, int wc, int fr, int fq) const {
        const int row0 = u.pm * 256 + wr * 64 + fr;
        v2u gr[2][2][4], ga[2][2][4];
#pragma unroll
        for (int bj = 0; bj < 2; ++bj) {
            const int col = u.pn * 256 + bj * 128 + wc * 32 + 8 * fq;
#pragma unroll
            for (int ai = 0; ai < 2; ++ai)
#pragma unroll
                for (int m = 0; m < 4; ++m) {
                    const size_t row = (size_t)(row0 + ai * 128 + m * 16);
                    gr[bj][ai][m] = *(const v2u*)(GATES + row * NGATE + col); ga[bj][ai][m] = *(const v2u*)(GATES + row * NGATE + 1024 + col);
                }
        }
        EPI_MEMBAR;
#pragma unroll
        for (int bj = 0; bj < 2; ++bj)
#pragma unroll
            for (int ai = 0; ai < 2; ++ai)
#pragma unroll
                for (int m = 0; m < 4; ++m) {
                    const unsigned grw[2] = {gr[bj][ai][m].x, gr[bj][ai][m].y}, gaw[2] = {ga[bj][ai][m].x, ga[bj][ai][m].y};
#pragma unroll
                    for (int n = 0; n < 2; ++n)
#pragma unroll
                        for (int i = 0; i < 4; ++i) {
                            const float fr_ = (float)((grw[n] >> (8 * i)) & 0xffu), fa_ = fmaxf((float)((gaw[n] >> (8 * i)) & 0xffu), 0.25f);
                            acc[ai][bj][m][n][i] *= fr_ * __builtin_amdgcn_rcpf(fa_);
                        }
                }
    }
    DI void operator()(const f32x4 (&acc)[2][2][4][2], const Unit& u, int wr, int wc, int fr, int fq) const {
        const int row0 = u.pm * 256 + wr * 64 + fr;
        v2u ga[2][2][4];
#pragma unroll
        for (int bj = 0; bj < 2; ++bj) {
            const int col = u.pn * 256 + bj * 128 + wc * 32 + 8 * fq;
#pragma unroll
            for (int ai = 0; ai < 2; ++ai)
#pragma unroll
                for (int m = 0; m < 4; ++m) ga[bj][ai][m] = *(const v2u*)(GATES + (size_t)(row0 + ai * 128 + m * 16) * NGATE + 1024 + col);
        }
        EPI_MEMBAR;
#pragma unroll
        for (int bj = 0; bj < 2; ++bj) {
            const int col = u.pn * 256 + bj * 128 + wc * 32 + 8 * fq;
#pragma unroll
            for (int ai = 0; ai < 2; ++ai)
#pragma unroll
                for (int m = 0; m < 4; ++m) {
                    const size_t row = (size_t)(row0 + ai * 128 + m * 16);
                    const unsigned gaw[2] = {ga[bj][ai][m].x, ga[bj][ai][m].y};
                    float o[8];
#pragma unroll
                    for (int n = 0; n < 2; ++n)
#pragma unroll
                        for (int i = 0; i < 4; ++i) o[4 * n + i] = acc[ai][bj][m][n][i] * (fmaxf((float)((gaw[n] >> (8 * i)) & 0xffu), 0.25f) * (1.0f / 255.0f));
                    v4u w; w.x = pk2(o[0], o[1]); w.y = pk2(o[2], o[3]); w.z = pk2(o[4], o[5]); w.w = pk2(o[6], o[7]);
                    *(v4u*)(MG + row * D + col) = w;
                }
        }
    }
};
struct EpiResid {
    static constexpr bool PERM = true, AFTER_DRAIN = false;
    const float* X; bf16* O;
    DI void operator()(const f32x4 (&acc)[2][2][4][2], const Unit& u, int wr, int wc, int fr, int fq) const {
        const int row0 = u.pm * 256 + wr * 64 + fr, col0 = u.pn * 256 + wc * 32 + 8 * fq;
        f32x4 xa[2][2][2], xb[2][2][2];
#define EPIR_LOAD(xv, b) do { _Pragma("unroll") for (int mm = 0; mm < 2; ++mm) { const size_t off = (size_t)(row0 + ((b) >> 1) * 128 + (((b) & 1) * 2 + mm) * 16) * D + col0; \
            _Pragma("unroll") for (int bj = 0; bj < 2; ++bj) { xv[mm][bj][0] = *(const f32x4*)(X + off + bj * 128); xv[mm][bj][1] = *(const f32x4*)(X + off + bj * 128 + 4); } } } while (0)
#define EPIR_PROC(xv, b) do { _Pragma("unroll") for (int mm = 0; mm < 2; ++mm) { const int ai = (b) >> 1, m = ((b) & 1) * 2 + mm; const size_t off = (size_t)(row0 + ai * 128 + m * 16) * D + col0; \
            _Pragma("unroll") for (int bj = 0; bj < 2; ++bj) { const f32x4 v0 = xv[mm][bj][0] + acc[ai][bj][m][0], v1 = xv[mm][bj][1] + acc[ai][bj][m][1]; \
                v4u w; w.x = pk2(v0[0], v0[1]); w.y = pk2(v0[2], v0[3]); w.z = pk2(v1[0], v1[1]); w.w = pk2(v1[2], v1[3]); *(v4u*)(O + off + bj * 128) = w; } } } while (0)
        EPIR_LOAD(xa, 0); EPIR_LOAD(xb, 1); EPI_MEMBAR;
        EPIR_PROC(xa, 0); EPI_MEMBAR; EPIR_LOAD(xa, 2); EPI_MEMBAR;
        EPIR_PROC(xb, 1); EPI_MEMBAR; EPIR_LOAD(xb, 3); EPI_MEMBAR;
        EPIR_PROC(xa, 2); EPI_MEMBAR;
        EPIR_PROC(xb, 3);
#undef EPIR_LOAD
#undef EPIR_PROC
    }
};
struct EpiSwiglu {
    static constexpr bool PERM = true, AFTER_DRAIN = false;
    unsigned char* HID;
    DI void operator()(const f32x4 (&acc)[2][2][4][2], const Unit& u, int wr, int wc, int fr, int fq) const {
        asm volatile("" : "+v"(fr), "+v"(fq));
        const int row0 = u.pm * 256 + wr * 64 + fr, col = u.pn * 128 + wc * 32 + 8 * fq;
#pragma unroll
        for (int ai = 0; ai < 2; ++ai)
#pragma unroll
            for (int m = 0; m < 4; ++m) {
                float o[8];
#pragma unroll
                for (int n = 0; n < 2; ++n)
#pragma unroll
                    for (int i = 0; i < 4; ++i) { const float gt = acc[ai][0][m][n][i] * 0.03125f, up = acc[ai][1][m][n][i] * 0.03125f; o[4 * n + i] = gt * sigmoidf_(gt) * up; }
                v2u w; w.x = pk4_fp8(o[0], o[1], o[2], o[3]); w.y = pk4_fp8(o[4], o[5], o[6], o[7]);
                *(v2u*)(HID + (size_t)(row0 + ai * 128 + m * 16) * FF + col) = w;
            }
    }
};
struct EpiYs {
    static constexpr bool PERM = true, AFTER_DRAIN = false;
    bf16* YS; const float* VAL;
    DI void operator()(const f32x4 (&acc)[2][2][4][2], const Unit& u, int wr, int wc, int fr, int fq) const {
        asm volatile("" : "+v"(fr), "+v"(fq));
        const int row0 = u.pm * 256 + wr * 64 + fr;
        float svv[2][4];
#pragma unroll
        for (int ai = 0; ai < 2; ++ai)
#pragma unroll
            for (int m = 0; m < 4; ++m) svv[ai][m] = VAL[(size_t)(row0 + ai * 128 + m * 16)];
        EPI_MEMBAR;
#pragma unroll
        for (int ai = 0; ai < 2; ++ai)
#pragma unroll
            for (int m = 0; m < 4; ++m) {
                const size_t row = (size_t)(row0 + ai * 128 + m * 16);
                const float sv = svv[ai][m] * 0.03125f;
#pragma unroll
                for (int bj = 0; bj < 2; ++bj) {
                    const int col = u.pn * 256 + bj * 128 + wc * 32 + 8 * fq;
                    const f32x4 v0 = acc[ai][bj][m][0] * sv, v1 = acc[ai][bj][m][1] * sv;
                    v4u w; w.x = pk2(v0[0], v0[1]); w.y = pk2(v0[2], v0[3]); w.z = pk2(v1[0], v1[1]); w.w = pk2(v1[2], v1[3]);
                    *(v4u*)(YS + row * D + col) = w;
                }
            }
    }
};

DI void phaseP1(const DArgs& a, LAS unsigned char* lds, int own) {
    const int tid = threadIdx.x, lane = tid & 63, wave = __builtin_amdgcn_readfirstlane(tid >> 6);
    unsigned char* ws = a.ws;
    const bf16* UR = (const bf16*)(ws + WS_UR);
    f16* RKV = (f16*)(ws + WS_RKV); bf16* AP = (bf16*)(ws + WS_AP);
    float mp[4][8], mn[4][8], kc[8];
#pragma unroll
    for (int i = 0; i < 4; ++i) { const int cidx = lane + 64 * i; const int col = (cidx < RC / 8 ? cidx : 0) * 8;
#pragma unroll
        for (int j = 0; j < 8; ++j) { mp[i][j] = a.in[I_MUP][col + j]; mn[i][j] = a.in[I_MUN][col + j]; } }
#pragma unroll
    for (int j = 0; j < 8; ++j) kc[j] = a.in[I_KK][lane * 8 + j];
    const bool act3 = lane + 192 < RC / 8;
#define P1_LOADROW(dst, rowp) do { _Pragma("unroll") for (int i_ = 0; i_ < 4; ++i_) { if (i_ < 3 || act3) dst[i_] = *(const v4u*)((rowp) + (lane + 64 * i_) * 8); else dst[i_] = (v4u){0u, 0u, 0u, 0u}; } } while (0)
    { const int r0 = own * 256 + wave * 32;
        const int t0 = r0 & (T - 1);
        const bf16* rp = UR + (size_t)r0 * RC;
        v4u prev[4], cur[4], nxt[4], nn[4];
        if (t0 > 0) P1_LOADROW(prev, rp - RC); else { _Pragma("unroll") for (int i = 0; i < 4; ++i) prev[i] = (v4u){0u, 0u, 0u, 0u}; }
        P1_LOADROW(cur, rp); P1_LOADROW(nxt, rp + RC);
#pragma unroll 1
        for (int r = 0; r < 32; ++r) {
            const int m = r0 + r, t = t0 + r;
            if (t + 2 < T) P1_LOADROW(nn, rp + (size_t)(r + 2) * RC); else { _Pragma("unroll") for (int i = 0; i < 4; ++i) nn[i] = (v4u){0u, 0u, 0u, 0u}; }
#pragma unroll
            for (int i = 0; i < 4; ++i) {
                if (i < 3 || act3) {
                    const int col = (lane + 64 * i) * 8;
                    float o[8];
                    const unsigned ucw[4] = {cur[i].x, cur[i].y, cur[i].z, cur[i].w}, upw[4] = {prev[i].x, prev[i].y, prev[i].z, prev[i].w}, unw[4] = {nxt[i].x, nxt[i].y, nxt[i].z, nxt[i].w};
#pragma unroll
                    for (int j = 0; j < 4; ++j) {
                        const float c0 = bflo(ucw[j]), c1 = bfhi(ucw[j]), p0 = bflo(upw[j]), p1 = bfhi(upw[j]), n0 = bflo(unw[j]), n1 = bfhi(unw[j]);
                        o[2 * j] = c0 + mp[i][2 * j] * (p0 - c0) + mn[i][2 * j] * (n0 - c0);
                        o[2 * j + 1] = c1 + mp[i][2 * j + 1] * (p1 - c1) + mn[i][2 * j + 1] * (n1 - c1);
                    }
                    if (i == 1) {
                        float ssq = 0.f;
#pragma unroll
                        for (int j = 0; j < 8; ++j) { const float e0 = o[j] * kc[j]; ssq += e0 * e0; }
                        ssq += __shfl_xor(ssq, 1); ssq += __shfl_xor(ssq, 2); ssq += __shfl_xor(ssq, 4);
                        if ((lane & 7) == 0) ((float*)(ws + WS_KN))[(size_t)m * 8 + (lane >> 3)] = 1.0f / fmaxf(sqrtf(ssq), 1e-12f);
                    }
                    if (i < 3) {
                        f16x8 h;
#pragma unroll
                        for (int j = 0; j < 8; ++j) h[j] = (f16)o[j];
                        *(f16x8*)(RKV + (size_t)i * ((size_t)M * 512) + (size_t)m * 512 + lane * 8) = h;
                    } else {
                        const int ac = lane * 8;
                        if (ac < 128) {
#pragma unroll
                            for (int j = 0; j < 8; ++j) o[j] = sigmoidf_(o[j]);
                        } else if (ac < 256) {
#pragma unroll
                            for (int j = 0; j < 8; ++j) o[j] = tanhf(o[j]);
                        }
                        v4u w; w.x = pk2(o[0], o[1]); w.y = pk2(o[2], o[3]); w.z = pk2(o[4], o[5]); w.w = pk2(o[6], o[7]);
                        *(v4u*)(AP + (size_t)m * NLK + ac) = w;
                    }
                }
            }
#pragma unroll
            for (int i = 0; i < 4; ++i) { prev[i] = cur[i]; cur[i] = nxt[i]; nxt[i] = nn[i]; }
        }
    }
#undef P1_LOADROW
    {
        const bf16* QKV = (const bf16*)(ws + WS_QKV); bf16* VT = (bf16*)(ws + WS_VT);
        LAS bf16* tile = (LAS bf16*)lds;
        for (int tl = own * 4; tl < own * 4 + 4; ++tl) {
            const int m0 = tl * 64, b = m0 / T, t0 = m0 % T;
            __syncthreads();
#pragma unroll
            for (int i = 0; i < 2; ++i) { const int ch = tid + 512 * i, r = ch >> 4, c8 = (ch & 15) * 8;
                const v4u v = *(const v4u*)(QKV + (size_t)(m0 + r) * NQKV + 640 + c8);
                *(LAS v4u*)(tile + r * 136 + c8) = v; }
            __syncthreads();
#pragma unroll
            for (int i = 0; i < 2; ++i) { const int ch = tid + 512 * i, dcol = ch >> 3, tq = (ch & 7) * 8;
                unsigned short e[8];
#pragma unroll
                for (int j = 0; j < 8; ++j) e[j] = tile[(tq + j) * 136 + dcol];
                v4u w; w.x = e[0] | ((unsigned)e[1] << 16); w.y = e[2] | ((unsigned)e[3] << 16); w.z = e[4] | ((unsigned)e[5] << 16); w.w = e[6] | ((unsigned)e[7] << 16);
                *(v4u*)(VT + ((size_t)(b * 2 + (dcol >> 6)) * 64 + (dcol & 63)) * T + t0 + tq) = w; }
        }
        __syncthreads();
    }
}

DI f32x16 mfma32(const bf16x8 a, const bf16x8 b, const f32x16 c) { return __builtin_amdgcn_mfma_f32_32x32x16_bf16(a, b, c, 0, 0, 0); }
DI bf16x8 packlo(const f32x16& x) { v4u p; p.x = pk2(x[0], x[1]); p.y = pk2(x[2], x[3]); p.z = pk2(x[4], x[5]); p.w = pk2(x[6], x[7]); return __builtin_bit_cast(bf16x8, p); }
DI bf16x8 packhi(const f32x16& x) { v4u p; p.x = pk2(x[8], x[9]); p.y = pk2(x[10], x[11]); p.z = pk2(x[12], x[13]); p.w = pk2(x[14], x[15]); return __builtin_bit_cast(bf16x8, p); }
DI f32x16 zero16() { f32x16 z;
#pragma unroll
    for (int i = 0; i < 16; ++i) z[i] = 0.f;
    return z; }
DI int crow(int reg, int hh) { return (reg & 3) + 8 * (reg >> 2) + 4 * hh; }
DI bf16x8 ldperm(const LAS bf16* rowp, int ks, int hh) {
    const v2u lo = *(const LAS v2u*)(rowp + 16 * ks + 4 * hh), hi = *(const LAS v2u*)(rowp + 16 * ks + 8 + 4 * hh);
    v4u w; w.x = lo.x; w.y = lo.y; w.z = hi.x; w.w = hi.y; return __builtin_bit_cast(bf16x8, w);
}
#define SCAN_DEP(cv, val) asm volatile("" : "+v"(cv) : "v"(val))
constexpr int TJS = 72, JSS = 40;
constexpr int CH_TJ = 0, CH_JS = 18432, CH_JSB = 20480, CH_GL = CH_JS + 2 * CH_JSB, CH_FLAG = CH_GL + 512, CHAIN_LDS = CH_FLAG + 128;
DI int ld_flag(volatile LAS int* p) { return *p; }
constexpr int CH_RAW = CH_FLAG + 128, RAW_SLOT = 5 * 1024 + 256, CH_YT = CH_RAW + 2 * RAW_SLOT, YT_RS = 144, CHAIN_LDS2 = CH_YT + 32 * YT_RS;
DI void scan_dma_block(const DArgs& a, LAS unsigned char* slotp, int blk, int dir, size_t rowbase, int h, unsigned lane_off, unsigned lane_off_kn) {
    unsigned char* ws = a.ws;
    const int p0 = blk * 8, tl = dir ? T - 1 - p0 - 7 : p0;
#pragma unroll
    for (int arr = 0; arr < 5; ++arr) {
        const unsigned char* base = arr < 3 ? (const unsigned char*)(ws + WS_RKV) + (size_t)arr * ((size_t)M * 512 * 2)
                                            : (const unsigned char*)a.out + (size_t)((arr == 3 ? 0 : 2) + dir) * OUT_AW;
        const unsigned char* ub = base + ((rowbase + tl) * 512 + h * 64) * 2;
        __builtin_amdgcn_global_load_lds((const unsigned*)(ub + lane_off), (LAS unsigned*)(slotp + arr * 1024), 16, 0, 0);
    }
    { const unsigned char* ub = (const unsigned char*)(ws + WS_KN) + ((rowbase + tl) * 8 + h) * 4;
      __builtin_amdgcn_global_load_lds((const unsigned*)(ub + lane_off_kn), (LAS unsigned*)(slotp + 5 * 1024), 4, 0, 0); }
}
DI void scan_producer(const DArgs& a, LAS unsigned char* cl, int chain, int lane) {
    const int dir = chain & 1, h = (chain >> 1) & 7, b = chain >> 4;
    const size_t rowbase = (size_t)b * T;
    LAS bf16* Qh = (LAS bf16*)(cl + CH_TJ); LAS bf16* Rh = Qh + 32 * TJS; LAS bf16* Bc = Rh + 32 * TJS; LAS bf16* Kc = Bc + 32 * TJS;
    volatile LAS int* flag = (volatile LAS int*)(cl + CH_FLAG);
    const int chn = h * 64 + lane;
    const float kkc = a.in[I_KK][chn], kac = a.in[I_KA][chn];
    const unsigned lane_off = (unsigned)((dir ? 7 - (lane >> 3) : (lane >> 3)) * 1024 + (lane & 7) * 16);
    const unsigned lane_off_kn = (unsigned)((dir ? 7 - (lane & 7) : (lane & 7)) * 32);
    asm volatile("s_waitcnt vmcnt(0)" ::: "memory");
    scan_dma_block(a, cl + CH_RAW, 0, dir, rowbase, h, lane_off, lane_off_kn);
    scan_dma_block(a, cl + CH_RAW + RAW_SLOT, 1, dir, rowbase, h, lane_off, lane_off_kn);
    for (int chunk = 0; chunk < T / 32; ++chunk) {
        const int buf = chunk & 1;
        LAS bf16* QhT = (LAS bf16*)(cl + CH_JS + buf * CH_JSB); LAS bf16* BcT = QhT + 64 * JSS; LAS bf16* KcT = BcT + 64 * JSS; LAS bf16* VT = KcT + 64 * JSS;
        LAS float* GL = (LAS float*)(cl + CH_GL + buf * 256);
        while (ld_flag(flag + 1) < chunk || ld_flag(flag + 2) < chunk - 1) __builtin_amdgcn_s_sleep(2);
        asm volatile("" ::: "memory");
        float g = 1.f;
#pragma unroll 1
        for (int tb = 0; tb < 4; ++tb) {
            const int blk = chunk * 4 + tb;
            LAS unsigned char* slotp = cl + CH_RAW + (tb & 1) * RAW_SLOT;
            const LAS f16* RAW = (const LAS f16*)slotp; const LAS float* KNL = (const LAS float*)(slotp + 5 * 1024);
            if (blk + 1 < T / 8) asm volatile("s_waitcnt vmcnt(6)" ::: "memory"); else asm volatile("s_waitcnt vmcnt(0)" ::: "memory");
            unsigned qw[4], bw[4], kw[4], vw[4];
            f16 rraw[8], kraw[8], vraw[8], araw[8], wraw[8]; float knv[8];
#pragma unroll
            for (int u = 0; u < 8; ++u) { rraw[u] = RAW[0 * 512 + u * 64 + lane]; kraw[u] = RAW[1 * 512 + u * 64 + lane]; vraw[u] = RAW[2 * 512 + u * 64 + lane]; araw[u] = RAW[3 * 512 + u * 64 + lane]; wraw[u] = RAW[4 * 512 + u * 64 + lane]; }
            { const f32x4 k0_ = *(const LAS f32x4*)KNL, k1_ = *(const LAS f32x4*)(KNL + 4);
#pragma unroll
              for (int u = 0; u < 4; ++u) { knv[u] = k0_[u]; knv[4 + u] = k1_[u]; } }
            LDS_WAIT(); asm volatile("" ::: "memory");
            if (blk + 2 < T / 8) { unsigned lo1 = lane_off, lo2 = lane_off_kn; asm volatile("" : "+v"(lo1), "+v"(lo2));
                scan_dma_block(a, slotp, blk + 2, dir, rowbase, h, lo1, lo2); }
#pragma unroll
            for (int u2 = 0; u2 < 4; ++u2) {
                float qv[2], rv[2], bv[2], kv[2], vv[2];
#pragma unroll
                for (int e = 0; e < 2; ++e) {
                    const int u = 2 * u2 + e;
                    const float r = (float)rraw[u], k = (float)kraw[u], v = (float)vraw[u];
                    const float av = (float)araw[u], w = (float)wraw[u];
                    const float invn = knv[u];
                    const float gprev = g; g *= w; const float ginv = __builtin_amdgcn_rcpf(g);
                    const float kk = k * kkc * invn, kt = k * (1.0f + (av - 1.0f) * kac), bb = av * kk;
                    qv[e] = kk * gprev; rv[e] = r * g; bv[e] = bb * ginv; kv[e] = kt * ginv; vv[e] = v;
                }
                const int tau = 8 * tb + 2 * u2;
                const unsigned q2 = pk2(qv[0], qv[1]), r2 = pk2(rv[0], rv[1]), b2 = pk2(bv[0], bv[1]), k2 = pk2(kv[0], kv[1]);
                Qh[tau * TJS + lane] = (bf16)(q2 & 0xffffu); Qh[(tau + 1) * TJS + lane] = (bf16)(q2 >> 16);
                Rh[tau * TJS + lane] = (bf16)(r2 & 0xffffu); Rh[(tau + 1) * TJS + lane] = (bf16)(r2 >> 16);
                Bc[tau * TJS + lane] = (bf16)(b2 & 0xffffu); Bc[(tau + 1) * TJS + lane] = (bf16)(b2 >> 16);
                Kc[tau * TJS + lane] = (bf16)(k2 & 0xffffu); Kc[(tau + 1) * TJS + lane] = (bf16)(k2 >> 16);
                qw[u2] = q2 ^ 0x80008000u; bw[u2] = b2; kw[u2] = k2; vw[u2] = pk2(vv[0], vv[1]);
            }
            *(LAS v4u*)(QhT + lane * JSS + 8 * tb) = (v4u){qw[0], qw[1], qw[2], qw[3]};
            *(LAS v4u*)(BcT + lane * JSS + 8 * tb) = (v4u){bw[0], bw[1], bw[2], bw[3]};
            *(LAS v4u*)(KcT + lane * JSS + 8 * tb) = (v4u){kw[0], kw[1], kw[2], kw[3]};
            *(LAS v4u*)(VT + lane * JSS + 8 * tb) = (v4u){vw[0], vw[1], vw[2], vw[3]};
        }
        GL[lane] = g;
        LDS_WAIT(); asm volatile("" ::: "memory");
        if (lane == 0) flag[0] = chunk + 1;
        asm volatile("" ::: "memory");
    }
}
template <int DIR> DI void scan_consumer(const DArgs& a, LAS unsigned char* cl, int chain, int lane) {
    unsigned char* ws = a.ws;
    const int h = (chain >> 1) & 7, b = chain >> 4;
    const int c = lane & 31, hh = lane >> 5;
    const size_t rowbase = (size_t)b * T;
    const LAS bf16* Qh = (const LAS bf16*)(cl + CH_TJ); const LAS bf16* Rh = Qh + 32 * TJS; const LAS bf16* Bc = Rh + 32 * TJS; const LAS bf16* Kc = Bc + 32 * TJS;
    volatile LAS int* flag = (volatile LAS int*)(cl + CH_FLAG);
    f16* Y = (f16*)(ws + (DIR ? WS_YB : WS_YF));
    bf16x8 xs[2][2][2];
#pragma unroll
    for (int q = 0; q < 8; ++q) xs[q >> 2][(q >> 1) & 1][q & 1] = (bf16x8){0, 0, 0, 0, 0, 0, 0, 0};
    f32x16 eye;
#pragma unroll
    for (int i = 0; i < 16; ++i) eye[i] = (crow(i, hh) == c) ? 1.f : 0.f;
    LAS unsigned char* YT = cl + CH_YT;
    LAS unsigned char* ytw = YT + c * YT_RS + 8 * hh;
    const LAS unsigned char* ytr = YT + (lane >> 3) * YT_RS + (lane & 7) * 16;
    f16* ybase = Y + (rowbase + (DIR ? T - 1 - (lane >> 3) : (lane >> 3))) * 512 + h * 64 + (lane & 7) * 8;
    for (int chunk = 0; chunk < T / 32; ++chunk) {
        const int buf = chunk & 1;
        const LAS bf16* QhT = (const LAS bf16*)(cl + CH_JS + buf * CH_JSB); const LAS bf16* BcT = QhT + 64 * JSS; const LAS bf16* KcT = BcT + 64 * JSS; const LAS bf16* VT = KcT + 64 * JSS;
        const LAS float* GL = (const LAS float*)(cl + CH_GL + buf * 256);
        while (ld_flag(flag) < chunk + 1) __builtin_amdgcn_s_sleep(1);
        asm volatile("" ::: "memory");
        f32x16 nN = zero16(), nT = zero16(), akT = zero16(), rbT = zero16(), rkT = zero16();
        v2u rhc[2][4];
        {
            bf16x8 fq[4], fb[4], fk[4], fr[4];
#pragma unroll
            for (int ks = 0; ks < 4; ++ks) {
                fq[ks] = *(const LAS bf16x8*)(Qh + c * TJS + 16 * ks + 8 * hh); fb[ks] = *(const LAS bf16x8*)(Bc + c * TJS + 16 * ks + 8 * hh);
                fk[ks] = *(const LAS bf16x8*)(Kc + c * TJS + 16 * ks + 8 * hh); fr[ks] = *(const LAS bf16x8*)(Rh + c * TJS + 16 * ks + 8 * hh);
            }
#pragma unroll
            for (int jb = 0; jb < 2; ++jb)
#pragma unroll
                for (int g4 = 0; g4 < 4; ++g4) rhc[jb][g4] = *(const LAS v2u*)(Rh + c * TJS + 32 * jb + 8 * g4 + 4 * hh);
            v4u yq[4];
            if (chunk > 0) {
#pragma unroll
                for (int j = 0; j < 4; ++j) yq[j] = *(const LAS v4u*)(ytr + 8 * j * YT_RS);
            }
            LDS_WAIT(); asm volatile("" ::: "memory");
            if (lane == 0) flag[1] = chunk + 1;
            asm volatile("" ::: "memory");
            if (chunk > 0) {
                f16* yp = ybase + (DIR ? -((chunk - 1) * 32 * 512) : (chunk - 1) * 32 * 512);
#pragma unroll
                for (int j = 0; j < 4; ++j) *(v4u*)(yp + (DIR ? -(8 * j * 512) : 8 * j * 512)) = yq[j];
            }
#pragma unroll
            for (int ks = 0; ks < 4; ++ks) {
                nN = mfma32(fq[ks], fb[ks], nN); nT = mfma32(fb[ks], fq[ks], nT); akT = mfma32(fk[ks], fq[ks], akT); rbT = mfma32(fb[ks], fr[ks], rbT); rkT = mfma32(fk[ks], fr[ks], rkT);
            }
        }
        __builtin_amdgcn_sched_barrier(0);
        f32x16 TT;
#pragma unroll
        for (int i = 0; i < 16; ++i) { const int rw = crow(i, hh);
            nN[i] = (c < rw) ? nN[i] : 0.f; nT[i] = (rw < c) ? nT[i] : 0.f; akT[i] = (rw < c) ? -akT[i] : 0.f;
            rbT[i] = (rw <= c) ? rbT[i] : 0.f; rkT[i] = (rw <= c) ? rkT[i] : 0.f; TT[i] = eye[i] - nT[i]; }
        bf16x8 pN0 = packlo(nN), pN1 = packhi(nN), pNT0 = packlo(nT), pNT1 = packhi(nT);
        const bf16x8 pAK0 = packlo(akT), pAK1 = packhi(akT), pRB0 = packlo(rbT), pRB1 = packhi(rbT), pRK0 = packlo(rkT), pRK1 = packhi(rkT);
        __builtin_amdgcn_sched_barrier(0);
#pragma unroll
        for (int lvl = 1; lvl <= 4; ++lvl) {
            f32x16 n2 = mfma32(pNT0, pN0, zero16()); n2 = mfma32(pNT1, pN1, n2);
            if (lvl < 4) { f32x16 n2T = mfma32(pN0, pNT0, zero16()); n2T = mfma32(pN1, pNT1, n2T); pNT0 = packlo(n2T); pNT1 = packhi(n2T); }
            pN0 = packlo(n2); pN1 = packhi(n2);
            const bf16x8 pT0 = packlo(TT), pT1 = packhi(TT);
            TT = mfma32(pN0, pT0, TT); TT = mfma32(pN1, pT1, TT);
            __builtin_amdgcn_sched_barrier(0);
        }
        const bf16x8 pTT0 = packlo(TT), pTT1 = packhi(TT);
        __builtin_amdgcn_sched_barrier(0);
        bf16x8 pQ[2][2];
        int cq = c; SCAN_DEP(cq, TT[15]);
        float depq = 0.f;
#pragma unroll
        for (int jt = 0; jt < 2; ++jt) {
            f32x16 acc = mfma32(pTT0, ldperm(QhT + (32 * jt + cq) * JSS, 0, hh), zero16());
            acc = mfma32(pTT1, ldperm(QhT + (32 * jt + cq) * JSS, 1, hh), acc);
            pQ[jt][0] = packlo(acc); pQ[jt][1] = packhi(acc); depq = acc[15];
        }
        __builtin_amdgcn_sched_barrier(0);
        bf16x8 vtp[2][2];
        int cv = c; SCAN_DEP(cv, depq);
#pragma unroll
        for (int it = 0; it < 2; ++it) { vtp[it][0] = ldperm(VT + (32 * it + cv) * JSS, 0, hh); vtp[it][1] = ldperm(VT + (32 * it + cv) * JSS, 1, hh); }
        bf16x8 pU[2][2]; float depu = 0.f;
#pragma unroll
        for (int it = 0; it < 2; ++it) {
            f32x16 w1 = mfma32(pAK0, vtp[it][0], zero16()); w1 = mfma32(pAK1, vtp[it][1], w1);
            const bf16x8 pw0 = packlo(w1), pw1 = packhi(w1);
            f32x16 u0 = mfma32(pTT0, pw0, zero16()); u0 = mfma32(pTT1, pw1, u0);
            pU[it][0] = packlo(u0); pU[it][1] = packhi(u0); depu = u0[15];
            __builtin_amdgcn_sched_barrier(0);
        }
        bf16x8 pR[2][2]; float depr = 0.f;
#pragma unroll
        for (int jb = 0; jb < 2; ++jb) {
            f32x16 rt;
#pragma unroll
            for (int g4 = 0; g4 < 4; ++g4) { const v2u rr = rhc[jb][g4]; rt[4 * g4] = bflo(rr.x); rt[4 * g4 + 1] = bfhi(rr.x); rt[4 * g4 + 2] = bflo(rr.y); rt[4 * g4 + 3] = bfhi(rr.y); }
            rt = mfma32(pQ[jb][0], pRB0, rt); rt = mfma32(pQ[jb][1], pRB1, rt);
            pR[jb][0] = packlo(rt); pR[jb][1] = packhi(rt); depr = rt[15];
            __builtin_amdgcn_sched_barrier(0);
        }
        bf16x8 pP[2][2][2]; float depp = 0.f;
        bf16x8 bcp[2][2];
        {
            int cp = c; SCAN_DEP(cp, depr);
#pragma unroll
            for (int jb = 0; jb < 2; ++jb) { bcp[jb][0] = ldperm(BcT + (32 * jb + cp) * JSS, 0, hh); bcp[jb][1] = ldperm(BcT + (32 * jb + cp) * JSS, 1, hh); }
#pragma unroll
            for (int jb = 0; jb < 2; ++jb)
#pragma unroll
                for (int jpb = 0; jpb < 2; ++jpb) {
                    f32x16 m = mfma32(pQ[jb][0], bcp[jpb][0], jb == jpb ? eye : zero16()); m = mfma32(pQ[jb][1], bcp[jpb][1], m);
                    pP[jb][jpb][0] = packlo(m); pP[jb][jpb][1] = packhi(m); depp = m[15];
                    __builtin_amdgcn_sched_barrier(0);
                }
        }
#pragma unroll
        for (int ib = 0; ib < 2; ++ib) {
            const bf16x8 x0l = xs[ib][0][0], x0h = xs[ib][0][1], x1l = xs[ib][1][0], x1h = xs[ib][1][1];
            {
                f32x16 y = mfma32(pU[ib][0], pRB0, zero16()); y = mfma32(pU[ib][1], pRB1, y);
                y = mfma32(vtp[ib][0], pRK0, y); y = mfma32(vtp[ib][1], pRK1, y);
                y = mfma32(x0l, pR[0][0], y); y = mfma32(x0h, pR[0][1], y);
                y = mfma32(x1l, pR[1][0], y); y = mfma32(x1h, pR[1][1], y);
#pragma unroll
                for (int g4 = 0; g4 < 4; ++g4) { const f16x4 hv = {(f16)y[4 * g4], (f16)y[4 * g4 + 1], (f16)y[4 * g4 + 2], (f16)y[4 * g4 + 3]}; *(LAS f16x4*)(ytw + 64 * ib + 16 * g4) = hv; }
                __builtin_amdgcn_sched_barrier(0);
            }
            f32x16 accn[2];
#pragma unroll
            for (int jpb = 0; jpb < 2; ++jpb) {
                int ch2 = c, hh2 = hh; SCAN_DEP(ch2, depp); SCAN_DEP(hh2, depp);
                f32x16 acc = mfma32(bcp[jpb][0], pU[ib][0], zero16()); acc = mfma32(bcp[jpb][1], pU[ib][1], acc);
                acc = mfma32(ldperm(KcT + (32 * jpb + ch2) * JSS, 0, hh2), vtp[ib][0], acc); acc = mfma32(ldperm(KcT + (32 * jpb + ch2) * JSS, 1, hh2), vtp[ib][1], acc);
                acc = mfma32(pP[0][jpb][0], x0l, acc); acc = mfma32(pP[0][jpb][1], x0h, acc);
                acc = mfma32(pP[1][jpb][0], x1l, acc); acc = mfma32(pP[1][jpb][1], x1h, acc);
#pragma unroll
                for (int g4 = 0; g4 < 4; ++g4) { const f32x4 gl = *(const LAS f32x4*)(GL + 32 * jpb + 8 * g4 + 4 * hh2);
                    acc[4 * g4] *= gl[0]; acc[4 * g4 + 1] *= gl[1]; acc[4 * g4 + 2] *= gl[2]; acc[4 * g4 + 3] *= gl[3]; }
                accn[jpb] = acc; depp = acc[15];
                __builtin_amdgcn_sched_barrier(0);
            }
            xs[ib][0][0] = packlo(accn[0]); xs[ib][0][1] = packhi(accn[0]); xs[ib][1][0] = packlo(accn[1]); xs[ib][1][1] = packhi(accn[1]);
        }
        LDS_WAIT(); asm volatile("" ::: "memory");
        if (lane == 0) flag[2] = chunk + 1;
        asm volatile("" ::: "memory");
    }
    {
        v4u yq[4];
#pragma unroll
        for (int j = 0; j < 4; ++j) yq[j] = *(const LAS v4u*)(ytr + 8 * j * YT_RS);
        LDS_WAIT();
        f16* yp = ybase + (DIR ? -((T / 32 - 1) * 32 * 512) : (T / 32 - 1) * 32 * 512);
#pragma unroll
        for (int j = 0; j < 4; ++j) *(v4u*)(yp + (DIR ? -(8 * j * 512) : 8 * j * 512)) = yq[j];
    }
}
DI void phaseScan(const DArgs& a, LAS unsigned char* lds, int G, int vcu, int wave, int lane) {
    const int slot = wave & 1;
    LAS unsigned char* cl = lds + slot * CHAIN_LDS2;
    for (int chain = vcu * 2 + slot; chain < NB * NH * 2; chain += G * 2) {
        if (wave < 2) { __builtin_amdgcn_s_setprio(3); if (chain & 1) scan_consumer<1>(a, cl, chain, lane); else scan_consumer<0>(a, cl, chain, lane); __builtin_amdgcn_s_setprio(0); }
        else { __builtin_amdgcn_s_setprio(2); scan_producer(a, cl, chain, lane); __builtin_amdgcn_s_setprio(0); }
    }
}

DI void phaseAttn(const DArgs& a, LAS int* qctr, int vcu, int lane) {
    unsigned char* ws = a.ws;
    bf16* QKV = (bf16*)(ws + WS_QKV); const bf16* VT = (const bf16*)(ws + WS_VT);
    const int r32 = lane & 31, hh = lane >> 5;
    for (;;) {
        int idx = 0;
        if (lane == 0) idx = __hip_atomic_fetch_add(qctr, 1, __ATOMIC_RELAXED, __HIP_MEMORY_SCOPE_WORKGROUP);
        idx = __builtin_amdgcn_readfirstlane(idx);
        if (idx >= 64) break;
        const int unit = vcu * 64 + idx;
        const int qt = unit & 63, hq = (unit >> 6) & 7, b = unit >> 9, kvh = hq >> 2, q0 = qt * 32;
        const float slope = exp2f(-(float)(hq + 1)), sink = a.in[I_SINK][hq];
        const size_t rowb = (size_t)b * T;
        bf16x8 qf[4];
        { const bf16* qp = QKV + (rowb + q0 + r32) * NQKV + hq * 64 + 8 * hh;
#pragma unroll
          for (int s = 0; s < 4; ++s) qf[s] = *(const bf16x8*)(qp + 16 * s); }
        float mrun = sink, lrun = 0.f;
        f32x16 o0, o1;
#pragma unroll
        for (int i = 0; i < 16; ++i) { o0[i] = 0.f; o1[i] = 0.f; }
        const int tq = q0 + r32;
        for (int kt = 0; kt < 9; ++kt) {
            const int k0 = q0 - 128 + 32 * kt;
            if (k0 < 0 || k0 >= T) continue;
            f32x16 st;
#pragma unroll
            for (int i = 0; i < 16; ++i) st[i] = 0.f;
            v2u vlo[2][2], vhi[2][2];
#pragma unroll
            for (int s = 0; s < 2; ++s)
#pragma unroll
                for (int db = 0; db < 2; ++db) { const bf16* vp = VT + ((size_t)(b * 2 + kvh) * 64 + 32 * db + r32) * T + k0 + 16 * s + 4 * hh; vlo[s][db] = *(const v2u*)vp; vhi[s][db] = *(const v2u*)(vp + 8); }
            asm volatile("" ::: "memory");
            { const bf16* kp = QKV + (rowb + k0 + r32) * NQKV + 512 + kvh * 64 + 8 * hh;
#pragma unroll
              for (int s = 0; s < 4; ++s) { const bf16x8 kf = *(const bf16x8*)(kp + 16 * s); st = __builtin_amdgcn_mfma_f32_32x32x16_bf16(kf, qf[s], st, 0, 0, 0); } }
            float tmax = -1e30f;
            if (kt == 0 || kt == 4 || kt == 8) {
#pragma unroll
                for (int i = 0; i < 16; ++i) { const int sk = k0 + crow(i, hh); int dd = sk - tq; dd = dd < 0 ? -dd : dd;
                    const float sc = (dd <= 128) ? st[i] - slope * (float)dd : -1e30f; st[i] = sc; tmax = fmaxf(tmax, sc); }
            } else {
                const float sg = kt < 4 ? slope : -slope;
                const float b0 = sg * (float)(k0 + 4 * hh - tq);
#pragma unroll
                for (int i = 0; i < 16; ++i) { const float sc = st[i] + fmaf(sg, (float)crow(i, 0), b0); st[i] = sc; tmax = fmaxf(tmax, sc); }
            }
            tmax = fmaxf(tmax, __shfl_xor(tmax, 32));
            const float mnew = fmaxf(mrun, tmax), alpha = __expf(mrun - mnew);
            mrun = mnew;
            float ps = 0.f;
#pragma unroll
            for (int i = 0; i < 16; ++i) { const float p = __expf(st[i] - mnew); st[i] = p; ps += p; }
            lrun = lrun * alpha + ps;
#pragma unroll
            for (int i = 0; i < 16; ++i) { o0[i] *= alpha; o1[i] *= alpha; }
#pragma unroll
            for (int s = 0; s < 2; ++s) {
                v4u pw; pw.x = pk2(st[8 * s], st[8 * s + 1]); pw.y = pk2(st[8 * s + 2], st[8 * s + 3]); pw.z = pk2(st[8 * s + 4], st[8 * s + 5]); pw.w = pk2(st[8 * s + 6], st[8 * s + 7]);
                const bf16x8 pf = __builtin_bit_cast(bf16x8, pw);
#pragma unroll
                for (int db = 0; db < 2; ++db) {
                    const v2u lo = vlo[s][db], hi = vhi[s][db];
                    v4u vw; vw.x = lo.x; vw.y = lo.y; vw.z = hi.x; vw.w = hi.y;
                    const bf16x8 vf = __builtin_bit_cast(bf16x8, vw);
                    if (db == 0) o0 = __builtin_amdgcn_mfma_f32_32x32x16_bf16(vf, pf, o0, 0, 0, 0);
                    else o1 = __builtin_amdgcn_mfma_f32_32x32x16_bf16(vf, pf, o1, 0, 0, 0);
                }
            }
        }
        const float ltot = lrun + __shfl_xor(lrun, 32);
        const float inv = 1.0f / (ltot + __expf(sink - mrun));
        bf16* op = QKV + (rowb + q0 + r32) * NQKV + hq * 64;
#pragma unroll
        for (int g4 = 0; g4 < 4; ++g4) {
            v2u w0, w1;
            w0.x = pk2(o0[4 * g4] * inv, o0[4 * g4 + 1] * inv); w0.y = pk2(o0[4 * g4 + 2] * inv, o0[4 * g4 + 3] * inv);
            w1.x = pk2(o1[4 * g4] * inv, o1[4 * g4 + 1] * inv); w1.y = pk2(o1[4 * g4 + 2] * inv, o1[4 * g4 + 3] * inv);
            *(v2u*)(op + 8 * g4 + 4 * hh) = w0;
            *(v2u*)(op + 32 + 8 * g4 + 4 * hh) = w1;
        }
    }
}

DI float red8(float v) { v += __shfl_xor(v, 1); v += __shfl_xor(v, 2); v += __shfl_xor(v, 4); return v; }
DI void phasePost(const DArgs& a, int own) {
    const int tid = threadIdx.x, lane = tid & 63, wave = __builtin_amdgcn_readfirstlane(tid >> 6);
    unsigned char* ws = a.ws;
    f16* YF = (f16*)(ws + WS_YF); const f16* YB = (const f16*)(ws + WS_YB);
    const f16* Rr = (const f16*)(ws + WS_RKV); const f16* Kr = Rr + (size_t)M * 512; const f16* Vr = Kr + (size_t)M * 512; const bf16* Gg = (const bf16*)(ws + WS_G);
    const f16* AF = (const f16*)a.out; const f16* AB = (const f16*)((const unsigned char*)a.out + OUT_AW);
    const int ch0 = lane * 8;
    float rkc[8], kac[8], lw[8], lb[8];
#pragma unroll
    for (int j = 0; j < 8; ++j) { rkc[j] = a.in[I_RK][ch0 + j]; kac[j] = a.in[I_KA][ch0 + j]; lw[j] = a.in[I_LNW][ch0 + j]; lb[j] = a.in[I_LNB][ch0 + j]; }
    for (int m = own * 256 + wave; m < own * 256 + 256; m += NWAVES) {
        const size_t o = (size_t)m * 512 + ch0;
        const f16x8 yf = *(const f16x8*)(YF + o), yb = *(const f16x8*)(YB + o), r8 = *(const f16x8*)(Rr + o), k8 = *(const f16x8*)(Kr + o), v8 = *(const f16x8*)(Vr + o);
        const f16x8 af = *(const f16x8*)(AF + o), ab = *(const f16x8*)(AB + o);
        const v4u gq = *(const v4u*)(Gg + o);
        float wkv[8], s1 = 0.f, bs = 0.f;
#pragma unroll
        for (int j = 0; j < 8; ++j) { wkv[j] = (float)yf[j] + (float)yb[j]; s1 += wkv[j];
            bs += (float)r8[j] * (float)k8[j] * rkc[j] * (2.0f + ((float)af[j] + (float)ab[j] - 2.0f) * kac[j]); }
        const float mean = red8(s1) * (1.f / 64.f);
        float s2 = 0.f;
#pragma unroll
        for (int j = 0; j < 8; ++j) { wkv[j] -= mean; s2 += wkv[j] * wkv[j]; }
        const float rstd = rsqrtf(red8(s2) * (1.f / 64.f) + LNX_EPS);
        const float bsum = red8(bs);
        const unsigned gw4[4] = {gq.x, gq.y, gq.z, gq.w};
        float y[8];
#pragma unroll
        for (int j = 0; j < 8; ++j) { const float gj = (j & 1) ? bfhi(gw4[j >> 1]) : bflo(gw4[j >> 1]); y[j] = (wkv[j] * rstd * lw[j] + lb[j] + bsum * (float)v8[j]) * gj; }
        v4u w; w.x = pk2(y[0], y[1]); w.y = pk2(y[2], y[3]); w.z = pk2(y[4], y[5]); w.w = pk2(y[6], y[7]);
        *(v4u*)((bf16*)YF + o) = w;
    }
}

DI void phaseRouter(const DArgs& a, LAS unsigned char* lds, int own) {
    const int tid = threadIdx.x, lane = tid & 63, wave = __builtin_amdgcn_readfirstlane(tid >> 6);
    unsigned char* ws = a.ws;
    LAS float* wf = (LAS float*)lds;
    __syncthreads();
    { const float* g = a.in[I_NFG]; const float* wr = a.in[I_WR];
      for (int idx = tid; idx < 256 * 64; idx += NTHREADS) { const int s4 = idx >> 6, ln = idx & 63, cc = 16 * (s4 >> 2) + 4 * (ln >> 4) + (s4 & 3); wf[idx] = g[cc] * wr[cc * NE + (ln & 15)]; } }
    __syncthreads();
    const bf16* x1 = (const bf16*)(ws + WS_X1B); float* AFFT = (float*)(ws + WS_AFFT); float* RSTD = (float*)(ws + WS_RSTD);
    const int r = lane & 15, q = lane >> 4;
    for (int tile = own * 16 + wave; tile < own * 16 + 16; tile += NWAVES) {
        const int row0 = tile * 16;
        const v2u* xp = (const v2u*)(x1 + (size_t)(row0 + r) * D) + q;
        f32x4 acc = {0.f, 0.f, 0.f, 0.f}; float ss = 0.f;
#pragma unroll 4
        for (int sp = 0; sp < 64; ++sp) {
            const v2u xw = xp[4 * sp]; const f32x4 xv = {bflo(xw.x), bfhi(xw.x), bflo(xw.y), bfhi(xw.y)};
            ss += (xv[0] * xv[0] + xv[1] * xv[1]) + (xv[2] * xv[2] + xv[3] * xv[3]);
#pragma unroll
            for (int j = 0; j < 4; ++j) acc = __builtin_amdgcn_mfma_f32_16x16x4f32(xv[j], wf[(sp * 4 + j) * 64 + lane], acc, 0, 0, 0);
        }
        ss += __shfl_xor(ss, 16); ss += __shfl_xor(ss, 32);
        const float rstd = rsqrtf(ss * (1.f / D) + NORM_EPS);
        if (q == 0) RSTD[row0 + r] = rstd;
        f32x4 p;
#pragma unroll
        for (int i = 0; i < 4; ++i) {
            const float lg = acc[i] * __shfl(rstd, 4 * q + i);
            float mx = lg;
            mx = fmaxf(mx, __shfl_xor(mx, 1)); mx = fmaxf(mx, __shfl_xor(mx, 2)); mx = fmaxf(mx, __shfl_xor(mx, 4)); mx = fmaxf(mx, __shfl_xor(mx, 8));
            const float ex = expf(lg - mx);
            float sm = ex; sm += __shfl_xor(sm, 1); sm += __shfl_xor(sm, 2); sm += __shfl_xor(sm, 4); sm += __shfl_xor(sm, 8);
            p[i] = ex / sm;
        }
        const int b = row0 / T, t0 = row0 % T;
        *(f32x4*)(AFFT + ((size_t)b * NE + r) * T + t0 + 4 * q) = p;
    }
    __syncthreads();
}

DI int block_sum8(LAS int* red, int v, int wave, int lane) {
    if (lane == 0) red[wave] = v;
    __syncthreads();
    int t = 0;
#pragma unroll
    for (int w = 0; w < 8; ++w) t += red[w];
    return t;
}
DI void phaseTopk(const DArgs& a, LAS unsigned char* lds, int pr) {
    const int tid = threadIdx.x, lane = tid & 63, wave = __builtin_amdgcn_readfirstlane(tid >> 6);
    unsigned char* ws = a.ws;
    const float* AFFT = (const float*)(ws + WS_AFFT); int* SEL = (int*)(ws + WS_SEL); float* VAL = (float*)(ws + WS_VAL);
    const float* RSTD = (const float*)(ws + WS_RSTD); const bf16* x1 = (const bf16*)(ws + WS_X1B); bf16* XG = (bf16*)(ws + WS_XG);
    LAS int* red = (LAS int*)lds;
    LAS int* lst = (LAS int*)(lds + 256);
    const unsigned long long lt_mask = (lane == 0) ? 0ull : (~0ull >> (64 - lane));
    const float* g = a.in[I_NFG];
    f32x4 gvv[4];
#pragma unroll
    for (int j = 0; j < 4; ++j) gvv[j] = *(const f32x4*)(g + 4 * lane + 256 * j);
    __syncthreads();
    {
        const int b = pr / NE, e = pr % NE;
        const f32x4 av = *(const f32x4*)(AFFT + (size_t)pr * T + 4 * tid);
        unsigned key[4];
#pragma unroll
        for (int j = 0; j < 4; ++j) { const float f = av[j]; key[j] = __float_as_uint(f); }
        unsigned K = 0u; int it = 0;
        for (int bit = 30; bit >= 0; --bit, ++it) {
            const unsigned cand = K | (1u << bit);
            int cw = 0;
#pragma unroll
            for (int j = 0; j < 4; ++j) cw += __builtin_popcountll(__ballot(key[j] >= cand));
            const int tot = block_sum8(red + 8 * (it & 1), cw, wave, lane);
            if (tot >= CAP) K = cand;
        }
        int cw = 0;
#pragma unroll
        for (int j = 0; j < 4; ++j) cw += __builtin_popcountll(__ballot(key[j] > K));
        const int ngt = block_sum8(red + 8 * (it & 1), cw, wave, lane); ++it;
        const int need = CAP - ngt;
        int tw = 0, tl = 0;
#pragma unroll
        for (int j = 0; j < 4; ++j) { const unsigned long long bt = __ballot(key[j] == K); tw += __builtin_popcountll(bt); tl += __builtin_popcountll(bt & lt_mask); }
        if (lane == 0) red[8 * (it & 1) + wave] = tw;
        __syncthreads();
        int tbase = tl;
#pragma unroll
        for (int w = 0; w < 8; ++w) tbase += (w < wave) ? red[8 * (it & 1) + w] : 0;
        ++it;
        bool sel[4]; int run = tbase;
#pragma unroll
        for (int j = 0; j < 4; ++j) { const bool tie = key[j] == K; sel[j] = key[j] > K || (tie && run < need); run += tie ? 1 : 0; }
        int sw = 0, sl = 0;
#pragma unroll
        for (int j = 0; j < 4; ++j) { const unsigned long long bs = __ballot(sel[j]); sw += __builtin_popcountll(bs); sl += __builtin_popcountll(bs & lt_mask); }
        if (lane == 0) red[8 * (it & 1) + wave] = sw;
        __syncthreads();
        int slot = sl;
#pragma unroll
        for (int w = 0; w < 8; ++w) slot += (w < wave) ? red[8 * (it & 1) + w] : 0;
        ++it;
        const size_t slot0 = (size_t)(e * NB + b) * CAP;
        int so[4];
#pragma unroll
        for (int j = 0; j < 4; ++j) { so[j] = sel[j] ? slot : -1; if (sel[j]) { lst[slot] = 4 * tid + j; VAL[slot0 + slot] = av[j]; ++slot; } }
#pragma unroll
        for (int j = 0; j < 4; ++j) SEL[((size_t)b * T + 4 * tid + j) * NE + e] = so[j];
        __syncthreads();
        for (int rr = wave * 8; rr < CAP; rr += NWAVES * 8) {
            v2u xv[8][4]; float rs[8];
#pragma unroll
            for (int q = 0; q < 8; ++q) { const size_t m = (size_t)b * T + lst[rr + q]; rs[q] = RSTD[m];
                const v2u* xr = (const v2u*)(x1 + m * D) + lane;
#pragma unroll
                for (int j = 0; j < 4; ++j) xv[q][j] = xr[64 * j]; }
#pragma unroll
            for (int q = 0; q < 8; ++q) { unsigned* o = (unsigned*)((unsigned char*)XG + (slot0 + rr + q) * D) + lane;
#pragma unroll
                for (int j = 0; j < 4; ++j) { const f32x4 xf = {bflo(xv[q][j].x), bfhi(xv[q][j].x), bflo(xv[q][j].y), bfhi(xv[q][j].y)}; const f32x4 hv = xf * rs[q] * gvv[j];
                    o[64 * j] = pk4_fp8(hv.x, hv.y, hv.z, hv.w); } }
        }
        __syncthreads();
    }
}

DI void final_accum(f32x4 (&v)[4], const bf16* YS, int myr, unsigned mask, int b, int lane) {
    while (mask) {
        const int e0 = __builtin_ctz(mask); mask &= mask - 1;
        const int has1 = mask != 0; const int e1 = has1 ? __builtin_ctz(mask) : e0; if (has1) mask &= mask - 1;
        const int r0 = __builtin_amdgcn_readlane(myr, e0), r1 = __builtin_amdgcn_readlane(myr, e1);
        const v2u* y0 = (const v2u*)(YS + ((size_t)(e0 * NB + b) * CAP + r0) * D) + lane;
        const v2u* y1 = (const v2u*)(YS + ((size_t)(e1 * NB + b) * CAP + r1) * D) + lane;
        v2u w0[4], w1[4];
#pragma unroll
        for (int j = 0; j < 4; ++j) { w0[j] = y0[64 * j]; w1[j] = y1[64 * j]; }
        const float s1 = has1 ? 1.f : 0.f;
#pragma unroll
        for (int j = 0; j < 4; ++j) {
            v[j].x += bflo(w0[j].x) + s1 * bflo(w1[j].x); v[j].y += bfhi(w0[j].x) + s1 * bfhi(w1[j].x);
            v[j].z += bflo(w0[j].y) + s1 * bflo(w1[j].y); v[j].w += bfhi(w0[j].y) + s1 * bfhi(w1[j].y); }
    }
}
DI void phaseFinal(const DArgs& a, int G, int vcu) {
    const int tid = threadIdx.x, lane = tid & 63, wave = __builtin_amdgcn_readfirstlane(tid >> 6);
    const int gw = vcu * NWAVES + wave, NGW = G * NWAVES;
    unsigned char* ws = a.ws;
    const int* SEL = (const int*)(ws + WS_SEL); const bf16* YS = (const bf16*)(ws + WS_YS);
    float* out = a.out; const float* g = a.in[I_NFINAL]; const bf16* X1B = (const bf16*)(ws + WS_X1B);
    f32x4 gv[4];
#pragma unroll
    for (int j = 0; j < 4; ++j) gv[j] = *(const f32x4*)(g + 4 * lane + 256 * j);
    for (int m0 = gw * 2; m0 < M; m0 += NGW * 2) {
        f32x4* xa = (f32x4*)(out + (size_t)m0 * D) + lane; f32x4* xb = xa + D / 4;
        const v2u* ia = (const v2u*)(X1B + (size_t)m0 * D) + lane; const v2u* ib = ia + D / 4;
        const int ra = SEL[(size_t)m0 * NE + (lane & 15)], rb = SEL[(size_t)(m0 + 1) * NE + (lane & 15)];
        f32x4 va[4], vb[4];
#pragma unroll
        for (int j = 0; j < 4; ++j) { const v2u wa = ia[64 * j], wb = ib[64 * j];
            va[j] = (f32x4){bflo(wa.x), bfhi(wa.x), bflo(wa.y), bfhi(wa.y)}; vb[j] = (f32x4){bflo(wb.x), bfhi(wb.x), bflo(wb.y), bfhi(wb.y)}; }
        const int b = m0 / T;
        const unsigned ma = (unsigned)(__ballot(ra >= 0) & 0xffffull), mb = (unsigned)(__ballot(rb >= 0) & 0xffffull);
        final_accum(va, YS, ra, ma, b, lane);
        final_accum(vb, YS, rb, mb, b, lane);
        float sa = 0.f, sb = 0.f;
#pragma unroll
        for (int j = 0; j < 4; ++j) { sa += (va[j].x * va[j].x + va[j].y * va[j].y) + (va[j].z * va[j].z + va[j].w * va[j].w); sb += (vb[j].x * vb[j].x + vb[j].y * vb[j].y) + (vb[j].z * vb[j].z + vb[j].w * vb[j].w); }
        const float rsa = rsqrtf(wave_sum(sa) * (1.f / D) + NORM_EPS), rsb = rsqrtf(wave_sum(sb) * (1.f / D) + NORM_EPS);
#pragma unroll
        for (int j = 0; j < 4; ++j) { xa[64 * j] = va[j] * rsa * gv[j]; xb[64 * j] = vb[j] * rsb * gv[j]; }
    }
}

typedef __attribute__((address_space(1))) unsigned gu32;
#define XB_TMO      128
#define XB_XCNT(j)  (256  + 64 * (j))
#define XB_XSUB(j)  (1280 + 64 * (j))
#define XB_XGEN(j)  (2304 + 64 * (j))
#define XB_TOP      3328
#define XB_TOPGEN   3392
#define XCD_BAR_WORDS 3456
#define XB_SPIN_CAP (1u << 18)

__device__ __forceinline__ unsigned xb_ld(unsigned* p)              { return __hip_atomic_load(p, __ATOMIC_RELAXED, __HIP_MEMORY_SCOPE_AGENT); }
__device__ __forceinline__ unsigned xb_add(unsigned* p, unsigned v) { return __hip_atomic_fetch_add(p, v, __ATOMIC_RELAXED, __HIP_MEMORY_SCOPE_AGENT); }
__device__ __forceinline__ unsigned xb_xcc_id() { return (unsigned)__builtin_amdgcn_s_getreg((3 << 11) | 20) & 0xFu; }
#define XB_SPIN(cond, bar) do { unsigned _sp = 0; while (cond) { __builtin_amdgcn_s_sleep(1); \
    if ((++_sp & 255u) == 0u) { if (xb_ld(&(bar)[XB_TMO])) break; if (_sp > XB_SPIN_CAP) { atomicAdd(&(bar)[XB_TMO], 1u); break; } } } } while (0)

struct XcdBarrier {
    unsigned* bar; unsigned x;
    volatile LAS unsigned* st;
};

__device__ __forceinline__ XcdBarrier xcd_barrier_post(unsigned* bar, volatile LAS unsigned* st) {
    XcdBarrier b; b.bar = bar; b.x = xb_xcc_id(); b.st = st;
    if (threadIdx.x == 0) (void)xb_add(&bar[XB_XCNT(b.x)], 1u);
    return b;
}
__device__ __forceinline__ void xcd_barrier_complete(unsigned* bar, unsigned x, unsigned& nloc, unsigned& nx) {
    const unsigned G = gridDim.x * gridDim.y * gridDim.z;
    unsigned sum, cnt, mine, sp = 0u;
    for (;;) {
        sum = 0u; cnt = 0u; mine = 0u;
#pragma unroll
        for (unsigned j = 0; j < 16; ++j) { const unsigned c = xb_ld(&bar[XB_XCNT(j)]); sum += c; cnt += (c > 0u) ? 1u : 0u; mine = (j == x) ? c : mine; }
        if (sum == G) break;
        __builtin_amdgcn_s_sleep(1);
        if ((++sp & 255u) == 0u) { if (xb_ld(&bar[XB_TMO])) break; if (sp > XB_SPIN_CAP) { atomicAdd(&bar[XB_TMO], 1u); break; } }
    }
    nloc = mine > 0u ? mine : 1u; nx = cnt > 0u ? cnt : 1u;
}

__device__ __forceinline__ void xcd_barrier(const XcdBarrier& b) {
    asm volatile("s_waitcnt vmcnt(0)" ::: "memory");
    __syncthreads();
    if (threadIdx.x == 0) {
        unsigned* bar = b.bar;
        __builtin_amdgcn_s_waitcnt(0);
        unsigned nloc = b.st[0], nx = b.st[1];
        if (nloc == 0u) { xcd_barrier_complete(bar, b.x, nloc, nx); b.st[0] = nloc; b.st[1] = nx; }
        const unsigned old = xb_add(&bar[XB_XSUB(b.x)], 1u);
        const unsigned gen = old / nloc;
        if (old + 1u == (gen + 1u) * nloc) {
            __builtin_amdgcn_fence(__ATOMIC_RELEASE, "agent");
            asm volatile("s_waitcnt vmcnt(0)" ::: "memory");
            const unsigned og = xb_add(&bar[XB_TOP], 1u);
            const unsigned tg = og / nx;
            if (og + 1u == (tg + 1u) * nx) xb_add(&bar[XB_TOPGEN], 1u);
            else XB_SPIN(xb_ld(&bar[XB_TOPGEN]) == tg, bar);
            __builtin_amdgcn_fence(__ATOMIC_ACQUIRE, "agent");
            xb_add(&bar[XB_XGEN(b.x)], 1u);
            asm volatile("s_waitcnt vmcnt(0)" ::: "memory");
        } else {
            XB_SPIN(xb_ld(&bar[XB_XGEN(b.x)]) == gen, bar);
            __builtin_amdgcn_fence(__ATOMIC_ACQUIRE, "agent");
            asm volatile("s_waitcnt vmcnt(0)" ::: "memory");
        }
    }
    __syncthreads();
}


constexpr int NPHASE = 13;
#ifndef MK_ONE_LAUNCH
#define MK_ONE_LAUNCH 1
#endif
__global__ void __launch_bounds__(NTHREADS, 2) fwd_kernel(Args args) {
    extern __shared__ __attribute__((aligned(16))) unsigned char lds_raw[];
    LAS unsigned char* lds = (LAS unsigned char*)lds_raw;
    const int G = gridDim.x, bx = blockIdx.x;
    const int vcu = (G % 8 == 0) ? (bx % 8) * (G / 8) + bx / 8 : bx;
    const int lo = args.ph_lo, hi = args.ph_hi;
    unsigned char* ws = args.ws;
    DArgs dargs; dargs.out = args.out; dargs.ws = args.ws;
#if MK_ONE_LAUNCH
    volatile LAS unsigned* MISC = (volatile LAS unsigned*)(lds + LDS_BYTES - 128);
    if (threadIdx.x < 32) MISC[threadIdx.x] = 0u;
    __syncthreads();
    const XcdBarrier xbar = xcd_barrier_post((unsigned*)(ws + WS_CTL) + 64, MISC);
#endif
#ifndef REPEAT_MASK
#define REPEAT_MASK 0
#endif
#define IN(k) (lo <= (k) && (k) < hi)
#define REPS(k) for (int rep_ = 0; rep_ < (((REPEAT_MASK >> (k)) & 1) ? 2 : 1); ++rep_)
#if MK_ONE_LAUNCH
#define SEAM(k) do { if (IN(k) && IN((k) + 1)) { if ((k) == 0) cg::this_grid().sync(); else xcd_barrier(xbar); } } while (0)
#else
#define SEAM(k) do { } while (0)
#endif
    if (IN(0)) REPS(0) { phase0(dargs, lds, G, vcu); }
    SEAM(0);
    if (IN(1)) REPS(1) {
        { pg8::Gemm g{(const bf16*)args.out, (const bf16*)(ws + WS_WIN), M, 2816, D, D, 1 << 30, 0, nullptr, 0, nullptr, 0, 1 << 30, 0, 0};
          pg8::StaticOrder S; S.init(M, 2816, G, bx);
          EpiA E{(bf16*)(ws + WS_UR), (bf16*)(ws + WS_QKV), (bf16*)(ws + WS_GATES)};
          pg8::gemm_phase<EpiA, pg8::StaticOrder, PG8_ALIGN, PG8_SP2>(lds, g, S, E); }
        { pg8::Gemm g{(const bf16*)((const unsigned char*)args.out + 128 * MiB), (const bf16*)(ws + WS_WG8), M, NGATE, D / 2, D / 2, 1 << 30, 0, nullptr, 0, nullptr, 0, 1 << 30, 0, 0};
          pg8::StaticOrder S; S.init(M, NGATE, G, bx);
          EpiGates E{(unsigned char*)(ws + WS_GATES)};
          pg8::gemm_phase<EpiGates, pg8::StaticOrder, PG8_ALIGN, PG8_SP2, false, false, true>(lds, g, S, E); }
    }
    SEAM(1);
#define BSEAM() do { asm volatile("s_waitcnt vmcnt(0)" ::: "memory"); __syncthreads(); } while (0)
    if (IN(2)) {
        { const int own = vcu;
            phaseP1(dargs, lds, own);
            BSEAM();
            int kl = 128; asm volatile("" : "+s"(kl));
            pg8::Gemm g{(const bf16*)(ws + WS_AP), (const bf16*)(ws + WS_WLORA), M, NLN, kl, NLK, 1 << 30, 0, nullptr, 0, nullptr, 0, 1 << 30, 0, 0};
            pg8::OwnRowLoraOrder S; S.pm0 = own; S.pm1 = own; S.npm = 1; S.nN = NLN / 256;
            EpiLoraZ E{(bf16*)(ws + WS_G), (f16*)args.out, (const float*)(ws + WS_LBIAS)};
            pg8::gemm_phase<EpiLoraZ, pg8::OwnRowLoraOrder, PG8_ALIGN, PG8_SP2>(lds, g, S, E);
        }
    }
    SEAM(3);
    if (IN(4)) {
        const int lane4 = threadIdx.x & 63, wave4 = __builtin_amdgcn_readfirstlane(threadIdx.x >> 6);
        if (threadIdx.x < 64) { ((LAS int*)(lds + CH_FLAG))[threadIdx.x & 31] = 0; ((LAS int*)(lds + CHAIN_LDS2 + CH_FLAG))[threadIdx.x & 31] = 0; }
        __syncthreads();
        LAS int* qctr = (LAS int*)(lds + CH_FLAG) + 16;
        if ((wave4 & 2) == 0) phaseScan(dargs, lds, G, vcu, wave4, lane4);
        phaseAttn(dargs, qctr, vcu, lane4);
    }
    SEAM(4);
    if (IN(5)) { phasePost(dargs, vcu); }
    SEAM(5);
    if (IN(6)) REPS(6) {
        pg8::Gemm g{(const bf16*)(ws + WS_YF), (const bf16*)(ws + WS_WPR), M, D, D, 512, 1 << 30, 0, nullptr, 0, (const bf16*)(ws + WS_QKV), NQKV, 8, 0, 0};
        pg8::StaticOrder S; S.init(M, D, G, bx);
        EpiMerge2 E{(bf16*)(ws + WS_MERGED), (const unsigned char*)(ws + WS_GATES)};
        pg8::gemm_phase<EpiMerge2, pg8::StaticOrder, PG8_ALIGN, PG8_SP2, false, true>(lds, g, S, E);
    }
    SEAM(6);
    if (IN(7)) REPS(7) {
        pg8::Gemm g{(const bf16*)(ws + WS_MERGED), (const bf16*)(ws + WS_WOUT), M, D, D, D, 1 << 30, 0, nullptr, 0, nullptr, 0, 1 << 30, 0, 0};
        pg8::StaticOrder S; S.init(M, D, G, bx);
        EpiResid E{dargs.in[I_X], (bf16*)(ws + WS_X1B)};
        pg8::gemm_phase<EpiResid, pg8::StaticOrder, PG8_ALIGN, PG8_SP2>(lds, g, S, E);
    }
    SEAM(7);
    if (IN(8)) { phaseRouter(dargs, lds, vcu); }
    SEAM(8);
    if (IN(9)) { phaseTopk(dargs, lds, 2 * vcu); phaseTopk(dargs, lds, 2 * vcu + 1);   }
    SEAM(9);
    if (IN(10)) REPS(10) {
        pg8::Gemm g{(const bf16*)(ws + WS_XG), (const bf16*)(ws + WS_WGU), MS, 2048, D / 2, D / 2, NB, (size_t)2048 * D, nullptr, 0, nullptr, 0, 1 << 30, 0x7f7f7f7f, 0x7a7a7a7a};
        pg8::StaticOrder S; S.init(MS, 2048, G, bx);
        EpiSwiglu E{(unsigned char*)(ws + WS_HID)};
        pg8::gemm_phase<EpiSwiglu, pg8::StaticOrder, PG8_ALIGN, PG8_SP2, false, false, true>(lds, g, S, E);
    }
    SEAM(10);
    if (IN(11)) REPS(11) {
        pg8::Gemm g{(const bf16*)(ws + WS_HID), (const bf16*)(ws + WS_WD), MS, D, FF / 2, FF / 2, NB, (size_t)D * FF, nullptr, 0, nullptr, 0, 1 << 30, 0x7f7f7f7f, 0x7a7a7a7a};
        pg8::StaticOrder S; S.init(MS, D, G, bx);
        EpiYs E{(bf16*)(ws + WS_YS), (const float*)(ws + WS_VAL)};
        pg8::gemm_phase<EpiYs, pg8::StaticOrder, PG8_ALIGN, PG8_SP2, false, false, true>(lds, g, S, E);
    }
    SEAM(11);
    if (IN(12)) { phaseFinal(dargs, G, vcu); }
#undef IN
#undef SEAM
}

extern "C" void kernel_launch(void* const* d_in, const int* in_sizes, int n_in, void* d_out, int out_size, void* d_ws, size_t ws_size, hipStream_t stream) {
    static int grid = 0;
    if (grid == 0) {
        if (n_in != 29 || out_size != M * D || ws_size < WS_END) { fprintf(stderr, "kernel_launch: unexpected shapes (n_in %d out %d ws %zu)\n", n_in, out_size, ws_size); grid = -1; return; }
        int dev = 0, cus = 0, per_cu = 0;
        hipGetDevice(&dev);
        hipDeviceGetAttribute(&cus, hipDeviceAttributeMultiprocessorCount, dev);
        hipFuncSetAttribute((const void*)fwd_kernel, hipFuncAttributeMaxDynamicSharedMemorySize, LDS_BYTES);
        hipOccupancyMaxActiveBlocksPerMultiprocessor(&per_cu, (const void*)fwd_kernel, NTHREADS, LDS_BYTES);
        (void)hipGetLastError();
        if (per_cu < 1) { fprintf(stderr, "kernel_launch: occupancy query says %d blocks per CU\n", per_cu); per_cu = 1; }
        grid = cus;
        if (grid != M / 256) { fprintf(stderr, "kernel_launch: this build needs exactly %d workgroups (one per CU of a 256-CU device), got %d\n", M / 256, grid); grid = -1; return; }
    }
    if (grid < 0) return;
    Args a{};
    for (int i = 0; i < 29; ++i) a.in[i] = (const float*)d_in[i];
    a.out = (float*)d_out; a.ws = (unsigned char*)d_ws;
#if MK_ONE_LAUNCH
    if (hipMemsetAsync((char*)d_ws + WS_CTL, 0, 16384, stream) != hipSuccess) { fprintf(stderr, "kernel_launch: memset of the barrier words failed\n"); return; }
    a.ph_lo = 0; a.ph_hi = NPHASE;
    void* kargs[] = {&a};
    hipError_t e = hipLaunchCooperativeKernel((const void*)fwd_kernel, dim3(grid), dim3(NTHREADS), kargs, LDS_BYTES, stream);
    if (e != hipSuccess) fprintf(stderr, "cooperative launch failed: %s (grid %d)\n", hipGetErrorString(e), grid);
#else
    for (int p = 0; p < NPHASE; ++p) {
        a.ph_lo = p; a.ph_hi = p + 1;
        hipLaunchKernelGGL(fwd_kernel, dim3(grid), dim3(NTHREADS), LDS_BYTES, stream, a);
    }
#endif
}
```

```cpp
#include <hip/hip_runtime.h>
#include <hip/hip_cooperative_groups.h>
#include <cstdio>
#include <cstdint>
namespace cg = cooperative_groups;
namespace pg8 {
#define PG8_LAS __attribute__((address_space(3)))
typedef unsigned short bf16_t;
typedef short bf16x8 __attribute__((ext_vector_type(8)));
typedef float f32x4 __attribute__((ext_vector_type(4)));
typedef unsigned u32x4 __attribute__((ext_vector_type(4)));
typedef int i32x8 __attribute__((ext_vector_type(8)));
typedef int i32x4 __attribute__((ext_vector_type(4)));
constexpr int BM = 256, BK = 64, HALF = 128, HTB = HALF * BK * 2  , STAGE_BYTES = 8 * HTB, NXCD = 8, WGM = 8;

__host__ __device__ __forceinline__ int lds_byte(int r, int c) { const int st = (r >> 4) * 2 + (c >> 5), rr = r & 15, cc = c & 31, ob = rr * 64 + cc * 2; return st * 1024 + (ob ^ (((ob >> 9) & 1) << 5)); }
__host__ __device__ __forceinline__ void stage_rc(int b, int& R, int& C) { const int st = b / 1024, sb = b % 1024, swz = sb ^ (((sb >> 9) & 1) << 5); R = (st >> 1) * 16 + swz / 64; C = (st & 1) * 32 + (swz % 64) / 2; }
__host__ __device__ __forceinline__ int lds_byte_mx(int r, int c) { const int st = (r >> 4) * 2 + (c >> 5), rr = r & 15, cc = c & 31, ob = rr * 64 + cc * 2; return st * 1024 + (ob ^ (((ob >> 9) & 1) << 4)); }
__host__ __device__ __forceinline__ void stage_rc_mx(int b, int& R, int& C) { const int st = b / 1024, sb = b % 1024, swz = sb ^ (((sb >> 9) & 1) << 4); R = (st >> 1) * 16 + swz / 64; C = (st & 1) * 32 + (swz % 64) / 2; }
__host__ __device__ __forceinline__ int perm32(int rho) { const int n = rho >> 4, i = rho & 15; return 8 * (i >> 2) + 4 * n + (i & 3); }

struct Unit { int pm, pn; };
struct Gemm { const bf16_t* A; const bf16_t* Bt; int M, N, K, lda; int grp_tiles; size_t grp_stride; const PG8_LAS unsigned short* glist; int gather_T; const bf16_t* A2; int lda2, ksplit; int mx_scale_a, mx_scale_b; };

struct StaticOrder {
    int nM, nN, nwg, G, c;
    __host__ __device__ void init(int M, int N, int G_, int c_) { nM = M / BM; nN = N / BM; nwg = nM * nN; G = G_; c = c_; }
    __host__ __device__ bool next(int i, Unit& u) const {
        const long L = (long)i * G + c; if (L >= nwg) return false;
        int wgid = (int)L; { const int q = nwg / NXCD, r = nwg % NXCD, xcd = wgid % NXCD, off = wgid / NXCD; wgid = (xcd < r ? xcd * (q + 1) : r * (q + 1) + (xcd - r) * q) + off; }
        const int nig = WGM * nN, gid = wgid / nig, fm = gid * WGM, gsz = (nM - fm) < WGM ? (nM - fm) : WGM;
        u.pm = fm + ((wgid % nig) % gsz); u.pn = (wgid % nig) / gsz; return true;
    }
    __device__ __forceinline__ void a_ready(const Unit&) const {}
    __device__ __forceinline__ void done(const Unit&) const {}
    __device__ __forceinline__ size_t a_off(const Unit&) const { return 0; }
};
struct OwnRowOrder {
    int pm0, pm1, npm, nN;
    __device__ __forceinline__ bool next(int i, Unit& u) const { const int r = i / nN; if (r >= npm) return false; u.pm = r == 0 ? pm0 : pm1; u.pn = i - r * nN; return true; }
    __device__ __forceinline__ void a_ready(const Unit&) const {}
    __device__ __forceinline__ void done(const Unit&) const {}
    __device__ __forceinline__ size_t a_off(const Unit&) const { return 0; }
};
struct OwnRowLoraOrder : OwnRowOrder {
    __device__ __forceinline__ size_t a_off(const Unit& u) const { return u.pn < 2 ? 0 : (u.pn < 6 ? 256 : 512); }
};
struct LoraOrder : StaticOrder {
    __device__ __forceinline__ size_t a_off(const Unit& u) const { return u.pn < 2 ? 0 : (u.pn < 6 ? 256 : 512); }
};
template <class Epi, class Sched, bool ALIGN_EPI = false, bool SP2 = false, bool GA = false, bool SA2 = false, bool MX = false>
__device__ __forceinline__ void gemm_phase(PG8_LAS unsigned char* lds, const Gemm g, const Sched& S, const Epi& E) {
    const int tid = threadIdx.x, wid = __builtin_amdgcn_readfirstlane(tid >> 6), lane = tid & 63, wr = wid >> 2, wc = wid & 3, fr = lane & 15, fq = lane >> 4;
    const int K = g.K, nt = K / BK;
    unsigned voffA[2], voffB[2], voffA2[2];
#pragma unroll
    for (int i = 0; i < 2; ++i) { int R, C; if constexpr (MX) stage_rc_mx(tid * 16 + i * 8192, R, C); else stage_rc(tid * 16 + i * 8192, R, C); const int Rb = Epi::PERM ? ((R & ~31) + perm32(R & 31)) : R;
        voffA[i] = (unsigned)(R * g.lda + C) * 2u; voffB[i] = (unsigned)(Rb * K + C) * 2u; voffA2[i] = (unsigned)(R * g.lda2 + C) * 2u; }
    const size_t kstep = (size_t)(BK * 2);
    const size_t hstepA = (size_t)HALF * g.lda * 2, hstepB = (size_t)HALF * K * 2;
    const size_t tstepA = GA ? 0 : 2 * hstepA, tstepB = 2 * hstepB;
    const size_t hstepA2 = (size_t)HALF * g.lda2 * 2; const int ks = g.ksplit;
    const unsigned ldsw = (unsigned)wid * 1024u;
    const int aoff = lds_byte(wr * 64 + fr, fq * 8), boff = lds_byte(wc * 32 + fr, fq * 8);
    const int aoffx0 = lds_byte_mx(wr * 64 + fr, 16 * fq), aoffx1 = lds_byte_mx(wr * 64 + fr, 16 * fq + 8), boffx0 = lds_byte_mx(wc * 32 + fr, 16 * fq), boffx1 = lds_byte_mx(wc * 32 + fr, 16 * fq + 8);
#define PG8_SA(b, h) (((b) * 2 + (h)) * HTB)
#define PG8_SB(b, h) ((4 + (b) * 2 + (h)) * HTB)
#define PG8_STAGE(bufoff, gbase, voff) do { _Pragma("unroll") for (int _i = 0; _i < 2; ++_i) { unsigned vo1_ = (voff)[_i]; if constexpr (MX) asm volatile("" : "+v"(vo1_));     \
        __builtin_amdgcn_global_load_lds((const unsigned*)((const char*)(gbase) + vo1_), (PG8_LAS unsigned*)(lds + (bufoff) + ldsw + _i * 8192), 16, 0, 0); } } while (0)
#define PG8_STAGE_A(bufoff, base, half, usenext, side) do { if constexpr (GA) { unsigned vo_[2]; _Pragma("unroll") for (int q_ = 0; q_ < 2; ++q_) vo_[q_] = (usenext) ? nG[half][q_] : cG[half][q_]; PG8_STAGE(bufoff, base, vo_); } \
        else if constexpr (SA2) { if (side) { PG8_STAGE(bufoff, (base) + (half) * hstepA2, voffA2); } else { PG8_STAGE(bufoff, (base) + (half) * hstepA, voffA); } } \
        else { PG8_STAGE(bufoff, (base) + (half) * hstepA, voffA); } } while (0)
#define PG8_LDA(dst, b, h) do { if constexpr (MX) { _Pragma("unroll") for (int m = 0; m < 4; ++m) { const i32x4 lo_ = *(const PG8_LAS i32x4*)(lds + PG8_SA(b, h) + aoffx0 + m * 2048), hi_ = *(const PG8_LAS i32x4*)(lds + PG8_SA(b, h) + aoffx1 + m * 2048); \
            dst##X[m] = __builtin_shufflevector(lo_, hi_, 0, 1, 2, 3, 4, 5, 6, 7); } } \
        else { _Pragma("unroll") for (int m = 0; m < 4; ++m) _Pragma("unroll") for (int k = 0; k < 2; ++k) dst[m][k] = *(const PG8_LAS bf16x8*)(lds + PG8_SA(b, h) + aoff + m * 2048 + k * 1024); } } while (0)
#define PG8_LDB(dst, b, h) do { if constexpr (MX) { _Pragma("unroll") for (int n = 0; n < 2; ++n) { const i32x4 lo_ = *(const PG8_LAS i32x4*)(lds + PG8_SB(b, h) + boffx0 + n * 2048), hi_ = *(const PG8_LAS i32x4*)(lds + PG8_SB(b, h) + boffx1 + n * 2048); \
            dst##X[n] = __builtin_shufflevector(lo_, hi_, 0, 1, 2, 3, 4, 5, 6, 7); } } \
        else { _Pragma("unroll") for (int n = 0; n < 2; ++n) _Pragma("unroll") for (int k = 0; k < 2; ++k) dst[n][k] = *(const PG8_LAS bf16x8*)(lds + PG8_SB(b, h) + boff + n * 2048 + k * 1024); } } while (0)
#define PG8_MMA(ai, bj, At, Bt) do { __builtin_amdgcn_s_setprio(1); if constexpr (MX) { _Pragma("unroll") for (int m = 0; m < 4; ++m) _Pragma("unroll") for (int n = 0; n < 2; ++n) \
        asm volatile("v_mfma_scale_f32_16x16x128_f8f6f4 %0, %1, %2, %0, %3, %3 op_sel_hi:[0,0,0]" : "+v"(acc[ai][bj][m][n]) : "v"(Bt##X[n]), "v"(At##X[m]), "v"(mxs)); }     \
        else { _Pragma("unroll") for (int m = 0; m < 4; ++m) _Pragma("unroll") for (int n = 0; n < 2; ++n) _Pragma("unroll") for (int k = 0; k < 2; ++k) \
        acc[ai][bj][m][n] = __builtin_amdgcn_mfma_f32_16x16x32_bf16(Bt[n][k], At[m][k], acc[ai][bj][m][n], 0, 0, 0); } __builtin_amdgcn_s_setprio(0); } while (0)
#define PG8_WAIT_V(n) asm volatile("s_waitcnt vmcnt(" #n ")" ::: "memory")
#define PG8_WAIT_L(n) asm volatile("s_waitcnt lgkmcnt(" #n ")" ::: "memory")
#define PG8_BAR __builtin_amdgcn_s_barrier()
#define PG8_SCHED __builtin_amdgcn_sched_barrier(0)
    Unit cur, nxt; int ui = 0;
    if (!S.next(0, cur)) return;
    f32x4 acc[2][2][4][2];
#pragma unroll
    for (int a = 0; a < 2; ++a)
#pragma unroll
        for (int b = 0; b < 2; ++b)
#pragma unroll
            for (int m = 0; m < 4; ++m)
#pragma unroll
                for (int n = 0; n < 2; ++n) acc[a][b][m][n] = (f32x4){0.f, 0.f, 0.f, 0.f};
    bf16x8 At[4][2], B0[2][2], B1[2][2];
    i32x8 AtX[4], B0X[2], B1X[2];
    int mxs = 0x7f7f7f7f; asm volatile("" : "+v"(mxs));
    unsigned cG[2][2], nG[2][2]; int gR[2], gC[2];
    if constexpr (GA) {
#pragma unroll
        for (int i = 0; i < 2; ++i) { int R, C; stage_rc(tid * 16 + i * 8192, R, C); gR[i] = R; gC[i] = C; }
#pragma unroll
        for (int h = 0; h < 2; ++h)
#pragma unroll
            for (int i = 0; i < 2; ++i) { const int tok = g.glist[h * HALF + gR[i]]; cG[h][i] = (unsigned)(((cur.pm % g.grp_tiles) * g.gather_T + tok) * g.lda + gC[i]) * 2u; nG[h][i] = cG[h][i]; }
    }
    const char* cA = (const char*)g.A + (size_t)cur.pm * tstepA + S.a_off(cur); const char* cB = (const char*)g.Bt + (size_t)(cur.pm / g.grp_tiles) * g.grp_stride + (size_t)cur.pn * tstepB;
    const char* cA2 = (const char*)g.A2 + (size_t)cur.pm * 2 * hstepA2;
    S.a_ready(cur);
    if constexpr (SP2) {
        PG8_STAGE(PG8_SB(0, 0), cB, voffB); PG8_STAGE(PG8_SB(0, 1), cB + hstepB, voffB); PG8_STAGE_A(PG8_SA(0, 0), cA, 0, false, false); PG8_STAGE_A(PG8_SA(0, 1), cA, 1, false, false);
        if (wr == 1) PG8_BAR;
        PG8_WAIT_V(2); PG8_BAR;
        PG8_STAGE(PG8_SB(1, 0), cB + kstep, voffB); PG8_STAGE_A(PG8_SA(1, 0), cA + kstep, 0, false, false); PG8_STAGE(PG8_SB(1, 1), cB + hstepB + kstep, voffB);
        PG8_WAIT_V(6); PG8_BAR;
    } else {
        PG8_STAGE(PG8_SB(0, 0), cB, voffB); PG8_STAGE_A(PG8_SA(0, 0), cA, 0, false, false); PG8_STAGE(PG8_SB(0, 1), cB + hstepB, voffB); PG8_STAGE_A(PG8_SA(0, 1), cA, 1, false, false);
        if (wr == 1) PG8_BAR;
        PG8_WAIT_V(4); PG8_BAR;
        PG8_STAGE(PG8_SB(1, 0), cB + kstep, voffB); PG8_STAGE_A(PG8_SA(1, 0), cA + kstep, 0, false, false); PG8_STAGE(PG8_SB(1, 1), cB + hstepB + kstep, voffB);
        PG8_WAIT_V(6); PG8_BAR;
    }
    for (;;) {
        const bool has_next = S.next(ui + 1, nxt);
        if constexpr (GA) { if (has_next) {
#pragma unroll
            for (int h = 0; h < 2; ++h)
#pragma unroll
                for (int i = 0; i < 2; ++i) { const int tok = g.glist[(ui + 1) * 256 + h * HALF + gR[i]]; nG[h][i] = (unsigned)(((nxt.pm % g.grp_tiles) * g.gather_T + tok) * g.lda + gC[i]) * 2u; } } }
        const char* nA = has_next ? (const char*)g.A + (size_t)nxt.pm * tstepA + S.a_off(nxt) : cA; const char* nB = has_next ? (const char*)g.Bt + (size_t)(nxt.pm / g.grp_tiles) * g.grp_stride + (size_t)nxt.pn * tstepB : cB;
        for (int t = 0; t < nt; t += 2) {
            const bool last = (t == nt - 2); const bool usen = last && has_next;
            const bool s1 = SA2 && t >= ks, s2 = SA2 && !last && (t + 2 >= ks);
            const char* a1 = s1 ? cA2 + (size_t)(t + 1 - ks) * kstep : cA + (size_t)(t + 1) * kstep;
            const char* a2 = last ? nA : (s2 ? cA2 + (size_t)(t + 2 - ks) * kstep : cA + (size_t)(t + 2) * kstep); const char* b2 = last ? nB : cB + (size_t)(t + 2) * kstep;
            const char* a3 = a2 + kstep; const char* b3 = b2 + kstep;
            if (last && has_next) S.a_ready(nxt);
            if constexpr (SA2) { if (t == ks) E.mid(acc, cur, wr, wc, fr, fq); }
            if constexpr (SP2) {
            PG8_LDB(B0, 0, 0); PG8_LDB(B1, 0, 1); PG8_SCHED; PG8_LDA(At, 0, 0); PG8_STAGE_A(PG8_SA(1, 1), a1, 1, false, s1);
            PG8_WAIT_V(8); PG8_WAIT_L(0); PG8_BAR; PG8_MMA(0, 0, At, B0); PG8_MMA(0, 1, At, B1); PG8_BAR; PG8_SCHED;
            PG8_LDA(At, 0, 1); PG8_STAGE(PG8_SB(0, 0), b2, voffB); PG8_STAGE(PG8_SB(0, 1), b2 + hstepB, voffB); PG8_STAGE_A(PG8_SA(0, 0), a2, 0, usen, s2);
            PG8_WAIT_V(8); PG8_WAIT_L(0); PG8_BAR; PG8_MMA(1, 0, At, B0); PG8_MMA(1, 1, At, B1); PG8_BAR; PG8_SCHED;
            PG8_LDB(B0, 1, 0); PG8_LDB(B1, 1, 1); PG8_SCHED; PG8_LDA(At, 1, 0); PG8_STAGE_A(PG8_SA(0, 1), a2, 1, usen, s2);
            PG8_WAIT_V(8); PG8_WAIT_L(0); PG8_BAR; PG8_MMA(0, 0, At, B0); PG8_MMA(0, 1, At, B1); PG8_BAR; PG8_SCHED;
            PG8_LDA(At, 1, 1); PG8_STAGE(PG8_SB(1, 0), b3, voffB); PG8_STAGE(PG8_SB(1, 1), b3 + hstepB, voffB); PG8_STAGE_A(PG8_SA(1, 0), a3, 0, usen, s2);
            PG8_WAIT_V(8); PG8_WAIT_L(0); PG8_BAR; PG8_MMA(1, 0, At, B0); PG8_MMA(1, 1, At, B1); PG8_BAR; PG8_SCHED;
            } else {
            PG8_LDB(B0, 0, 0); PG8_SCHED; PG8_LDA(At, 0, 0); PG8_STAGE_A(PG8_SA(1, 1), a1, 1, false, s1);
            PG8_WAIT_L(8); PG8_BAR; PG8_WAIT_L(0); PG8_MMA(0, 0, At, B0); PG8_BAR; PG8_SCHED;
            PG8_LDB(B1, 0, 1); PG8_STAGE(PG8_SB(0, 0), b2, voffB);
            PG8_BAR; PG8_WAIT_L(0); PG8_MMA(0, 1, At, B1); PG8_BAR;
            PG8_LDA(At, 0, 1); PG8_STAGE_A(PG8_SA(0, 0), a2, 0, usen, s2);
            PG8_BAR; PG8_WAIT_L(0); PG8_MMA(1, 0, At, B0); PG8_BAR; PG8_SCHED;
            PG8_STAGE(PG8_SB(0, 1), b2 + hstepB, voffB);
            PG8_WAIT_V(6); PG8_BAR; PG8_MMA(1, 1, At, B1); PG8_BAR;
            PG8_LDB(B0, 1, 0); PG8_SCHED; PG8_LDA(At, 1, 0); PG8_STAGE_A(PG8_SA(0, 1), a2, 1, usen, s2);
            PG8_WAIT_L(8); PG8_BAR; PG8_WAIT_L(0); PG8_MMA(0, 0, At, B0); PG8_BAR; PG8_SCHED;
            PG8_LDB(B1, 1, 1); PG8_STAGE(PG8_SB(1, 0), b3, voffB);
            PG8_BAR; PG8_WAIT_L(0); PG8_MMA(0, 1, At, B1); PG8_BAR;
            PG8_LDA(At, 1, 1); PG8_STAGE_A(PG8_SA(1, 0), a3, 0, usen, s2);
            PG8_BAR; PG8_WAIT_L(0); PG8_MMA(1, 0, At, B0); PG8_BAR; PG8_SCHED;
            PG8_STAGE(PG8_SB(1, 1), b3 + hstepB, voffB);
            PG8_WAIT_V(6); PG8_BAR; PG8_MMA(1, 1, At, B1); PG8_BAR;
            }
        }
        if constexpr (ALIGN_EPI) { if (wr == 0) PG8_BAR; }
        if constexpr (MX) asm volatile("s_nop 15\n\ts_nop 15" ::: "memory");
#ifdef PG8_EPI_TWICE
        if constexpr (!Epi::AFTER_DRAIN) { E(acc, cur, wr, wc, fr, fq); asm volatile("" ::: "memory"); }
#endif
        if constexpr (!Epi::AFTER_DRAIN) { E(acc, cur, wr, wc, fr, fq); S.done(cur); }
        if (!has_next) break;
#pragma unroll
        for (int a = 0; a < 2; ++a)
#pragma unroll
            for (int b = 0; b < 2; ++b)
#pragma unroll
                for (int m = 0; m < 4; ++m)
#pragma unroll
                    for (int n = 0; n < 2; ++n) acc[a][b][m][n] = (f32x4){0.f, 0.f, 0.f, 0.f};
        cur = nxt; cA = nA; cB = nB; ++ui; cA2 = (const char*)g.A2 + (size_t)cur.pm * 2 * hstepA2;
        if constexpr (GA) { _Pragma("unroll") for (int h = 0; h < 2; ++h) _Pragma("unroll") for (int i = 0; i < 2; ++i) cG[h][i] = nG[h][i]; }
        if constexpr (ALIGN_EPI) { if (wr == 1) PG8_BAR; }
    }
    PG8_WAIT_V(0);
    if constexpr (!ALIGN_EPI) { if (wr == 0) PG8_BAR; }
    PG8_BAR;
    if constexpr (Epi::AFTER_DRAIN) { E.fused(acc, cur, wr, wc, fr, fq, lds, wid, lane); S.done(cur); }
#undef PG8_SA
#undef PG8_SB
#undef PG8_STAGE
#undef PG8_LDA
#undef PG8_LDB
#undef PG8_MMA
#undef PG8_WAIT_V
#undef PG8_WAIT_L
#undef PG8_BAR
#undef PG8_SCHED
}
}

#ifndef PG8_SP2
#define PG8_SP2 true
#endif
#ifndef PG8_ALIGN
#define PG8_ALIGN true
#endif

#define DI __device__ __forceinline__
#define LAS __attribute__((address_space(3)))
typedef unsigned short bf16;
typedef _Float16 f16;
typedef unsigned v4u __attribute__((ext_vector_type(4)));
typedef unsigned v2u __attribute__((ext_vector_type(2)));
typedef float f32x4 __attribute__((ext_vector_type(4)));
typedef float f32x2 __attribute__((ext_vector_type(2)));
typedef float f32x16 __attribute__((ext_vector_type(16)));
typedef short bf16x8 __attribute__((ext_vector_type(8)));
typedef _Float16 f16x8 __attribute__((ext_vector_type(8)));
typedef _Float16 f16x4 __attribute__((ext_vector_type(4)));
typedef __bf16 bf16x2_t __attribute__((ext_vector_type(2)));

constexpr int NB = 32, T = 2048, D = 1024, M = NB * T;
constexpr int RC = 1920, NQKV = 768, NGATE = 2048, NIN = 4736, NINP = 4864;
constexpr int RD = 512, NH = 8, HS = 64;
constexpr int NLK = 384, NLN = 2560;
constexpr int NE = 16, CAP = 256, FF = 1024, MS = NB * NE * CAP;
constexpr float DECAY_SCALE = 0.60653065971263342f;
constexpr float LNX_EPS = 64e-5f, NORM_EPS = 1e-6f;
constexpr int NWAVES = 8, NTHREADS = 512;

constexpr size_t MiB = 1u << 20;
constexpr size_t WS_CTL = 0;
constexpr size_t WS_KN = 1 * MiB;
constexpr size_t WS_AFFT = 5 * MiB;
constexpr size_t WS_SEL = 9 * MiB;
constexpr size_t WS_VAL = 13 * MiB;
constexpr size_t WS_RSTD = 13 * MiB + 768 * 1024;
constexpr size_t WS_LBIAS = 13 * MiB + 512 * 1024;
constexpr size_t WS_VT = 14 * MiB;
constexpr size_t WS_WIN = 30 * MiB;
constexpr size_t WS_WG8 = 36 * MiB;
constexpr size_t WS_WPR = 40 * MiB;
constexpr size_t WS_WPA = 41 * MiB;
constexpr size_t WS_WOUT = 42 * MiB;
constexpr size_t WS_WLORA = 44 * MiB;
constexpr size_t WS_WGU = 46 * MiB;
constexpr size_t WS_WD = 110 * MiB;
constexpr size_t WS_UR = 142 * MiB;
constexpr size_t WS_G = 606 * MiB;
constexpr size_t WS_YF = 206 * MiB;
constexpr size_t WS_YB = 270 * MiB;
constexpr size_t WS_HID = 142 * MiB;
constexpr size_t WS_QKV = 382 * MiB;
constexpr size_t WS_GATES = 478 * MiB;
constexpr size_t WS_XG = 478 * MiB;
constexpr size_t WS_YS = 478 * MiB;
constexpr size_t WS_RKV = 734 * MiB;
constexpr size_t WS_AP = 926 * MiB;
constexpr size_t WS_MERGED = 734 * MiB;
constexpr size_t WS_X1B = 862 * MiB;
constexpr size_t WS_END = 1024 * MiB;
constexpr size_t OUT_AW = 64 * MiB;

constexpr int LDS_BYTES = 151552;

#define LDS_WAIT() asm volatile("s_waitcnt lgkmcnt(0)" ::: "memory")
DI unsigned f2bf(float f) { unsigned u = __builtin_bit_cast(unsigned, f); return (u + 0x7fffu + ((u >> 16) & 1u)) >> 16; }
DI unsigned pk2(float lo, float hi) { f32x2 v = {lo, hi}; bf16x2_t b = __builtin_convertvector(v, bf16x2_t); return __builtin_bit_cast(unsigned, b); }
DI float bflo(unsigned w) { return __builtin_bit_cast(float, w << 16); }
DI float bfhi(unsigned w) { return __builtin_bit_cast(float, w & 0xffff0000u); }
DI float bf2f(bf16 b) { return __builtin_bit_cast(float, (unsigned)b << 16); }
DI float sigmoidf_(float x) { return __builtin_amdgcn_rcpf(1.0f + __expf(-x)); }
DI float wave_sum(float v) {
#pragma unroll
    for (int o = 1; o < 64; o <<= 1) v += __shfl_xor(v, o);
    return v;
}
DI float wave_max(float v) {
#pragma unroll
    for (int o = 1; o < 64; o <<= 1) v = fmaxf(v, __shfl_xor(v, o));
    return v;
}

struct Args { const float* in[29]; float* out; unsigned char* ws; int ph_lo, ph_hi; };
struct KIn { DI const float* operator[](int i) const { return ((const float* const*)__builtin_amdgcn_kernarg_segment_ptr())[i]; } };
struct DArgs { KIn in; float* out; unsigned char* ws; };

enum { I_X = 0, I_NMG, I_WIN, I_MUP, I_MUN, I_W0F, I_WUPF, I_W0B, I_WUPB, I_A0F, I_AUPF, I_A0B, I_AUPB, I_GUP, I_KK, I_KA, I_RK, I_LNW, I_LNB, I_SINK,
       I_WPR, I_WPA, I_WOUT, I_NFG, I_WR, I_EG, I_EU, I_ED, I_NFINAL };

DI void transpose_item(const float* __restrict__ W, int ldw, int k0, int n0, bf16* WT, size_t drow0, int ldt, int dk0, LAS float* scr, int lane) {
    f32x4 t[8];
#pragma unroll
    for (int i = 0; i < 8; ++i) t[i] = *(const f32x4*)(W + (size_t)(k0 + 8 * i + (lane >> 3)) * ldw + n0 + 4 * (lane & 7));
#pragma unroll
    for (int i = 0; i < 8; ++i) { LAS float* d = scr + (8 * i + (lane >> 3)) * 33 + 4 * (lane & 7); d[0] = t[i][0]; d[1] = t[i][1]; d[2] = t[i][2]; d[3] = t[i][3]; }
    LDS_WAIT(); asm volatile("" ::: "memory");
    const int c = lane & 7;
#pragma unroll
    for (int j = 0; j < 4; ++j) { const int n = (lane >> 3) + 8 * j; const LAS float* s = scr + (8 * c) * 33 + n;
        v4u o; o.x = pk2(s[0 * 33], s[1 * 33]); o.y = pk2(s[2 * 33], s[3 * 33]); o.z = pk2(s[4 * 33], s[5 * 33]); o.w = pk2(s[6 * 33], s[7 * 33]);
        *(v4u*)(WT + (drow0 + n) * (size_t)ldt + dk0 + 8 * c) = o; }
    LDS_WAIT(); asm volatile("" ::: "memory");
}

DI unsigned pk4_fp8(float a, float b, float c, float d) { unsigned w = 0; w = __builtin_amdgcn_cvt_pk_fp8_f32(a, b, w, false); w = __builtin_amdgcn_cvt_pk_fp8_f32(c, d, w, true); return w; }
DI void transpose_item_f8(const float* __restrict__ W, int ldw, int k0, int n0, unsigned char* WT, size_t drow0, int ldt, int dk0, LAS float* scr, int lane, float scale) {
    f32x4 t[8];
#pragma unroll
    for (int i = 0; i < 8; ++i) t[i] = *(const f32x4*)(W + (size_t)(k0 + 8 * i + (lane >> 3)) * ldw + n0 + 4 * (lane & 7));
#pragma unroll
    for (int i = 0; i < 8; ++i) { LAS float* d = scr + (8 * i + (lane >> 3)) * 33 + 4 * (lane & 7); d[0] = t[i][0] * scale; d[1] = t[i][1] * scale; d[2] = t[i][2] * scale; d[3] = t[i][3] * scale; }
    LDS_WAIT(); asm volatile("" ::: "memory");
    const int c = lane & 7;
#pragma unroll
    for (int j = 0; j < 4; ++j) { const int n = (lane >> 3) + 8 * j; const LAS float* s = scr + (8 * c) * 33 + n;
        v2u o; o.x = pk4_fp8(s[0 * 33], s[1 * 33], s[2 * 33], s[3 * 33]); o.y = pk4_fp8(s[4 * 33], s[5 * 33], s[6 * 33], s[7 * 33]);
        *(v2u*)(WT + (drow0 + n) * (size_t)ldt + dk0 + 8 * c) = o; }
    LDS_WAIT(); asm volatile("" ::: "memory");
}

DI void phase0(const DArgs& a, LAS unsigned char* lds, int G, int vcu) {
    const int tid = threadIdx.x, lane = tid & 63, wave = __builtin_amdgcn_readfirstlane(tid >> 6);
    LAS float* scr = (LAS float*)(lds + wave * 16384);
    const int gw = vcu * NWAVES + wave, NGW = G * NWAVES;
    unsigned char* ws = a.ws;
    constexpr int J1 = 16 * 148, J2 = 8 * 32, J3 = J2, J4 = 16 * 32, JE = 16 * 32, J5 = NE * JE;
    constexpr int NITEMS = J1 + J2 + J3 + J4 + 3 * J5;
    for (int it = gw; it < NITEMS; it += NGW) {
        int r = it;
        if (r < J1) { const int kb = r / 148, nb = r % 148;
            if (nb < 84) transpose_item(a.in[I_WIN], NIN, 64 * kb, 32 * nb, (bf16*)(ws + WS_WIN), 32 * nb, D, 64 * kb, scr, lane);
            else transpose_item_f8(a.in[I_WIN], NIN, 64 * kb, 32 * nb, (unsigned char*)(ws + WS_WG8), 32 * nb - 2688, D, 64 * kb, scr, lane, 32.0f);
            continue; } r -= J1;
        if (r < J2) { const int kb = r / 32, nb = r % 32; transpose_item(a.in[I_WPR], D, 64 * kb, 32 * nb, (bf16*)(ws + WS_WPR), 32 * nb, D, 64 * kb, scr, lane); continue; } r -= J2;
        if (r < J3) { const int kb = r / 32, nb = r % 32; transpose_item(a.in[I_WPA], D, 64 * kb, 32 * nb, (bf16*)(ws + WS_WPR), 32 * nb, D, 512 + 64 * kb, scr, lane); continue; } r -= J3;
        if (r < J4) { const int kb = r / 32, nb = r % 32; transpose_item(a.in[I_WOUT], D, 64 * kb, 32 * nb, (bf16*)(ws + WS_WOUT), 32 * nb, D, 64 * kb, scr, lane); continue; } r -= J4;
        if (r < J5) { const int e = r / JE, q = r % JE, kb = q / 32, nb = q % 32, n0 = 32 * nb;
            transpose_item_f8(a.in[I_EG] + (size_t)e * D * FF, FF, 64 * kb, n0, (unsigned char*)(ws + WS_WGU) + (size_t)e * 2048 * D, (n0 / 128) * 256 + (n0 % 128), D, 64 * kb, scr, lane, 32.0f); continue; } r -= J5;
        if (r < J5) { const int e = r / JE, q = r % JE, kb = q / 32, nb = q % 32, n0 = 32 * nb;
            transpose_item_f8(a.in[I_EU] + (size_t)e * D * FF, FF, 64 * kb, n0, (unsigned char*)(ws + WS_WGU) + (size_t)e * 2048 * D, (n0 / 128) * 256 + 128 + (n0 % 128), D, 64 * kb, scr, lane, 32.0f); continue; } r -= J5;
        { const int e = r / JE, q = r % JE, kb = q / 32, nb = q % 32;
            transpose_item_f8(a.in[I_ED] + (size_t)e * FF * D, D, 64 * kb, 32 * nb, (unsigned char*)(ws + WS_WD) + (size_t)e * D * FF, 32 * nb, FF, 64 * kb, scr, lane, 32.0f); }
    }
    {
        bf16* WL = (bf16*)(ws + WS_WLORA);
        const int gt = vcu * NTHREADS + tid, NGT = G * NTHREADS;
        for (int idx = gt; idx < 2560 * 16; idx += NGT) {
            const int n = idx >> 4, k = (idx & 15) * 8;
            const float* src = nullptr; int nn = n, koff = 0, klen = 128;
            if (n < 512) { src = a.in[I_GUP]; }
            else if (n < 1024) { src = a.in[I_WUPF]; nn = n - 512; klen = 64; }
            else if (n < 1536) { src = a.in[I_WUPB]; nn = n - 1024; koff = 64; klen = 64; }
            else if (n < 2048) { src = a.in[I_AUPF]; nn = n - 1536; klen = 64; }
            else { src = a.in[I_AUPB]; nn = n - 2048; koff = 64; klen = 64; }
            float v[8];
#pragma unroll
            for (int j = 0; j < 8; ++j) { const int kk = k + j - koff; v[j] = (kk >= 0 && kk < klen) ? src[(size_t)kk * 512 + nn] : 0.f; }
            v4u o; o.x = pk2(v[0], v[1]); o.y = pk2(v[2], v[3]); o.z = pk2(v[4], v[5]); o.w = pk2(v[6], v[7]);
            *(v4u*)(WL + (size_t)n * 128 + k) = o;
        }
    }
    if (vcu == 0) {
        float* LB = (float*)(ws + WS_LBIAS);
        LB[tid] = a.in[I_W0F][tid]; LB[512 + tid] = a.in[I_W0B][tid]; LB[1024 + tid] = a.in[I_A0F][tid]; LB[1536 + tid] = a.in[I_A0B][tid];
    }
    {
        bf16* H = (bf16*)a.out; unsigned char* H8 = (unsigned char*)a.out + 128 * MiB; const float* x = a.in[I_X]; const float* g = a.in[I_NMG];
        f32x4 gv[4];
#pragma unroll
        for (int j = 0; j < 4; ++j) gv[j] = *(const f32x4*)(g + 4 * lane + 256 * j);
        for (int m = gw * 2; m < M; m += NGW * 2) {
            const f32x4* xr = (const f32x4*)(x + (size_t)m * D) + lane;
            f32x4 v[4], u[4]; float s = 0.f, s2 = 0.f;
#pragma unroll
            for (int j = 0; j < 4; ++j) { v[j] = xr[64 * j]; u[j] = xr[64 * j + D / 4]; }
#pragma unroll
            for (int j = 0; j < 4; ++j) { s += (v[j].x * v[j].x + v[j].y * v[j].y) + (v[j].z * v[j].z + v[j].w * v[j].w); s2 += (u[j].x * u[j].x + u[j].y * u[j].y) + (u[j].z * u[j].z + u[j].w * u[j].w); }
            const float rstd = rsqrtf(wave_sum(s) * (1.f / D) + NORM_EPS), rstd2 = rsqrtf(wave_sum(s2) * (1.f / D) + NORM_EPS);
            v2u* o = (v2u*)(H + (size_t)m * D) + lane; unsigned* o8 = (unsigned*)(H8 + (size_t)m * D) + lane;
#pragma unroll
            for (int j = 0; j < 4; ++j) { const f32x4 h1 = v[j] * rstd * gv[j], h2 = u[j] * rstd2 * gv[j];
                v2u w; w.x = pk2(h1.x, h1.y); w.y = pk2(h1.z, h1.w); o[64 * j] = w; o8[64 * j] = pk4_fp8(h1.x, h1.y, h1.z, h1.w);
                v2u w2; w2.x = pk2(h2.x, h2.y); w2.y = pk2(h2.z, h2.w); o[64 * j + D / 4] = w2; o8[64 * j + D / 4] = pk4_fp8(h2.x, h2.y, h2.z, h2.w); }
        }
    }
}

using pg8::Unit;
struct EpiA {
    static constexpr bool PERM = true, AFTER_DRAIN = false;
    bf16* UR; bf16* QKV; bf16* GATES;
    DI void operator()(const f32x4 (&acc)[2][2][4][2], const Unit& u, int wr, int wc, int fr, int fq) const {
        const int row0 = u.pm * 256 + wr * 64 + fr;
#pragma unroll
        for (int bj = 0; bj < 2; ++bj) {
            const int cb = u.pn * 2 + bj;
            if (cb >= 21) continue;
            bf16* base; int ld, colb, mode;
            if (cb < 15) { base = UR; ld = RC; colb = cb * 128; mode = 0; }
            else if (cb < 21) { base = QKV; ld = NQKV; colb = (cb - 15) * 128; mode = (cb < 19) ? 1 : 0; }
            else { base = GATES; ld = NGATE; colb = (cb - 21) * 128; mode = 2; }
            const int col = colb + wc * 32 + 8 * fq;
#pragma unroll
            for (int ai = 0; ai < 2; ++ai)
#pragma unroll
                for (int m = 0; m < 4; ++m) {
                    f32x4 v0 = acc[ai][bj][m][0], v1 = acc[ai][bj][m][1];
                    if (mode == 1) { v0 = v0 * 0.125f; v1 = v1 * 0.125f; }
                    else if (mode == 2) {
#pragma unroll
                        for (int i = 0; i < 4; ++i) { v0[i] = sigmoidf_(v0[i]); v1[i] = sigmoidf_(v1[i]); }
                    }
                    if (mode == 2) {
                        unsigned q[8];
#pragma unroll
                        for (int i = 0; i < 4; ++i) { q[i] = (unsigned)(v0[i] * 255.0f + 0.5f); q[4 + i] = (unsigned)(v1[i] * 255.0f + 0.5f); }
                        v2u w; w.x = q[0] | (q[1] << 8) | (q[2] << 16) | (q[3] << 24); w.y = q[4] | (q[5] << 8) | (q[6] << 16) | (q[7] << 24);
                        *(v2u*)((unsigned char*)GATES + (size_t)(row0 + ai * 128 + m * 16) * NGATE + col) = w;
                    } else {
                        v4u w; w.x = pk2(v0[0], v0[1]); w.y = pk2(v0[2], v0[3]); w.z = pk2(v1[0], v1[1]); w.w = pk2(v1[2], v1[3]);
                        *(v4u*)(base + (size_t)(row0 + ai * 128 + m * 16) * ld + col) = w;
                    }
                }
        }
    }
};
struct EpiGates {
    static constexpr bool PERM = true, AFTER_DRAIN = false;
    unsigned char* GATES;
    DI void operator()(const f32x4 (&acc)[2][2][4][2], const Unit& u, int wr, int wc, int fr, int fq) const {
        asm volatile("" : "+v"(fr), "+v"(fq));
        const int row0 = u.pm * 256 + wr * 64 + fr;
#pragma unroll
        for (int bj = 0; bj < 2; ++bj) {
            const int col = u.pn * 256 + bj * 128 + wc * 32 + 8 * fq;
#pragma unroll
            for (int ai = 0; ai < 2; ++ai)
#pragma unroll
                for (int m = 0; m < 4; ++m) {
                    unsigned q[8];
#pragma unroll
                    for (int i = 0; i < 4; ++i) { q[i] = (unsigned)(sigmoidf_(acc[ai][bj][m][0][i] * 0.03125f) * 255.0f + 0.5f); q[4 + i] = (unsigned)(sigmoidf_(acc[ai][bj][m][1][i] * 0.03125f) * 255.0f + 0.5f); }
                    v2u w; w.x = q[0] | (q[1] << 8) | (q[2] << 16) | (q[3] << 24); w.y = q[4] | (q[5] << 8) | (q[6] << 16) | (q[7] << 24);
                    *(v2u*)(GATES + (size_t)(row0 + ai * 128 + m * 16) * NGATE + col) = w;
                }
        }
    }
};
struct EpiLoraZ {
    static constexpr bool PERM = true, AFTER_DRAIN = false;
    bf16* Gout; f16* AW; const float* lbias;
    DI void operator()(const f32x4 (&acc)[2][2][4][2], const Unit& u, int wr, int wc, int fr, int fq) const {
        const int row0 = u.pm * 256 + wr * 64 + fr;
        if (u.pn < 2) {
#pragma unroll
            for (int bj = 0; bj < 2; ++bj)
#pragma unroll
                for (int ai = 0; ai < 2; ++ai)
#pragma unroll
                    for (int m = 0; m < 4; ++m) {
                        const f32x4 v0 = acc[ai][bj][m][0], v1 = acc[ai][bj][m][1];
                        v4u w; w.x = pk2(v0[0], v0[1]); w.y = pk2(v0[2], v0[3]); w.z = pk2(v1[0], v1[1]); w.w = pk2(v1[2], v1[3]);
                        *(v4u*)(Gout + (size_t)(row0 + ai * 128 + m * 16) * 512 + u.pn * 256 + bj * 128 + wc * 32 + 8 * fq) = w;
                    }
        } else {
            const int q = u.pn - 2, grp = q >> 2, half = (q >> 1) & 1, cc = (q & 1) * 256 + wc * 32 + 8 * fq;
            f16* dst = (f16*)((unsigned char*)AW + (size_t)((grp == 0 ? 2 : 0) + half) * OUT_AW);
            const float* bias = lbias + (grp * 2 + half) * 512 + cc;
            const float dsc = -DECAY_SCALE * 1.4426950408889634f;
#pragma unroll
            for (int bj = 0; bj < 2; ++bj) {
                const f32x4 b0 = *(const f32x4*)(bias + bj * 128), b1 = *(const f32x4*)(bias + bj * 128 + 4);
#pragma unroll
                for (int ai = 0; ai < 2; ++ai)
#pragma unroll
                    for (int m = 0; m < 4; ++m) {
                        f32x4 v0 = acc[ai][bj][m][0] + b0, v1 = acc[ai][bj][m][1] + b1;
                        asm volatile("" : "+v"(v0), "+v"(v1));
                        f16x8 h;
#pragma unroll
                        for (int i = 0; i < 4; ++i) {
                            float s0 = sigmoidf_(v0[i]), s1 = sigmoidf_(v1[i]);
                            if (grp == 0) { s0 = __builtin_amdgcn_exp2f(dsc * s0); s1 = __builtin_amdgcn_exp2f(dsc * s1); }
                            h[i] = (f16)s0; h[4 + i] = (f16)s1;
                        }
                        *(f16x8*)(dst + (size_t)(row0 + ai * 128 + m * 16) * 512 + cc + bj * 128) = h;
                    }
            }
        }
    }
};
struct EpiMerge2 {
    static constexpr bool PERM = true, AFTER_DRAIN = false;
    bf16* MG; const unsigned char* GATES;
#define EPI_MEMBAR asm volatile("" ::: "memory")
    DI void mid(f32x4 (&acc)[2][2][4][2], const Unit& u, int wr, int wc, int fr, int fq) const {
        const int row0 = u.pm * 256 + wr * 64 + fr;
        v2u gr[2][2][4], ga[2][2][4];
#pragma unroll
        for (int bj = 0; bj < 2; ++bj) {
            const int col = u.pn * 256 + bj * 128 + wc * 32 + 8 * fq;
#pragma unroll
            for (int ai = 0; ai < 2; ++ai)
#pragma unroll
                for (int m = 0; m < 4; ++m) {
                    const size_t row = (size_t)(row0 + ai * 128 + m * 16);
                    gr[bj][ai][m] = *(const v2u*)(GATES + row * NGATE + col); ga[bj][ai][m] = *(const v2u*)(GATES + row * NGATE + 1024 + col);
                }
        }
        EPI_MEMBAR;
#pragma unroll
        for (int bj = 0; bj < 2; ++bj)
#pragma unroll
            for (int ai = 0; ai < 2; ++ai)
#pragma unroll
                for (int m = 0; m < 4; ++m) {
                    const unsigned grw[2] = {gr[bj][ai][m].x, gr[bj][ai][m].y}, gaw[2] = {ga[bj][ai][m].x, ga[bj][ai][m].y};
#pragma unroll
                    for (int n = 0; n < 2; ++n)
#pragma unroll
                        for (int i = 0; i < 4; ++i) {
                            const float fr_ = (float)((grw[n] >> (8 * i)) & 0xffu), fa_ = fmaxf((float)((gaw[n] >> (8 * i)) & 0xffu), 0.25f);
                            acc[ai][bj][m][n][i] *= fr_ * __builtin_amdgcn_rcpf(fa_);
                        }
                }
    }
    DI void operator()(const f32x4 (&acc)[2][2][4][2], const Unit& u, int wr, int wc, int fr, int fq) const {
        const int row0 = u.pm * 256 + wr * 64 + fr;
        v2u ga[2][2][4];
#pragma unroll
        for (int bj = 0; bj < 2; ++bj) {
            const int col = u.pn * 256 + bj * 128 + wc * 32 + 8 * fq;
#pragma unroll
            for (int ai = 0; ai < 2; ++ai)
#pragma unroll
                for (int m = 0; m < 4; ++m) ga[bj][ai][m] = *(const v2u*)(GATES + (size_t)(row0 + ai * 128 + m * 16) * NGATE + 1024 + col);
        }
        EPI_MEMBAR;
#pragma unroll
        for (int bj = 0; bj < 2; ++bj) {
            const int col = u.pn * 256 + bj * 128 + wc * 32 + 8 * fq;
#pragma unroll
            for (int ai = 0; ai < 2; ++ai)
#pragma unroll
                for (int m = 0; m < 4; ++m) {
                    const size_t row = (size_t)(row0 + ai * 128 + m * 16);
                    const unsigned gaw[2] = {ga[bj][ai][m].x, ga[bj][ai][m].y};
                    float o[8];
#pragma unroll
                    for (int n = 0; n < 2; ++n)
#pragma unroll
                        for (int i = 0; i < 4; ++i) o[4 * n + i] = acc[ai][bj][m][n][i] * (fmaxf((float)((gaw[n] >> (8 * i)) & 0xffu), 0.25f) * (1.0f / 255.0f));
                    v4u w; w.x = pk2(o[0], o[1]); w.y = pk2(o[2], o[3]); w.z = pk2(o[4], o[5]); w.w = pk2(o[6], o[7]);
                    *(v4u*)(MG + row * D + col) = w;
                }
        }
    }
};
struct EpiResid {
    static constexpr bool PERM = true, AFTER_DRAIN = false;
    const float* X; bf16* O;
    DI void operator()(const f32x4 (&acc)[2][2][4][2], const Unit& u, int wr, int wc, int fr, int fq) const {
        const int row0 = u.pm * 256 + wr * 64 + fr, col0 = u.pn * 256 + wc * 32 + 8 * fq;
        f32x4 xa[2][2][2], xb[2][2][2];
#define EPIR_LOAD(xv, b) do { _Pragma("unroll") for (int mm = 0; mm < 2; ++mm) { const size_t off = (size_t)(row0 + ((b) >> 1) * 128 + (((b) & 1) * 2 + mm) * 16) * D + col0; \
            _Pragma("unroll") for (int bj = 0; bj < 2; ++bj) { xv[mm][bj][0] = *(const f32x4*)(X + off + bj * 128); xv[mm][bj][1] = *(const f32x4*)(X + off + bj * 128 + 4); } } } while (0)
#define EPIR_PROC(xv, b) do { _Pragma("unroll") for (int mm = 0; mm < 2; ++mm) { const int ai = (b) >> 1, m = ((b) & 1) * 2 + mm; const size_t off = (size_t)(row0 + ai * 128 + m * 16) * D + col0; \
            _Pragma("unroll") for (int bj = 0; bj < 2; ++bj) { const f32x4 v0 = xv[mm][bj][0] + acc[ai][bj][m][0], v1 = xv[mm][bj][1] + acc[ai][bj][m][1]; \
                v4u w; w.x = pk2(v0[0], v0[1]); w.y = pk2(v0[2], v0[3]); w.z = pk2(v1[0], v1[1]); w.w = pk2(v1[2], v1[3]); *(v4u*)(O + off + bj * 128) = w; } } } while (0)
        EPIR_LOAD(xa, 0); EPIR_LOAD(xb, 1); EPI_MEMBAR;
        EPIR_PROC(xa, 0); EPI_MEMBAR; EPIR_LOAD(xa, 2); EPI_MEMBAR;
        EPIR_PROC(xb, 1); EPI_MEMBAR; EPIR_LOAD(xb, 3); EPI_MEMBAR;
        EPIR_PROC(xa, 2); EPI_MEMBAR;
        EPIR_PROC(xb, 3);
#undef EPIR_LOAD
#undef EPIR_PROC
    }
};
struct EpiSwiglu {
    static constexpr bool PERM = true, AFTER_DRAIN = false;
    unsigned char* HID;
    DI void operator()(const f32x4 (&acc)[2][2][4][2], const Unit& u, int wr, int wc, int fr, int fq) const {
        asm volatile("" : "+v"(fr), "+v"(fq));
        const int row0 = u.pm * 256 + wr * 64 + fr, col = u.pn * 128 + wc * 32 + 8 * fq;
#pragma unroll
        for (int ai = 0; ai < 2; ++ai)
#pragma unroll
            for (int m = 0; m < 4; ++m) {
                float o[8];
#pragma unroll
                for (int n = 0; n < 2; ++n)
#pragma unroll
                    for (int i = 0; i < 4; ++i) { const float gt = acc[ai][0][m][n][i] * 0.03125f, up = acc[ai][1][m][n][i] * 0.03125f; o[4 * n + i] = gt * sigmoidf_(gt) * up; }
                v2u w; w.x = pk4_fp8(o[0], o[1], o[2], o[3]); w.y = pk4_fp8(o[4], o[5], o[6], o[7]);
                *(v2u*)(HID + (size_t)(row0 + ai * 128 + m * 16) * FF + col) = w;
            }
    }
};
struct EpiYs {
    static constexpr bool PERM = true, AFTER_DRAIN = false;
    bf16* YS; const float* VAL;
    DI void operator()(const f32x4 (&acc)[2][2][4][2], const Unit& u, int wr, int wc, int fr, int fq) const {
        asm volatile("" : "+v"(fr), "+v"(fq));
        const int row0 = u.pm * 256 + wr * 64 + fr;
        float svv[2][4];
#pragma unroll
        for (int ai = 0; ai < 2; ++ai)
#pragma unroll
            for (int m = 0; m < 4; ++m) svv[ai][m] = VAL[(size_t)(row0 + ai * 128 + m * 16)];
        EPI_MEMBAR;
#pragma unroll
        for (int ai = 0; ai < 2; ++ai)
#pragma unroll
            for (int m = 0; m < 4; ++m) {
                const size_t row = (size_t)(row0 + ai * 128 + m * 16);
                const float sv = svv[ai][m] * 0.03125f;
#pragma unroll
                for (int bj = 0; bj < 2; ++bj) {
                    const int col = u.pn * 256 + bj * 128 + wc * 32 + 8 * fq;
                    const f32x4 v0 = acc[ai][bj][m][0] * sv, v1 = acc[ai][bj][m][1] * sv;
                    v4u w; w.x = pk2(v0[0], v0[1]); w.y = pk2(v0[2], v0[3]); w.z = pk2(v1[0], v1[1]); w.w = pk2(v1[2], v1[3]);
                    *(v4u*)(YS + row * D + col) = w;
                }
            }
    }
};

DI void phaseP1(const DArgs& a, LAS unsigned char* lds, int own) {
    const int tid = threadIdx.x, lane = tid & 63, wave = __builtin_amdgcn_readfirstlane(tid >> 6);
    unsigned char* ws = a.ws;
    const bf16* UR = (const bf16*)(ws + WS_UR);
    f16* RKV = (f16*)(ws + WS_RKV); bf16* AP = (bf16*)(ws + WS_AP);
    float mp[4][8], mn[4][8], kc[8];
#pragma unroll
    for (int i = 0; i < 4; ++i) { const int cidx = lane + 64 * i; const int col = (cidx < RC / 8 ? cidx : 0) * 8;
#pragma unroll
        for (int j = 0; j < 8; ++j) { mp[i][j] = a.in[I_MUP][col + j]; mn[i][j] = a.in[I_MUN][col + j]; } }
#pragma unroll
    for (int j = 0; j < 8; ++j) kc[j] = a.in[I_KK][lane * 8 + j];
    const bool act3 = lane + 192 < RC / 8;
#define P1_LOADROW(dst, rowp) do { _Pragma("unroll") for (int i_ = 0; i_ < 4; ++i_) { if (i_ < 3 || act3) dst[i_] = *(const v4u*)((rowp) + (lane + 64 * i_) * 8); else dst[i_] = (v4u){0u, 0u, 0u, 0u}; } } while (0)
    { const int r0 = own * 256 + wave * 32;
        const int t0 = r0 & (T - 1);
        const bf16* rp = UR + (size_t)r0 * RC;
        v4u prev[4], cur[4], nxt[4], nn[4];
        if (t0 > 0) P1_LOADROW(prev, rp - RC); else { _Pragma("unroll") for (int i = 0; i < 4; ++i) prev[i] = (v4u){0u, 0u, 0u, 0u}; }
        P1_LOADROW(cur, rp); P1_LOADROW(nxt, rp + RC);
#pragma unroll 1
        for (int r = 0; r < 32; ++r) {
            const int m = r0 + r, t = t0 + r;
            if (t + 2 < T) P1_LOADROW(nn, rp + (size_t)(r + 2) * RC); else { _Pragma("unroll") for (int i = 0; i < 4; ++i) nn[i] = (v4u){0u, 0u, 0u, 0u}; }
#pragma unroll
            for (int i = 0; i < 4; ++i) {
                if (i < 3 || act3) {
                    const int col = (lane + 64 * i) * 8;
                    float o[8];
                    const unsigned ucw[4] = {cur[i].x, cur[i].y, cur[i].z, cur[i].w}, upw[4] = {prev[i].x, prev[i].y, prev[i].z, prev[i].w}, unw[4] = {nxt[i].x, nxt[i].y, nxt[i].z, nxt[i].w};
#pragma unroll
                    for (int j = 0; j < 4; ++j) {
                        const float c0 = bflo(ucw[j]), c1 = bfhi(ucw[j]), p0 = bflo(upw[j]), p1 = bfhi(upw[j]), n0 = bflo(unw[j]), n1 = bfhi(unw[j]);
                        o[2 * j] = c0 + mp[i][2 * j] * (p0 - c0) + mn[i][2 * j] * (n0 - c0);
                        o[2 * j + 1] = c1 + mp[i][2 * j + 1] * (p1 - c1) + mn[i][2 * j + 1] * (n1 - c1);
                    }
                    if (i == 1) {
                        float ssq = 0.f;
#pragma unroll
                        for (int j = 0; j < 8; ++j) { const float e0 = o[j] * kc[j]; ssq += e0 * e0; }
                        ssq += __shfl_xor(ssq, 1); ssq += __shfl_xor(ssq, 2); ssq += __shfl_xor(ssq, 4);
                        if ((lane & 7) == 0) ((float*)(ws + WS_KN))[(size_t)m * 8 + (lane >> 3)] = 1.0f / fmaxf(sqrtf(ssq), 1e-12f);
                    }
                    if (i < 3) {
                        f16x8 h;
#pragma unroll
                        for (int j = 0; j < 8; ++j) h[j] = (f16)o[j];
                        *(f16x8*)(RKV + (size_t)i * ((size_t)M * 512) + (size_t)m * 512 + lane * 8) = h;
                    } else {
                        const int ac = lane * 8;
                        if (ac < 128) {
#pragma unroll
                            for (int j = 0; j < 8; ++j) o[j] = sigmoidf_(o[j]);
                        } else if (ac < 256) {
#pragma unroll
                            for (int j = 0; j < 8; ++j) o[j] = tanhf(o[j]);
                        }
                        v4u w; w.x = pk2(o[0], o[1]); w.y = pk2(o[2], o[3]); w.z = pk2(o[4], o[5]); w.w = pk2(o[6], o[7]);
                        *(v4u*)(AP + (size_t)m * NLK + ac) = w;
                    }
                }
            }
#pragma unroll
            for (int i = 0; i < 4; ++i) { prev[i] = cur[i]; cur[i] = nxt[i]; nxt[i] = nn[i]; }
        }
    }
#undef P1_LOADROW
    {
        const bf16* QKV = (const bf16*)(ws + WS_QKV); bf16* VT = (bf16*)(ws + WS_VT);
        LAS bf16* tile = (LAS bf16*)lds;
        for (int tl = own * 4; tl < own * 4 + 4; ++tl) {
            const int m0 = tl * 64, b = m0 / T, t0 = m0 % T;
            __syncthreads();
#pragma unroll
            for (int i = 0; i < 2; ++i) { const int ch = tid + 512 * i, r = ch >> 4, c8 = (ch & 15) * 8;
                const v4u v = *(const v4u*)(QKV + (size_t)(m0 + r) * NQKV + 640 + c8);
                *(LAS v4u*)(tile + r * 136 + c8) = v; }
            __syncthreads();
#pragma unroll
            for (int i = 0; i < 2; ++i) { const int ch = tid + 512 * i, dcol = ch >> 3, tq = (ch & 7) * 8;
                unsigned short e[8];
#pragma unroll
                for (int j = 0; j < 8; ++j) e[j] = tile[(tq + j) * 136 + dcol];
                v4u w; w.x = e[0] | ((unsigned)e[1] << 16); w.y = e[2] | ((unsigned)e[3] << 16); w.z = e[4] | ((unsigned)e[5] << 16); w.w = e[6] | ((unsigned)e[7] << 16);
                *(v4u*)(VT + ((size_t)(b * 2 + (dcol >> 6)) * 64 + (dcol & 63)) * T + t0 + tq) = w; }
        }
        __syncthreads();
    }
}

DI f32x16 mfma32(const bf16x8 a, const bf16x8 b, const f32x16 c) { return __builtin_amdgcn_mfma_f32_32x32x16_bf16(a, b, c, 0, 0, 0); }
DI bf16x8 packlo(const f32x16& x) { v4u p; p.x = pk2(x[0], x[1]); p.y = pk2(x[2], x[3]); p.z = pk2(x[4], x[5]); p.w = pk2(x[6], x[7]); return __builtin_bit_cast(bf16x8, p); }
DI bf16x8 packhi(const f32x16& x) { v4u p; p.x = pk2(x[8], x[9]); p.y = pk2(x[10], x[11]); p.z = pk2(x[12], x[13]); p.w = pk2(x[14], x[15]); return __builtin_bit_cast(bf16x8, p); }
DI f32x16 zero16() { f32x16 z;
#pragma unroll
    for (int i = 0; i < 16; ++i) z[i] = 0.f;
    return z; }
DI int crow(int reg, int hh) { return (reg & 3) + 8 * (reg >> 2) + 4 * hh; }
DI bf16x8 ldperm(const LAS bf16* rowp, int ks, int hh) {
    const v2u lo = *(const LAS v2u*)(rowp + 16 * ks + 4 * hh), hi = *(const LAS v2u*)(rowp + 16 * ks + 8 + 4 * hh);
    v4u w; w.x = lo.x; w.y = lo.y; w.z = hi.x; w.w = hi.y; return __builtin_bit_cast(bf16x8, w);
}
#define SCAN_DEP(cv, val) asm volatile("" : "+v"(cv) : "v"(val))
constexpr int TJS = 72, JSS = 40;
constexpr int CH_TJ = 0, CH_JS = 18432, CH_JSB = 20480, CH_GL = CH_JS + 2 * CH_JSB, CH_FLAG = CH_GL + 512, CHAIN_LDS = CH_FLAG + 128;
DI int ld_flag(volatile LAS int* p) { return *p; }
constexpr int CH_RAW = CH_FLAG + 128, RAW_SLOT = 5 * 1024 + 256, CH_YT = CH_RAW + 2 * RAW_SLOT, YT_RS = 144, CHAIN_LDS2 = CH_YT + 32 * YT_RS;
DI void scan_dma_block(const DArgs& a, LAS unsigned char* slotp, int blk, int dir, size_t rowbase, int h, unsigned lane_off, unsigned lane_off_kn) {
    unsigned char* ws = a.ws;
    const int p0 = blk * 8, tl = dir ? T - 1 - p0 - 7 : p0;
#pragma unroll
    for (int arr = 0; arr < 5; ++arr) {
        const unsigned char* base = arr < 3 ? (const unsigned char*)(ws + WS_RKV) + (size_t)arr * ((size_t)M * 512 * 2)
                                            : (const unsigned char*)a.out + (size_t)((arr == 3 ? 0 : 2) + dir) * OUT_AW;
        const unsigned char* ub = base + ((rowbase + tl) * 512 + h * 64) * 2;
        __builtin_amdgcn_global_load_lds((const unsigned*)(ub + lane_off), (LAS unsigned*)(slotp + arr * 1024), 16, 0, 0);
    }
    { const unsigned char* ub = (const unsigned char*)(ws + WS_KN) + ((rowbase + tl) * 8 + h) * 4;
      __builtin_amdgcn_global_load_lds((const unsigned*)(ub + lane_off_kn), (LAS unsigned*)(slotp + 5 * 1024), 4, 0, 0); }
}
DI void scan_producer(const DArgs& a, LAS unsigned char* cl, int chain, int lane) {
    const int dir = chain & 1, h = (chain >> 1) & 7, b = chain >> 4;
    const size_t rowbase = (size_t)b * T;
    LAS bf16* Qh = (LAS bf16*)(cl + CH_TJ); LAS bf16* Rh = Qh + 32 * TJS; LAS bf16* Bc = Rh + 32 * TJS; LAS bf16* Kc = Bc + 32 * TJS;
    volatile LAS int* flag = (volatile LAS int*)(cl + CH_FLAG);
    const int chn = h * 64 + lane;
    const float kkc = a.in[I_KK][chn], kac = a.in[I_KA][chn];
    const unsigned lane_off = (unsigned)((dir ? 7 - (lane >> 3) : (lane >> 3)) * 1024 + (lane & 7) * 16);
    const unsigned lane_off_kn = (unsigned)((dir ? 7 - (lane & 7) : (lane & 7)) * 32);
    asm volatile("s_waitcnt vmcnt(0)" ::: "memory");
    scan_dma_block(a, cl + CH_RAW, 0, dir, rowbase, h, lane_off, lane_off_kn);
    scan_dma_block(a, cl + CH_RAW + RAW_SLOT, 1, dir, rowbase, h, lane_off, lane_off_kn);
    for (int chunk = 0; chunk < T / 32; ++chunk) {
        const int buf = chunk & 1;
        LAS bf16* QhT = (LAS bf16*)(cl + CH_JS + buf * CH_JSB); LAS bf16* BcT = QhT + 64 * JSS; LAS bf16* KcT = BcT + 64 * JSS; LAS bf16* VT = KcT + 64 * JSS;
        LAS float* GL = (LAS float*)(cl + CH_GL + buf * 256);
        while (ld_flag(flag + 1) < chunk || ld_flag(flag + 2) < chunk - 1) __builtin_amdgcn_s_sleep(2);
        asm volatile("" ::: "memory");
        float g = 1.f;
#pragma unroll 1
        for (int tb = 0; tb < 4; ++tb) {
            const int blk = chunk * 4 + tb;
            LAS unsigned char* slotp = cl + CH_RAW + (tb & 1) * RAW_SLOT;
            const LAS f16* RAW = (const LAS f16*)slotp; const LAS float* KNL = (const LAS float*)(slotp + 5 * 1024);
            if (blk + 1 < T / 8) asm volatile("s_waitcnt vmcnt(6)" ::: "memory"); else asm volatile("s_waitcnt vmcnt(0)" ::: "memory");
            unsigned qw[4], bw[4], kw[4], vw[4];
            f16 rraw[8], kraw[8], vraw[8], araw[8], wraw[8]; float knv[8];
#pragma unroll
            for (int u = 0; u < 8; ++u) { rraw[u] = RAW[0 * 512 + u * 64 + lane]; kraw[u] = RAW[1 * 512 + u * 64 + lane]; vraw[u] = RAW[2 * 512 + u * 64 + lane]; araw[u] = RAW[3 * 512 + u * 64 + lane]; wraw[u] = RAW[4 * 512 + u * 64 + lane]; }
            { const f32x4 k0_ = *(const LAS f32x4*)KNL, k1_ = *(const LAS f32x4*)(KNL + 4);
#pragma unroll
              for (int u = 0; u < 4; ++u) { knv[u] = k0_[u]; knv[4 + u] = k1_[u]; } }
            LDS_WAIT(); asm volatile("" ::: "memory");
            if (blk + 2 < T / 8) { unsigned lo1 = lane_off, lo2 = lane_off_kn; asm volatile("" : "+v"(lo1), "+v"(lo2));
                scan_dma_block(a, slotp, blk + 2, dir, rowbase, h, lo1, lo2); }
#pragma unroll
            for (int u2 = 0; u2 < 4; ++u2) {
                float qv[2], rv[2], bv[2], kv[2], vv[2];
#pragma unroll
                for (int e = 0; e < 2; ++e) {
                    const int u = 2 * u2 + e;
                    const float r = (float)rraw[u], k = (float)kraw[u], v = (float)vraw[u];
                    const float av = (float)araw[u], w = (float)wraw[u];
                    const float invn = knv[u];
                    const float gprev = g; g *= w; const float ginv = __builtin_amdgcn_rcpf(g);
                    const float kk = k * kkc * invn, kt = k * (1.0f + (av - 1.0f) * kac), bb = av * kk;
                    qv[e] = kk * gprev; rv[e] = r * g; bv[e] = bb * ginv; kv[e] = kt * ginv; vv[e] = v;
                }
                const int tau = 8 * tb + 2 * u2;
                const unsigned q2 = pk2(qv[0], qv[1]), r2 = pk2(rv[0], rv[1]), b2 = pk2(bv[0], bv[1]), k2 = pk2(kv[0], kv[1]);
                Qh[tau * TJS + lane] = (bf16)(q2 & 0xffffu); Qh[(tau + 1) * TJS + lane] = (bf16)(q2 >> 16);
                Rh[tau * TJS + lane] = (bf16)(r2 & 0xffffu); Rh[(tau + 1) * TJS + lane] = (bf16)(r2 >> 16);
                Bc[tau * TJS + lane] = (bf16)(b2 & 0xffffu); Bc[(tau + 1) * TJS + lane] = (bf16)(b2 >> 16);
                Kc[tau * TJS + lane] = (bf16)(k2 & 0xffffu); Kc[(tau + 1) * TJS + lane] = (bf16)(k2 >> 16);
                qw[u2] = q2 ^ 0x80008000u; bw[u2] = b2; kw[u2] = k2; vw[u2] = pk2(vv[0], vv[1]);
            }
            *(LAS v4u*)(QhT + lane * JSS + 8 * tb) = (v4u){qw[0], qw[1], qw[2], qw[3]};
            *(LAS v4u*)(BcT + lane * JSS + 8 * tb) = (v4u){bw[0], bw[1], bw[2], bw[3]};
            *(LAS v4u*)(KcT + lane * JSS + 8 * tb) = (v4u){kw[0], kw[1], kw[2], kw[3]};
            *(LAS v4u*)(VT + lane * JSS + 8 * tb) = (v4u){vw[0], vw[1], vw[2], vw[3]};
        }
        GL[lane] = g;
        LDS_WAIT(); asm volatile("" ::: "memory");
        if (lane == 0) flag[0] = chunk + 1;
        asm volatile("" ::: "memory");
    }
}
template <int DIR> DI void scan_consumer(const DArgs& a, LAS unsigned char* cl, int chain, int lane) {
    unsigned char* ws = a.ws;
    const int h = (chain >> 1) & 7, b = chain >> 4;
    const int c = lane & 31, hh = lane >> 5;
    const size_t rowbase = (size_t)b * T;
    const LAS bf16* Qh = (const LAS bf16*)(cl + CH_TJ); const LAS bf16* Rh = Qh + 32 * TJS; const LAS bf16* Bc = Rh + 32 * TJS; const LAS bf16* Kc = Bc + 32 * TJS;
    volatile LAS int* flag = (volatile LAS int*)(cl + CH_FLAG);
    f16* Y = (f16*)(ws + (DIR ? WS_YB : WS_YF));
    bf16x8 xs[2][2][2];
#pragma unroll
    for (int q = 0; q < 8; ++q) xs[q >> 2][(q >> 1) & 1][q & 1] = (bf16x8){0, 0, 0, 0, 0, 0, 0, 0};
    f32x16 eye;
#pragma unroll
    for (int i = 0; i < 16; ++i) eye[i] = (crow(i, hh) == c) ? 1.f : 0.f;
    LAS unsigned char* YT = cl + CH_YT;
    LAS unsigned char* ytw = YT + c * YT_RS + 8 * hh;
    const LAS unsigned char* ytr = YT + (lane >> 3) * YT_RS + (lane & 7) * 16;
    f16* ybase = Y + (rowbase + (DIR ? T - 1 - (lane >> 3) : (lane >> 3))) * 512 + h * 64 + (lane & 7) * 8;
    for (int chunk = 0; chunk < T / 32; ++chunk) {
        const int buf = chunk & 1;
        const LAS bf16* QhT = (const LAS bf16*)(cl + CH_JS + buf * CH_JSB); const LAS bf16* BcT = QhT + 64 * JSS; const LAS bf16* KcT = BcT + 64 * JSS; const LAS bf16* VT = KcT + 64 * JSS;
        const LAS float* GL = (const LAS float*)(cl + CH_GL + buf * 256);
        while (ld_flag(flag) < chunk + 1) __builtin_amdgcn_s_sleep(1);
        asm volatile("" ::: "memory");
        f32x16 nN = zero16(), nT = zero16(), akT = zero16(), rbT = zero16(), rkT = zero16();
        v2u rhc[2][4];
        {
            bf16x8 fq[4], fb[4], fk[4], fr[4];
#pragma unroll
            for (int ks = 0; ks < 4; ++ks) {
                fq[ks] = *(const LAS bf16x8*)(Qh + c * TJS + 16 * ks + 8 * hh); fb[ks] = *(const LAS bf16x8*)(Bc + c * TJS + 16 * ks + 8 * hh);
                fk[ks] = *(const LAS bf16x8*)(Kc + c * TJS + 16 * ks + 8 * hh); fr[ks] = *(const LAS bf16x8*)(Rh + c * TJS + 16 * ks + 8 * hh);
            }
#pragma unroll
            for (int jb = 0; jb < 2; ++jb)
#pragma unroll
                for (int g4 = 0; g4 < 4; ++g4) rhc[jb][g4] = *(const LAS v2u*)(Rh + c * TJS + 32 * jb + 8 * g4 + 4 * hh);
            v4u yq[4];
            if (chunk > 0) {
#pragma unroll
                for (int j = 0; j < 4; ++j) yq[j] = *(const LAS v4u*)(ytr + 8 * j * YT_RS);
            }
            LDS_WAIT(); asm volatile("" ::: "memory");
            if (lane == 0) flag[1] = chunk + 1;
            asm volatile("" ::: "memory");
            if (chunk > 0) {
                f16* yp = ybase + (DIR ? -((chunk - 1) * 32 * 512) : (chunk - 1) * 32 * 512);
#pragma unroll
                for (int j = 0; j < 4; ++j) *(v4u*)(yp + (DIR ? -(8 * j * 512) : 8 * j * 512)) = yq[j];
            }
#pragma unroll
            for (int ks = 0; ks < 4; ++ks) {
                nN = mfma32(fq[ks], fb[ks], nN); nT = mfma32(fb[ks], fq[ks], nT); akT = mfma32(fk[ks], fq[ks], akT); rbT = mfma32(fb[ks], fr[ks], rbT); rkT = mfma32(fk[ks], fr[ks], rkT);
            }
        }
        __builtin_amdgcn_sched_barrier(0);
        f32x16 TT;
#pragma unroll
        for (int i = 0; i < 16; ++i) { const int rw = crow(i, hh);
            nN[i] = (c < rw) ? nN[i] : 0.f; nT[i] = (rw < c) ? nT[i] : 0.f; akT[i] = (rw < c) ? -akT[i] : 0.f;
            rbT[i] = (rw <= c) ? rbT[i] : 0.f; rkT[i] = (rw <= c) ? rkT[i] : 0.f; TT[i] = eye[i] - nT[i]; }
        bf16x8 pN0 = packlo(nN), pN1 = packhi(nN), pNT0 = packlo(nT), pNT1 = packhi(nT);
        const bf16x8 pAK0 = packlo(akT), pAK1 = packhi(akT), pRB0 = packlo(rbT), pRB1 = packhi(rbT), pRK0 = packlo(rkT), pRK1 = packhi(rkT);
        __builtin_amdgcn_sched_barrier(0);
#pragma unroll
        for (int lvl = 1; lvl <= 4; ++lvl) {
            f32x16 n2 = mfma32(pNT0, pN0, zero16()); n2 = mfma32(pNT1, pN1, n2);
            if (lvl < 4) { f32x16 n2T = mfma32(pN0, pNT0, zero16()); n2T = mfma32(pN1, pNT1, n2T); pNT0 = packlo(n2T); pNT1 = packhi(n2T); }
            pN0 = packlo(n2); pN1 = packhi(n2);
            const bf16x8 pT0 = packlo(TT), pT1 = packhi(TT);
            TT = mfma32(pN0, pT0, TT); TT = mfma32(pN1, pT1, TT);
            __builtin_amdgcn_sched_barrier(0);
        }
        const bf16x8 pTT0 = packlo(TT), pTT1 = packhi(TT);
        __builtin_amdgcn_sched_barrier(0);
        bf16x8 pQ[2][2];
        int cq = c; SCAN_DEP(cq, TT[15]);
        float depq = 0.f;
#pragma unroll
        for (int jt = 0; jt < 2; ++jt) {
            f32x16 acc = mfma32(pTT0, ldperm(QhT + (32 * jt + cq) * JSS, 0, hh), zero16());
            acc = mfma32(pTT1, ldperm(QhT + (32 * jt + cq) * JSS, 1, hh), acc);
            pQ[jt][0] = packlo(acc); pQ[jt][1] = packhi(acc); depq = acc[15];
        }
        __builtin_amdgcn_sched_barrier(0);
        bf16x8 vtp[2][2];
        int cv = c; SCAN_DEP(cv, depq);
#pragma unroll
        for (int it = 0; it < 2; ++it) { vtp[it][0] = ldperm(VT + (32 * it + cv) * JSS, 0, hh); vtp[it][1] = ldperm(VT + (32 * it + cv) * JSS, 1, hh); }
        bf16x8 pU[2][2]; float depu = 0.f;
#pragma unroll
        for (int it = 0; it < 2; ++it) {
            f32x16 w1 = mfma32(pAK0, vtp[it][0], zero16()); w1 = mfma32(pAK1, vtp[it][1], w1);
            const bf16x8 pw0 = packlo(w1), pw1 = packhi(w1);
            f32x16 u0 = mfma32(pTT0, pw0, zero16()); u0 = mfma32(pTT1, pw1, u0);
            pU[it][0] = packlo(u0); pU[it][1] = packhi(u0); depu = u0[15];
            __builtin_amdgcn_sched_barrier(0);
        }
        bf16x8 pR[2][2]; float depr = 0.f;
#pragma unroll
        for (int jb = 0; jb < 2; ++jb) {
            f32x16 rt;
#pragma unroll
            for (int g4 = 0; g4 < 4; ++g4) { const v2u rr = rhc[jb][g4]; rt[4 * g4] = bflo(rr.x); rt[4 * g4 + 1] = bfhi(rr.x); rt[4 * g4 + 2] = bflo(rr.y); rt[4 * g4 + 3] = bfhi(rr.y); }
            rt = mfma32(pQ[jb][0], pRB0, rt); rt = mfma32(pQ[jb][1], pRB1, rt);
            pR[jb][0] = packlo(rt); pR[jb][1] = packhi(rt); depr = rt[15];
            __builtin_amdgcn_sched_barrier(0);
        }
        bf16x8 pP[2][2][2]; float depp = 0.f;
        bf16x8 bcp[2][2];
        {
            int cp = c; SCAN_DEP(cp, depr);
#pragma unroll
            for (int jb = 0; jb < 2; ++jb) { bcp[jb][0] = ldperm(BcT + (32 * jb + cp) * JSS, 0, hh); bcp[jb][1] = ldperm(BcT + (32 * jb + cp) * JSS, 1, hh); }
#pragma unroll
            for (int jb = 0; jb < 2; ++jb)
#pragma unroll
                for (int jpb = 0; jpb < 2; ++jpb) {
                    f32x16 m = mfma32(pQ[jb][0], bcp[jpb][0], jb == jpb ? eye : zero16()); m = mfma32(pQ[jb][1], bcp[jpb][1], m);
                    pP[jb][jpb][0] = packlo(m); pP[jb][jpb][1] = packhi(m); depp = m[15];
                    __builtin_amdgcn_sched_barrier(0);
                }
        }
#pragma unroll
        for (int ib = 0; ib < 2; ++ib) {
            const bf16x8 x0l = xs[ib][0][0], x0h = xs[ib][0][1], x1l = xs[ib][1][0], x1h = xs[ib][1][1];
            {
                f32x16 y = mfma32(pU[ib][0], pRB0, zero16()); y = mfma32(pU[ib][1], pRB1, y);
                y = mfma32(vtp[ib][0], pRK0, y); y = mfma32(vtp[ib][1], pRK1, y);
                y = mfma32(x0l, pR[0][0], y); y = mfma32(x0h, pR[0][1], y);
                y = mfma32(x1l, pR[1][0], y); y = mfma32(x1h, pR[1][1], y);
#pragma unroll
                for (int g4 = 0; g4 < 4; ++g4) { const f16x4 hv = {(f16)y[4 * g4], (f16)y[4 * g4 + 1], (f16)y[4 * g4 + 2], (f16)y[4 * g4 + 3]}; *(LAS f16x4*)(ytw + 64 * ib + 16 * g4) = hv; }
                __builtin_amdgcn_sched_barrier(0);
            }
            f32x16 accn[2];
#pragma unroll
            for (int jpb = 0; jpb < 2; ++jpb) {
                int ch2 = c, hh2 = hh; SCAN_DEP(ch2, depp); SCAN_DEP(hh2, depp);
                f32x16 acc = mfma32(bcp[jpb][0], pU[ib][0], zero16()); acc = mfma32(bcp[jpb][1], pU[ib][1], acc);
                acc = mfma32(ldperm(KcT + (32 * jpb + ch2) * JSS, 0, hh2), vtp[ib][0], acc); acc = mfma32(ldperm(KcT + (32 * jpb + ch2) * JSS, 1, hh2), vtp[ib][1], acc);
                acc = mfma32(pP[0][jpb][0], x0l, acc); acc = mfma32(pP[0][jpb][1], x0h, acc);
                acc = mfma32(pP[1][jpb][0], x1l, acc); acc = mfma32(pP[1][jpb][1], x1h, acc);
#pragma unroll
                for (int g4 = 0; g4 < 4; ++g4) { const f32x4 gl = *(const LAS f32x4*)(GL + 32 * jpb + 8 * g4 + 4 * hh2);
                    acc[4 * g4] *= gl[0]; acc[4 * g4 + 1] *= gl[1]; acc[4 * g4 + 2] *= gl[2]; acc[4 * g4 + 3] *= gl[3]; }
                accn[jpb] = acc; depp = acc[15];
                __builtin_amdgcn_sched_barrier(0);
            }
            xs[ib][0][0] = packlo(accn[0]); xs[ib][0][1] = packhi(accn[0]); xs[ib][1][0] = packlo(accn[1]); xs[ib][1][1] = packhi(accn[1]);
        }
        LDS_WAIT(); asm volatile("" ::: "memory");
        if (lane == 0) flag[2] = chunk + 1;
        asm volatile("" ::: "memory");
    }
    {
        v4u yq[4];
#pragma unroll
        for (int j = 0; j < 4; ++j) yq[j] = *(const LAS v4u*)(ytr + 8 * j * YT_RS);
        LDS_WAIT();
        f16* yp = ybase + (DIR ? -((T / 32 - 1) * 32 * 512) : (T / 32 - 1) * 32 * 512);
#pragma unroll
        for (int j = 0; j < 4; ++j) *(v4u*)(yp + (DIR ? -(8 * j * 512) : 8 * j * 512)) = yq[j];
    }
}
DI void phaseScan(const DArgs& a, LAS unsigned char* lds, int G, int vcu, int wave, int lane) {
    const int slot = wave & 1;
    LAS unsigned char* cl = lds + slot * CHAIN_LDS2;
    for (int chain = vcu * 2 + slot; chain < NB * NH * 2; chain += G * 2) {
        if (wave < 2) { __builtin_amdgcn_s_setprio(3); if (chain & 1) scan_consumer<1>(a, cl, chain, lane); else scan_consumer<0>(a, cl, chain, lane); __builtin_amdgcn_s_setprio(0); }
        else { __builtin_amdgcn_s_setprio(2); scan_producer(a, cl, chain, lane); __builtin_amdgcn_s_setprio(0); }
    }
}

DI void phaseAttn(const DArgs& a, LAS int* qctr, int vcu, int lane) {
    unsigned char* ws = a.ws;
    bf16* QKV = (bf16*)(ws + WS_QKV); const bf16* VT = (const bf16*)(ws + WS_VT);
    const int r32 = lane & 31, hh = lane >> 5;
    for (;;) {
        int idx = 0;
        if (lane == 0) idx = __hip_atomic_fetch_add(qctr, 1, __ATOMIC_RELAXED, __HIP_MEMORY_SCOPE_WORKGROUP);
        idx = __builtin_amdgcn_readfirstlane(idx);
        if (idx >= 64) break;
        const int unit = vcu * 64 + idx;
        const int qt = unit & 63, hq = (unit >> 6) & 7, b = unit >> 9, kvh = hq >> 2, q0 = qt * 32;
        const float slope = exp2f(-(float)(hq + 1)), sink = a.in[I_SINK][hq];
        const size_t rowb = (size_t)b * T;
        bf16x8 qf[4];
        { const bf16* qp = QKV + (rowb + q0 + r32) * NQKV + hq * 64 + 8 * hh;
#pragma unroll
          for (int s = 0; s < 4; ++s) qf[s] = *(const bf16x8*)(qp + 16 * s); }
        float mrun = sink, lrun = 0.f;
        f32x16 o0, o1;
#pragma unroll
        for (int i = 0; i < 16; ++i) { o0[i] = 0.f; o1[i] = 0.f; }
        const int tq = q0 + r32;
        for (int kt = 0; kt < 9; ++kt) {
            const int k0 = q0 - 128 + 32 * kt;
            if (k0 < 0 || k0 >= T) continue;
            f32x16 st;
#pragma unroll
            for (int i = 0; i < 16; ++i) st[i] = 0.f;
            v2u vlo[2][2], vhi[2][2];
#pragma unroll
            for (int s = 0; s < 2; ++s)
#pragma unroll
                for (int db = 0; db < 2; ++db) { const bf16* vp = VT + ((size_t)(b * 2 + kvh) * 64 + 32 * db + r32) * T + k0 + 16 * s + 4 * hh; vlo[s][db] = *(const v2u*)vp; vhi[s][db] = *(const v2u*)(vp + 8); }
            asm volatile("" ::: "memory");
            { const bf16* kp = QKV + (rowb + k0 + r32) * NQKV + 512 + kvh * 64 + 8 * hh;
#pragma unroll
              for (int s = 0; s < 4; ++s) { const bf16x8 kf = *(const bf16x8*)(kp + 16 * s); st = __builtin_amdgcn_mfma_f32_32x32x16_bf16(kf, qf[s], st, 0, 0, 0); } }
            float tmax = -1e30f;
            if (kt == 0 || kt == 4 || kt == 8) {
#pragma unroll
                for (int i = 0; i < 16; ++i) { const int sk = k0 + crow(i, hh); int dd = sk - tq; dd = dd < 0 ? -dd : dd;
                    const float sc = (dd <= 128) ? st[i] - slope * (float)dd : -1e30f; st[i] = sc; tmax = fmaxf(tmax, sc); }
            } else {
                const float sg = kt < 4 ? slope : -slope;
                const float b0 = sg * (float)(k0 + 4 * hh - tq);
#pragma unroll
                for (int i = 0; i < 16; ++i) { const float sc = st[i] + fmaf(sg, (float)crow(i, 0), b0); st[i] = sc; tmax = fmaxf(tmax, sc); }
            }
            tmax = fmaxf(tmax, __shfl_xor(tmax, 32));
            const float mnew = fmaxf(mrun, tmax), alpha = __expf(mrun - mnew);
            mrun = mnew;
            float ps = 0.f;
#pragma unroll
            for (int i = 0; i < 16; ++i) { const float p = __expf(st[i] - mnew); st[i] = p; ps += p; }
            lrun = lrun * alpha + ps;
#pragma unroll
            for (int i = 0; i < 16; ++i) { o0[i] *= alpha; o1[i] *= alpha; }
#pragma unroll
            for (int s = 0; s < 2; ++s) {
                v4u pw; pw.x = pk2(st[8 * s], st[8 * s + 1]); pw.y = pk2(st[8 * s + 2], st[8 * s + 3]); pw.z = pk2(st[8 * s + 4], st[8 * s + 5]); pw.w = pk2(st[8 * s + 6], st[8 * s + 7]);
                const bf16x8 pf = __builtin_bit_cast(bf16x8, pw);
#pragma unroll
                for (int db = 0; db < 2; ++db) {
                    const v2u lo = vlo[s][db], hi = vhi[s][db];
                    v4u vw; vw.x = lo.x; vw.y = lo.y; vw.z = hi.x; vw.w = hi.y;
                    const bf16x8 vf = __builtin_bit_cast(bf16x8, vw);
                    if (db == 0) o0 = __builtin_amdgcn_mfma_f32_32x32x16_bf16(vf, pf, o0, 0, 0, 0);
                    else o1 = __builtin_amdgcn_mfma_f32_32x32x16_bf16(vf, pf, o1, 0, 0, 0);
                }
            }
        }
        const float ltot = lrun + __shfl_xor(lrun, 32);
        const float inv = 1.0f / (ltot + __expf(sink - mrun));
        bf16* op = QKV + (rowb + q0 + r32) * NQKV + hq * 64;
#pragma unroll
        for (int g4 = 0; g4 < 4; ++g4) {
            v2u w0, w1;
            w0.x = pk2(o0[4 * g4] * inv, o0[4 * g4 + 1] * inv); w0.y = pk2(o0[4 * g4 + 2] * inv, o0[4 * g4 + 3] * inv);
            w1.x = pk2(o1[4 * g4] * inv, o1[4 * g4 + 1] * inv); w1.y = pk2(o1[4 * g4 + 2] * inv, o1[4 * g4 + 3] * inv);
            *(v2u*)(op + 8 * g4 + 4 * hh) = w0;
            *(v2u*)(op + 32 + 8 * g4 + 4 * hh) = w1;
        }
    }
}

DI float red8(float v) { v += __shfl_xor(v, 1); v += __shfl_xor(v, 2); v += __shfl_xor(v, 4); return v; }
DI void phasePost(const DArgs& a, int own) {
    const int tid = threadIdx.x, lane = tid & 63, wave = __builtin_amdgcn_readfirstlane(tid >> 6);
    unsigned char* ws = a.ws;
    f16* YF = (f16*)(ws + WS_YF); const f16* YB = (const f16*)(ws + WS_YB);
    const f16* Rr = (const f16*)(ws + WS_RKV); const f16* Kr = Rr + (size_t)M * 512; const f16* Vr = Kr + (size_t)M * 512; const bf16* Gg = (const bf16*)(ws + WS_G);
    const f16* AF = (const f16*)a.out; const f16* AB = (const f16*)((const unsigned char*)a.out + OUT_AW);
    const int ch0 = lane * 8;
    float rkc[8], kac[8], lw[8], lb[8];
#pragma unroll
    for (int j = 0; j < 8; ++j) { rkc[j] = a.in[I_RK][ch0 + j]; kac[j] = a.in[I_KA][ch0 + j]; lw[j] = a.in[I_LNW][ch0 + j]; lb[j] = a.in[I_LNB][ch0 + j]; }
    for (int m = own * 256 + wave; m < own * 256 + 256; m += NWAVES) {
        const size_t o = (size_t)m * 512 + ch0;
        const f16x8 yf = *(const f16x8*)(YF + o), yb = *(const f16x8*)(YB + o), r8 = *(const f16x8*)(Rr + o), k8 = *(const f16x8*)(Kr + o), v8 = *(const f16x8*)(Vr + o);
        const f16x8 af = *(const f16x8*)(AF + o), ab = *(const f16x8*)(AB + o);
        const v4u gq = *(const v4u*)(Gg + o);
        float wkv[8], s1 = 0.f, bs = 0.f;
#pragma unroll
        for (int j = 0; j < 8; ++j) { wkv[j] = (float)yf[j] + (float)yb[j]; s1 += wkv[j];
            bs += (float)r8[j] * (float)k8[j] * rkc[j] * (2.0f + ((float)af[j] + (float)ab[j] - 2.0f) * kac[j]); }
        const float mean = red8(s1) * (1.f / 64.f);
        float s2 = 0.f;
#pragma unroll
        for (int j = 0; j < 8; ++j) { wkv[j] -= mean; s2 += wkv[j] * wkv[j]; }
        const float rstd = rsqrtf(red8(s2) * (1.f / 64.f) + LNX_EPS);
        const float bsum = red8(bs);
        const unsigned gw4[4] = {gq.x, gq.y, gq.z, gq.w};
        float y[8];
#pragma unroll
        for (int j = 0; j < 8; ++j) { const float gj = (j & 1) ? bfhi(gw4[j >> 1]) : bflo(gw4[j >> 1]); y[j] = (wkv[j] * rstd * lw[j] + lb[j] + bsum * (float)v8[j]) * gj; }
        v4u w; w.x = pk2(y[0], y[1]); w.y = pk2(y[2], y[3]); w.z = pk2(y[4], y[5]); w.w = pk2(y[6], y[7]);
        *(v4u*)((bf16*)YF + o) = w;
    }
}

DI void phaseRouter(const DArgs& a, LAS unsigned char* lds, int own) {
    const int tid = threadIdx.x, lane = tid & 63, wave = __builtin_amdgcn_readfirstlane(tid >> 6);
    unsigned char* ws = a.ws;
    LAS float* wf = (LAS float*)lds;
    __syncthreads();
    { const float* g = a.in[I_NFG]; const float* wr = a.in[I_WR];
      for (int idx = tid; idx < 256 * 64; idx += NTHREADS) { const int s4 = idx >> 6, ln = idx & 63, cc = 16 * (s4 >> 2) + 4 * (ln >> 4) + (s4 & 3); wf[idx] = g[cc] * wr[cc * NE + (ln & 15)]; } }
    __syncthreads();
    const bf16* x1 = (const bf16*)(ws + WS_X1B); float* AFFT = (float*)(ws + WS_AFFT); float* RSTD = (float*)(ws + WS_RSTD);
    const int r = lane & 15, q = lane >> 4;
    for (int tile = own * 16 + wave; tile < own * 16 + 16; tile += NWAVES) {
        const int row0 = tile * 16;
        const v2u* xp = (const v2u*)(x1 + (size_t)(row0 + r) * D) + q;
        f32x4 acc = {0.f, 0.f, 0.f, 0.f}; float ss = 0.f;
#pragma unroll 4
        for (int sp = 0; sp < 64; ++sp) {
            const v2u xw = xp[4 * sp]; const f32x4 xv = {bflo(xw.x), bfhi(xw.x), bflo(xw.y), bfhi(xw.y)};
            ss += (xv[0] * xv[0] + xv[1] * xv[1]) + (xv[2] * xv[2] + xv[3] * xv[3]);
#pragma unroll
            for (int j = 0; j < 4; ++j) acc = __builtin_amdgcn_mfma_f32_16x16x4f32(xv[j], wf[(sp * 4 + j) * 64 + lane], acc, 0, 0, 0);
        }
        ss += __shfl_xor(ss, 16); ss += __shfl_xor(ss, 32);
        const float rstd = rsqrtf(ss * (1.f / D) + NORM_EPS);
        if (q == 0) RSTD[row0 + r] = rstd;
        f32x4 p;
#pragma unroll
        for (int i = 0; i < 4; ++i) {
            const float lg = acc[i] * __shfl(rstd, 4 * q + i);
            float mx = lg;
            mx = fmaxf(mx, __shfl_xor(mx, 1)); mx = fmaxf(mx, __shfl_xor(mx, 2)); mx = fmaxf(mx, __shfl_xor(mx, 4)); mx = fmaxf(mx, __shfl_xor(mx, 8));
            const float ex = expf(lg - mx);
            float sm = ex; sm += __shfl_xor(sm, 1); sm += __shfl_xor(sm, 2); sm += __shfl_xor(sm, 4); sm += __shfl_xor(sm, 8);
            p[i] = ex / sm;
        }
        const int b = row0 / T, t0 = row0 % T;
        *(f32x4*)(AFFT + ((size_t)b * NE + r) * T + t0 + 4 * q) = p;
    }
    __syncthreads();
}

DI int block_sum8(LAS int* red, int v, int wave, int lane) {
    if (lane == 0) red[wave] = v;
    __syncthreads();
    int t = 0;
#pragma unroll
    for (int w = 0; w < 8; ++w) t += red[w];
    return t;
}
DI void phaseTopk(const DArgs& a, LAS unsigned char* lds, int pr) {
    const int tid = threadIdx.x, lane = tid & 63, wave = __builtin_amdgcn_readfirstlane(tid >> 6);
    unsigned char* ws = a.ws;
    const float* AFFT = (const float*)(ws + WS_AFFT); int* SEL = (int*)(ws + WS_SEL); float* VAL = (float*)(ws + WS_VAL);
    const float* RSTD = (const float*)(ws + WS_RSTD); const bf16* x1 = (const bf16*)(ws + WS_X1B); bf16* XG = (bf16*)(ws + WS_XG);
    LAS int* red = (LAS int*)lds;
    LAS int* lst = (LAS int*)(lds + 256);
    const unsigned long long lt_mask = (lane == 0) ? 0ull : (~0ull >> (64 - lane));
    const float* g = a.in[I_NFG];
    f32x4 gvv[4];
#pragma unroll
    for (int j = 0; j < 4; ++j) gvv[j] = *(const f32x4*)(g + 4 * lane + 256 * j);
    __syncthreads();
    {
        const int b = pr / NE, e = pr % NE;
        const f32x4 av = *(const f32x4*)(AFFT + (size_t)pr * T + 4 * tid);
        unsigned key[4];
#pragma unroll
        for (int j = 0; j < 4; ++j) { const float f = av[j]; key[j] = __float_as_uint(f); }
        unsigned K = 0u; int it = 0;
        for (int bit = 30; bit >= 0; --bit, ++it) {
            const unsigned cand = K | (1u << bit);
            int cw = 0;
#pragma unroll
            for (int j = 0; j < 4; ++j) cw += __builtin_popcountll(__ballot(key[j] >= cand));
            const int tot = block_sum8(red + 8 * (it & 1), cw, wave, lane);
            if (tot >= CAP) K = cand;
        }
        int cw = 0;
#pragma unroll
        for (int j = 0; j < 4; ++j) cw += __builtin_popcountll(__ballot(key[j] > K));
        const int ngt = block_sum8(red + 8 * (it & 1), cw, wave, lane); ++it;
        const int need = CAP - ngt;
        int tw = 0, tl = 0;
#pragma unroll
        for (int j = 0; j < 4; ++j) { const unsigned long long bt = __ballot(key[j] == K); tw += __builtin_popcountll(bt); tl += __builtin_popcountll(bt & lt_mask); }
        if (lane == 0) red[8 * (it & 1) + wave] = tw;
        __syncthreads();
        int tbase = tl;
#pragma unroll
        for (int w = 0; w < 8; ++w) tbase += (w < wave) ? red[8 * (it & 1) + w] : 0;
        ++it;
        bool sel[4]; int run = tbase;
#pragma unroll
        for (int j = 0; j < 4; ++j) { const bool tie = key[j] == K; sel[j] = key[j] > K || (tie && run < need); run += tie ? 1 : 0; }
        int sw = 0, sl = 0;
#pragma unroll
        for (int j = 0; j < 4; ++j) { const unsigned long long bs = __ballot(sel[j]); sw += __builtin_popcountll(bs); sl += __builtin_popcountll(bs & lt_mask); }
        if (lane == 0) red[8 * (it & 1) + wave] = sw;
        __syncthreads();
        int slot = sl;
#pragma unroll
        for (int w = 0; w < 8; ++w) slot += (w < wave) ? red[8 * (it & 1) + w] : 0;
        ++it;
        const size_t slot0 = (size_t)(e * NB + b) * CAP;
        int so[4];
#pragma unroll
        for (int j = 0; j < 4; ++j) { so[j] = sel[j] ? slot : -1; if (sel[j]) { lst[slot] = 4 * tid + j; VAL[slot0 + slot] = av[j]; ++slot; } }
#pragma unroll
        for (int j = 0; j < 4; ++j) SEL[((size_t)b * T + 4 * tid + j) * NE + e] = so[j];
        __syncthreads();
        for (int rr = wave * 8; rr < CAP; rr += NWAVES * 8) {
            v2u xv[8][4]; float rs[8];
#pragma unroll
            for (int q = 0; q < 8; ++q) { const size_t m = (size_t)b * T + lst[rr + q]; rs[q] = RSTD[m];
                const v2u* xr = (const v2u*)(x1 + m * D) + lane;
#pragma unroll
                for (int j = 0; j < 4; ++j) xv[q][j] = xr[64 * j]; }
#pragma unroll
            for (int q = 0; q < 8; ++q) { unsigned* o = (unsigned*)((unsigned char*)XG + (slot0 + rr + q) * D) + lane;
#pragma unroll
                for (int j = 0; j < 4; ++j) { const f32x4 xf = {bflo(xv[q][j].x), bfhi(xv[q][j].x), bflo(xv[q][j].y), bfhi(xv[q][j].y)}; const f32x4 hv = xf * rs[q] * gvv[j];
                    o[64 * j] = pk4_fp8(hv.x, hv.y, hv.z, hv.w); } }
        }
        __syncthreads();
    }
}

DI void phaseFinal(const DArgs& a, int G, int vcu) {
    const int tid = threadIdx.x, lane = tid & 63, wave = __builtin_amdgcn_readfirstlane(tid >> 6);
    const int gw = vcu * NWAVES + wave, NGW = G * NWAVES;
    unsigned char* ws = a.ws;
    const int* SEL = (const int*)(ws + WS_SEL); const bf16* YS = (const bf16*)(ws + WS_YS);
    float* out = a.out; const float* g = a.in[I_NFINAL]; const bf16* X1B = (const bf16*)(ws + WS_X1B);
    f32x4 gv[4];
#pragma unroll
    for (int j = 0; j < 4; ++j) gv[j] = *(const f32x4*)(g + 4 * lane + 256 * j);
    int m0 = gw * 2;
    if (m0 >= M) return;
    int ra, rb; v2u wa[4], wb[4];
#define FIN_FETCH(m_, ra_, rb_, wa_, wb_) do { const v2u* ia_ = (const v2u*)(X1B + (size_t)(m_) * D) + lane; const v2u* ib_ = ia_ + D / 4; \
        ra_ = SEL[(size_t)(m_) * NE + (lane & 15)]; rb_ = SEL[(size_t)((m_) + 1) * NE + (lane & 15)]; \
        _Pragma("unroll") for (int j = 0; j < 4; ++j) { wa_[j] = ia_[64 * j]; wb_[j] = ib_[64 * j]; } } while (0)
    FIN_FETCH(m0, ra, rb, wa, wb);
    for (;;) {
        const int mn = m0 + NGW * 2; const bool more = mn < M;
        int nra = -1, nrb = -1; v2u nwa[4], nwb[4];
#pragma unroll
        for (int j = 0; j < 4; ++j) { nwa[j] = (v2u){0u, 0u}; nwb[j] = (v2u){0u, 0u}; }
        f32x4 va[4], vb[4];
#pragma unroll
        for (int j = 0; j < 4; ++j) { va[j] = (f32x4){bflo(wa[j].x), bfhi(wa[j].x), bflo(wa[j].y), bfhi(wa[j].y)}; vb[j] = (f32x4){bflo(wb[j].x), bfhi(wb[j].x), bflo(wb[j].y), bfhi(wb[j].y)}; }
        const int b = m0 / T;
        unsigned ma = (unsigned)(__ballot(ra >= 0) & 0xffffull), mb = (unsigned)(__ballot(rb >= 0) & 0xffffull);
        EPI_MEMBAR;
        if (more) FIN_FETCH(mn, nra, nrb, nwa, nwb);
        EPI_MEMBAR;
        while (ma | mb) {
            const bool ha0 = ma != 0u; const int ea0 = ha0 ? __builtin_ctz(ma) : 0; if (ha0) ma &= ma - 1u;
            const bool ha1 = ma != 0u; const int ea1 = ha1 ? __builtin_ctz(ma) : ea0; if (ha1) ma &= ma - 1u;
            const bool hb0 = mb != 0u; const int eb0 = hb0 ? __builtin_ctz(mb) : 0; if (hb0) mb &= mb - 1u;
            const bool hb1 = mb != 0u; const int eb1 = hb1 ? __builtin_ctz(mb) : eb0; if (hb1) mb &= mb - 1u;
            const int sa0 = ha0 ? __builtin_amdgcn_readlane(ra, ea0) : 0, sa1 = ha0 ? __builtin_amdgcn_readlane(ra, ea1) : 0;
            const int sb0 = hb0 ? __builtin_amdgcn_readlane(rb, eb0) : 0, sb1 = hb0 ? __builtin_amdgcn_readlane(rb, eb1) : 0;
            const v2u* ya0 = (const v2u*)(YS + ((size_t)(ea0 * NB + b) * CAP + sa0) * D) + lane; const v2u* ya1 = (const v2u*)(YS + ((size_t)(ea1 * NB + b) * CAP + sa1) * D) + lane;
            const v2u* yb0 = (const v2u*)(YS + ((size_t)(eb0 * NB + b) * CAP + sb0) * D) + lane; const v2u* yb1 = (const v2u*)(YS + ((size_t)(eb1 * NB + b) * CAP + sb1) * D) + lane;
            v2u pa0[4], pa1[4], pb0[4], pb1[4];
#pragma unroll
            for (int j = 0; j < 4; ++j) { pa0[j] = ya0[64 * j]; pa1[j] = ya1[64 * j]; pb0[j] = yb0[64 * j]; pb1[j] = yb1[64 * j]; }
            const float fa0 = ha0 ? 1.f : 0.f, fa1 = ha1 ? 1.f : 0.f, fb0 = hb0 ? 1.f : 0.f, fb1 = hb1 ? 1.f : 0.f;
#pragma unroll
            for (int j = 0; j < 4; ++j) {
                va[j].x += fa0 * bflo(pa0[j].x) + fa1 * bflo(pa1[j].x); va[j].y += fa0 * bfhi(pa0[j].x) + fa1 * bfhi(pa1[j].x);
                va[j].z += fa0 * bflo(pa0[j].y) + fa1 * bflo(pa1[j].y); va[j].w += fa0 * bfhi(pa0[j].y) + fa1 * bfhi(pa1[j].y);
                vb[j].x += fb0 * bflo(pb0[j].x) + fb1 * bflo(pb1[j].x); vb[j].y += fb0 * bfhi(pb0[j].x) + fb1 * bfhi(pb1[j].x);
                vb[j].z += fb0 * bflo(pb0[j].y) + fb1 * bflo(pb1[j].y); vb[j].w += fb0 * bfhi(pb0[j].y) + fb1 * bfhi(pb1[j].y); }
        }
        float sa = 0.f, sb = 0.f;
#pragma unroll
        for (int j = 0; j < 4; ++j) { sa += (va[j].x * va[j].x + va[j].y * va[j].y) + (va[j].z * va[j].z + va[j].w * va[j].w); sb += (vb[j].x * vb[j].x + vb[j].y * vb[j].y) + (vb[j].z * vb[j].z + vb[j].w * vb[j].w); }
        const float rsa = rsqrtf(wave_sum(sa) * (1.f / D) + NORM_EPS), rsb = rsqrtf(wave_sum(sb) * (1.f / D) + NORM_EPS);
        f32x4* xa = (f32x4*)(out + (size_t)m0 * D) + lane; f32x4* xb = xa + D / 4;
#pragma unroll
        for (int j = 0; j < 4; ++j) { xa[64 * j] = va[j] * rsa * gv[j]; xb[64 * j] = vb[j] * rsb * gv[j]; }
        if (!more) break;
        m0 = mn; ra = nra; rb = nrb;
#pragma unroll
        for (int j = 0; j < 4; ++j) { wa[j] = nwa[j]; wb[j] = nwb[j]; }
    }
#undef FIN_FETCH
}

typedef __attribute__((address_space(1))) unsigned gu32;
#define XB_TMO      128
#define XB_XCNT(j)  (256  + 64 * (j))
#define XB_XSUB(j)  (1280 + 64 * (j))
#define XB_XGEN(j)  (2304 + 64 * (j))
#define XB_TOP      3328
#define XB_TOPGEN   3392
#define XCD_BAR_WORDS 3456
#define XB_SPIN_CAP (1u << 18)

__device__ __forceinline__ unsigned xb_ld(unsigned* p)              { return __hip_atomic_load(p, __ATOMIC_RELAXED, __HIP_MEMORY_SCOPE_AGENT); }
__device__ __forceinline__ unsigned xb_add(unsigned* p, unsigned v) { return __hip_atomic_fetch_add(p, v, __ATOMIC_RELAXED, __HIP_MEMORY_SCOPE_AGENT); }
__device__ __forceinline__ unsigned xb_xcc_id() { return (unsigned)__builtin_amdgcn_s_getreg((3 << 11) | 20) & 0xFu; }
#define XB_SPIN(cond, bar) do { unsigned _sp = 0; while (cond) { __builtin_amdgcn_s_sleep(1); \
    if ((++_sp & 255u) == 0u) { if (xb_ld(&(bar)[XB_TMO])) break; if (_sp > XB_SPIN_CAP) { atomicAdd(&(bar)[XB_TMO], 1u); break; } } } } while (0)

struct XcdBarrier {
    unsigned* bar; unsigned x;
    volatile LAS unsigned* st;
};

__device__ __forceinline__ XcdBarrier xcd_barrier_post(unsigned* bar, volatile LAS unsigned* st) {
    XcdBarrier b; b.bar = bar; b.x = xb_xcc_id(); b.st = st;
    if (threadIdx.x == 0) (void)xb_add(&bar[XB_XCNT(b.x)], 1u);
    return b;
}
__device__ __forceinline__ void xcd_barrier_complete(unsigned* bar, unsigned x, unsigned& nloc, unsigned& nx) {
    const unsigned G = gridDim.x * gridDim.y * gridDim.z;
    unsigned sum, cnt, mine, sp = 0u;
    for (;;) {
        sum = 0u; cnt = 0u; mine = 0u;
#pragma unroll
        for (unsigned j = 0; j < 16; ++j) { const unsigned c = xb_ld(&bar[XB_XCNT(j)]); sum += c; cnt += (c > 0u) ? 1u : 0u; mine = (j == x) ? c : mine; }
        if (sum == G) break;
        __builtin_amdgcn_s_sleep(1);
        if ((++sp & 255u) == 0u) { if (xb_ld(&bar[XB_TMO])) break; if (sp > XB_SPIN_CAP) { atomicAdd(&bar[XB_TMO], 1u); break; } }
    }
    nloc = mine > 0u ? mine : 1u; nx = cnt > 0u ? cnt : 1u;
}

__device__ __forceinline__ void xcd_barrier(const XcdBarrier& b) {
    asm volatile("s_waitcnt vmcnt(0)" ::: "memory");
    __syncthreads();
    if (threadIdx.x == 0) {
        unsigned* bar = b.bar;
        __builtin_amdgcn_s_waitcnt(0);
        unsigned nloc = b.st[0], nx = b.st[1];
        if (nloc == 0u) { xcd_barrier_complete(bar, b.x, nloc, nx); b.st[0] = nloc; b.st[1] = nx; }
        const unsigned old = xb_add(&bar[XB_XSUB(b.x)], 1u);
        const unsigned gen = old / nloc;
        if (old + 1u == (gen + 1u) * nloc) {
            __builtin_amdgcn_fence(__ATOMIC_RELEASE, "agent");
            asm volatile("s_waitcnt vmcnt(0)" ::: "memory");
            const unsigned og = xb_add(&bar[XB_TOP], 1u);
            const unsigned tg = og / nx;
            if (og + 1u == (tg + 1u) * nx) xb_add(&bar[XB_TOPGEN], 1u);
            else XB_SPIN(xb_ld(&bar[XB_TOPGEN]) == tg, bar);
            __builtin_amdgcn_fence(__ATOMIC_ACQUIRE, "agent");
            xb_add(&bar[XB_XGEN(b.x)], 1u);
            asm volatile("s_waitcnt vmcnt(0)" ::: "memory");
        } else {
            XB_SPIN(xb_ld(&bar[XB_XGEN(b.x)]) == gen, bar);
            __builtin_amdgcn_fence(__ATOMIC_ACQUIRE, "agent");
            asm volatile("s_waitcnt vmcnt(0)" ::: "memory");
        }
    }
    __syncthreads();
}


constexpr int NPHASE = 13;
#ifndef MK_ONE_LAUNCH
#define MK_ONE_LAUNCH 1
#endif
__global__ void __launch_bounds__(NTHREADS, 2) fwd_kernel(Args args) {
    extern __shared__ __attribute__((aligned(16))) unsigned char lds_raw[];
    LAS unsigned char* lds = (LAS unsigned char*)lds_raw;
    const int G = gridDim.x, bx = blockIdx.x;
    const int vcu = (G % 8 == 0) ? (bx % 8) * (G / 8) + bx / 8 : bx;
    const int lo = args.ph_lo, hi = args.ph_hi;
    unsigned char* ws = args.ws;
    DArgs dargs; dargs.out = args.out; dargs.ws = args.ws;
#if MK_ONE_LAUNCH
    volatile LAS unsigned* MISC = (volatile LAS unsigned*)(lds + LDS_BYTES - 128);
    if (threadIdx.x < 32) MISC[threadIdx.x] = 0u;
    __syncthreads();
    const XcdBarrier xbar = xcd_barrier_post((unsigned*)(ws + WS_CTL) + 64, MISC);
#endif
#ifndef REPEAT_MASK
#define REPEAT_MASK 0
#endif
#define IN(k) (lo <= (k) && (k) < hi)
#define REPS(k) for (int rep_ = 0; rep_ < (((REPEAT_MASK >> (k)) & 1) ? 2 : 1); ++rep_)
#if MK_ONE_LAUNCH
#define SEAM(k) do { if (IN(k) && IN((k) + 1)) { if ((k) == 0) cg::this_grid().sync(); else xcd_barrier(xbar); } } while (0)
#else
#define SEAM(k) do { } while (0)
#endif
    if (IN(0)) REPS(0) { phase0(dargs, lds, G, vcu); }
    SEAM(0);
    if (IN(1)) REPS(1) {
        { pg8::Gemm g{(const bf16*)args.out, (const bf16*)(ws + WS_WIN), M, 2816, D, D, 1 << 30, 0, nullptr, 0, nullptr, 0, 1 << 30, 0, 0};
          pg8::StaticOrder S; S.init(M, 2816, G, bx);
          EpiA E{(bf16*)(ws + WS_UR), (bf16*)(ws + WS_QKV), (bf16*)(ws + WS_GATES)};
          pg8::gemm_phase<EpiA, pg8::StaticOrder, PG8_ALIGN, PG8_SP2>(lds, g, S, E); }
        { pg8::Gemm g{(const bf16*)((const unsigned char*)args.out + 128 * MiB), (const bf16*)(ws + WS_WG8), M, NGATE, D / 2, D / 2, 1 << 30, 0, nullptr, 0, nullptr, 0, 1 << 30, 0, 0};
          pg8::StaticOrder S; S.init(M, NGATE, G, bx);
          EpiGates E{(unsigned char*)(ws + WS_GATES)};
          pg8::gemm_phase<EpiGates, pg8::StaticOrder, PG8_ALIGN, PG8_SP2, false, false, true>(lds, g, S, E); }
    }
    SEAM(1);
#define BSEAM() do { asm volatile("s_waitcnt vmcnt(0)" ::: "memory"); __syncthreads(); } while (0)
    if (IN(2)) {
        { const int own = vcu;
            phaseP1(dargs, lds, own);
            BSEAM();
            int kl = 128; asm volatile("" : "+s"(kl));
            pg8::Gemm g{(const bf16*)(ws + WS_AP), (const bf16*)(ws + WS_WLORA), M, NLN, kl, NLK, 1 << 30, 0, nullptr, 0, nullptr, 0, 1 << 30, 0, 0};
            pg8::OwnRowLoraOrder S; S.pm0 = own; S.pm1 = own; S.npm = 1; S.nN = NLN / 256;
            EpiLoraZ E{(bf16*)(ws + WS_G), (f16*)args.out, (const float*)(ws + WS_LBIAS)};
            pg8::gemm_phase<EpiLoraZ, pg8::OwnRowLoraOrder, PG8_ALIGN, PG8_SP2>(lds, g, S, E);
        }
    }
    SEAM(3);
    if (IN(4)) {
        const int lane4 = threadIdx.x & 63, wave4 = __builtin_amdgcn_readfirstlane(threadIdx.x >> 6);
        if (threadIdx.x < 64) { ((LAS int*)(lds + CH_FLAG))[threadIdx.x & 31] = 0; ((LAS int*)(lds + CHAIN_LDS2 + CH_FLAG))[threadIdx.x & 31] = 0; }
        __syncthreads();
        LAS int* qctr = (LAS int*)(lds + CH_FLAG) + 16;
        if (wave4 < 4) phaseScan(dargs, lds, G, vcu, wave4, lane4);
        phaseAttn(dargs, qctr, vcu, lane4);
    }
    SEAM(4);
    if (IN(5)) { phasePost(dargs, vcu); }
    SEAM(5);
    if (IN(6)) REPS(6) {
        pg8::Gemm g{(const bf16*)(ws + WS_YF), (const bf16*)(ws + WS_WPR), M, D, D, 512, 1 << 30, 0, nullptr, 0, (const bf16*)(ws + WS_QKV), NQKV, 8, 0, 0};
        pg8::StaticOrder S; S.init(M, D, G, bx);
        EpiMerge2 E{(bf16*)(ws + WS_MERGED), (const unsigned char*)(ws + WS_GATES)};
        pg8::gemm_phase<EpiMerge2, pg8::StaticOrder, PG8_ALIGN, PG8_SP2, false, true>(lds, g, S, E);
    }
    SEAM(6);
    if (IN(7)) REPS(7) {
        pg8::Gemm g{(const bf16*)(ws + WS_MERGED), (const bf16*)(ws + WS_WOUT), M, D, D, D, 1 << 30, 0, nullptr, 0, nullptr, 0, 1 << 30, 0, 0};
        pg8::StaticOrder S; S.init(M, D, G, bx);
        EpiResid E{dargs.in[I_X], (bf16*)(ws + WS_X1B)};
        pg8::gemm_phase<EpiResid, pg8::StaticOrder, PG8_ALIGN, PG8_SP2>(lds, g, S, E);
    }
    SEAM(7);
    if (IN(8)) { phaseRouter(dargs, lds, vcu); }
    SEAM(8);
    if (IN(9)) { phaseTopk(dargs, lds, 2 * vcu); phaseTopk(dargs, lds, 2 * vcu + 1);   }
    SEAM(9);
    if (IN(10)) REPS(10) {
        pg8::Gemm g{(const bf16*)(ws + WS_XG), (const bf16*)(ws + WS_WGU), MS, 2048, D / 2, D / 2, NB, (size_t)2048 * D, nullptr, 0, nullptr, 0, 1 << 30, 0x7f7f7f7f, 0x7a7a7a7a};
        pg8::StaticOrder S; S.init(MS, 2048, G, bx);
        EpiSwiglu E{(unsigned char*)(ws + WS_HID)};
        pg8::gemm_phase<EpiSwiglu, pg8::StaticOrder, PG8_ALIGN, PG8_SP2, false, false, true>(lds, g, S, E);
    }
    SEAM(10);
    if (IN(11)) REPS(11) {
        pg8::Gemm g{(const bf16*)(ws + WS_HID), (const bf16*)(ws + WS_WD), MS, D, FF / 2, FF / 2, NB, (size_t)D * FF, nullptr, 0, nullptr, 0, 1 << 30, 0x7f7f7f7f, 0x7a7a7a7a};
        pg8::StaticOrder S; S.init(MS, D, G, bx);
        EpiYs E{(bf16*)(ws + WS_YS), (const float*)(ws + WS_VAL)};
        pg8::gemm_phase<EpiYs, pg8::StaticOrder, PG8_ALIGN, PG8_SP2, false, false, true>(lds, g, S, E);
    }
    SEAM(11);
    if (IN(12)) { phaseFinal(dargs, G, vcu); }
#undef IN
#undef SEAM
}

extern "C" void kernel_launch(void* const* d_in, const int* in_sizes, int n_in, void* d_out, int out_size, void* d_ws, size_t ws_size, hipStream_t stream) {
    static int grid = 0;
    if (grid == 0) {
        if (n_in != 29 || out_size != M * D || ws_size < WS_END) { fprintf(stderr, "kernel_launch: unexpected shapes (n_in %d out %d ws %zu)\n", n_in, out_size, ws_size); grid = -1; return; }
        int dev = 0, cus = 0, per_cu = 0;
        hipGetDevice(&dev);
        hipDeviceGetAttribute(&cus, hipDeviceAttributeMultiprocessorCount, dev);
        hipFuncSetAttribute((const void*)fwd_kernel, hipFuncAttributeMaxDynamicSharedMemorySize, LDS_BYTES);
        hipOccupancyMaxActiveBlocksPerMultiprocessor(&per_cu, (const void*)fwd_kernel, NTHREADS, LDS_BYTES);
        (void)hipGetLastError();
        if (per_cu < 1) { fprintf(stderr, "kernel_launch: occupancy query says %d blocks per CU\n", per_cu); per_cu = 1; }
        grid = cus;
        if (grid != M / 256) { fprintf(stderr, "kernel_launch: this build needs exactly %d workgroups (one per CU of a 256-CU device), got %d\n", M / 256, grid); grid = -1; return; }
    }
    if (grid < 0) return;
    Args a{};
    for (int i = 0; i < 29; ++i) a.in[i] = (const float*)d_in[i];
    a.out = (float*)d_out; a.ws = (unsigned char*)d_ws;
#if MK_ONE_LAUNCH
    if (hipMemsetAsync((char*)d_ws + WS_CTL, 0, 16384, stream) != hipSuccess) { fprintf(stderr, "kernel_launch: memset of the barrier words failed\n"); return; }
    a.ph_lo = 0; a.ph_hi = NPHASE;
    void* kargs[] = {&a};
    hipError_t e = hipLaunchCooperativeKernel((const void*)fwd_kernel, dim3(grid), dim3(NTHREADS), kargs, LDS_BYTES, stream);
    if (e != hipSuccess) fprintf(stderr, "cooperative launch failed: %s (grid %d)\n", hipGetErrorString(e), grid);
#else
    for (int p = 0; p < NPHASE; ++p) {
        a.ph_lo = p; a.ph_hi = p + 1;
        hipLaunchKernelGGL(fwd_kernel, dim3(grid), dim3(NTHREADS), LDS_BYTES, stream, a);
    }
#endif
}
```

```cpp
#include <hip/hip_runtime.h>
#include <hip/hip_cooperative_groups.h>
#include <cstdio>
#include <cstdint>
namespace cg = cooperative_groups;
namespace pg8 {
#define PG8_LAS __attribute__((address_space(3)))
typedef unsigned short bf16_t;
typedef short bf16x8 __attribute__((ext_vector_type(8)));
typedef float f32x4 __attribute__((ext_vector_type(4)));
typedef unsigned u32x4 __attribute__((ext_vector_type(4)));
typedef int i32x8 __attribute__((ext_vector_type(8)));
typedef int i32x4 __attribute__((ext_vector_type(4)));
constexpr int BM = 256, BK = 64, HALF = 128, HTB = HALF * BK * 2  , STAGE_BYTES = 8 * HTB, NXCD = 8, WGM = 8;

__host__ __device__ __forceinline__ int lds_byte(int r, int c) { const int st = (r >> 4) * 2 + (c >> 5), rr = r & 15, cc = c & 31, ob = rr * 64 + cc * 2; return st * 1024 + (ob ^ (((ob >> 9) & 1) << 5)); }
__host__ __device__ __forceinline__ void stage_rc(int b, int& R, int& C) { const int st = b / 1024, sb = b % 1024, swz = sb ^ (((sb >> 9) & 1) << 5); R = (st >> 1) * 16 + swz / 64; C = (st & 1) * 32 + (swz % 64) / 2; }
__host__ __device__ __forceinline__ int lds_byte_mx(int r, int c) { const int st = (r >> 4) * 2 + (c >> 5), rr = r & 15, cc = c & 31, ob = rr * 64 + cc * 2; return st * 1024 + (ob ^ (((ob >> 9) & 1) << 4)); }
__host__ __device__ __forceinline__ void stage_rc_mx(int b, int& R, int& C) { const int st = b / 1024, sb = b % 1024, swz = sb ^ (((sb >> 9) & 1) << 4); R = (st >> 1) * 16 + swz / 64; C = (st & 1) * 32 + (swz % 64) / 2; }
__host__ __device__ __forceinline__ int perm32(int rho) { const int n = rho >> 4, i = rho & 15; return 8 * (i >> 2) + 4 * n + (i & 3); }

struct Unit { int pm, pn; };
struct Gemm { const bf16_t* A; const bf16_t* Bt; int M, N, K, lda; int grp_tiles; size_t grp_stride; const PG8_LAS unsigned short* glist; int gather_T; const bf16_t* A2; int lda2, ksplit; int mx_scale_a, mx_scale_b; };

struct StaticOrder {
    int nM, nN, nwg, G, c;
    __host__ __device__ void init(int M, int N, int G_, int c_) { nM = M / BM; nN = N / BM; nwg = nM * nN; G = G_; c = c_; }
    __host__ __device__ bool next(int i, Unit& u) const {
        const long L = (long)i * G + c; if (L >= nwg) return false;
        int wgid = (int)L; { const int q = nwg / NXCD, r = nwg % NXCD, xcd = wgid % NXCD, off = wgid / NXCD; wgid = (xcd < r ? xcd * (q + 1) : r * (q + 1) + (xcd - r) * q) + off; }
        const int nig = WGM * nN, gid = wgid / nig, fm = gid * WGM, gsz = (nM - fm) < WGM ? (nM - fm) : WGM;
        u.pm = fm + ((wgid % nig) % gsz); u.pn = (wgid % nig) / gsz; return true;
    }
    __device__ __forceinline__ void a_ready(const Unit&) const {}
    __device__ __forceinline__ void done(const Unit&) const {}
    __device__ __forceinline__ size_t a_off(const Unit&) const { return 0; }
};
struct OwnRowOrder {
    int pm0, pm1, npm, nN;
    __device__ __forceinline__ bool next(int i, Unit& u) const { const int r = i / nN; if (r >= npm) return false; u.pm = r == 0 ? pm0 : pm1; u.pn = i - r * nN; return true; }
    __device__ __forceinline__ void a_ready(const Unit&) const {}
    __device__ __forceinline__ void done(const Unit&) const {}
    __device__ __forceinline__ size_t a_off(const Unit&) const { return 0; }
};
struct OwnRowLoraOrder : OwnRowOrder {
    __device__ __forceinline__ size_t a_off(const Unit& u) const { return u.pn < 2 ? 0 : (u.pn < 6 ? 256 : 512); }
};
struct LoraOrder : StaticOrder {
    __device__ __forceinline__ size_t a_off(const Unit& u) const { return u.pn < 2 ? 0 : (u.pn < 6 ? 256 : 512); }
};
template <class Epi, class Sched, bool ALIGN_EPI = false, bool SP2 = false, bool GA = false, bool SA2 = false, bool MX = false>
__device__ __forceinline__ void gemm_phase(PG8_LAS unsigned char* lds, const Gemm g, const Sched& S, const Epi& E) {
    const int tid = threadIdx.x, wid = __builtin_amdgcn_readfirstlane(tid >> 6), lane = tid & 63, wr = wid >> 2, wc = wid & 3, fr = lane & 15, fq = lane >> 4;
    const int K = g.K, nt = K / BK;
    unsigned voffA[2], voffB[2], voffA2[2];
#pragma unroll
    for (int i = 0; i < 2; ++i) { int R, C; if constexpr (MX) stage_rc_mx(tid * 16 + i * 8192, R, C); else stage_rc(tid * 16 + i * 8192, R, C); const int Rb = Epi::PERM ? ((R & ~31) + perm32(R & 31)) : R;
        voffA[i] = (unsigned)(R * g.lda + C) * 2u; voffB[i] = (unsigned)(Rb * K + C) * 2u; voffA2[i] = (unsigned)(R * g.lda2 + C) * 2u; }
    const size_t kstep = (size_t)(BK * 2);
    const size_t hstepA = (size_t)HALF * g.lda * 2, hstepB = (size_t)HALF * K * 2;
    const size_t tstepA = GA ? 0 : 2 * hstepA, tstepB = 2 * hstepB;
    const size_t hstepA2 = (size_t)HALF * g.lda2 * 2; const int ks = g.ksplit;
    const unsigned ldsw = (unsigned)wid * 1024u;
    const int aoff = lds_byte(wr * 64 + fr, fq * 8), boff = lds_byte(wc * 32 + fr, fq * 8);
    const int aoffx0 = lds_byte_mx(wr * 64 + fr, 16 * fq), aoffx1 = lds_byte_mx(wr * 64 + fr, 16 * fq + 8), boffx0 = lds_byte_mx(wc * 32 + fr, 16 * fq), boffx1 = lds_byte_mx(wc * 32 + fr, 16 * fq + 8);
#define PG8_SA(b, h) (((b) * 2 + (h)) * HTB)
#define PG8_SB(b, h) ((4 + (b) * 2 + (h)) * HTB)
#define PG8_STAGE(bufoff, gbase, voff) do { _Pragma("unroll") for (int _i = 0; _i < 2; ++_i) { unsigned vo1_ = (voff)[_i]; if constexpr (MX) asm volatile("" : "+v"(vo1_));     \
        __builtin_amdgcn_global_load_lds((const unsigned*)((const char*)(gbase) + vo1_), (PG8_LAS unsigned*)(lds + (bufoff) + ldsw + _i * 8192), 16, 0, 0); } } while (0)
#define PG8_STAGE_A(bufoff, base, half, usenext, side) do { if constexpr (GA) { unsigned vo_[2]; _Pragma("unroll") for (int q_ = 0; q_ < 2; ++q_) vo_[q_] = (usenext) ? nG[half][q_] : cG[half][q_]; PG8_STAGE(bufoff, base, vo_); } \
        else if constexpr (SA2) { if (side) { PG8_STAGE(bufoff, (base) + (half) * hstepA2, voffA2); } else { PG8_STAGE(bufoff, (base) + (half) * hstepA, voffA); } } \
        else { PG8_STAGE(bufoff, (base) + (half) * hstepA, voffA); } } while (0)
#define PG8_LDA(dst, b, h) do { if constexpr (MX) { _Pragma("unroll") for (int m = 0; m < 4; ++m) { const i32x4 lo_ = *(const PG8_LAS i32x4*)(lds + PG8_SA(b, h) + aoffx0 + m * 2048), hi_ = *(const PG8_LAS i32x4*)(lds + PG8_SA(b, h) + aoffx1 + m * 2048); \
            dst##X[m] = __builtin_shufflevector(lo_, hi_, 0, 1, 2, 3, 4, 5, 6, 7); } } \
        else { _Pragma("unroll") for (int m = 0; m < 4; ++m) _Pragma("unroll") for (int k = 0; k < 2; ++k) dst[m][k] = *(const PG8_LAS bf16x8*)(lds + PG8_SA(b, h) + aoff + m * 2048 + k * 1024); } } while (0)
#define PG8_LDB(dst, b, h) do { if constexpr (MX) { _Pragma("unroll") for (int n = 0; n < 2; ++n) { const i32x4 lo_ = *(const PG8_LAS i32x4*)(lds + PG8_SB(b, h) + boffx0 + n * 2048), hi_ = *(const PG8_LAS i32x4*)(lds + PG8_SB(b, h) + boffx1 + n * 2048); \
            dst##X[n] = __builtin_shufflevector(lo_, hi_, 0, 1, 2, 3, 4, 5, 6, 7); } } \
        else { _Pragma("unroll") for (int n = 0; n < 2; ++n) _Pragma("unroll") for (int k = 0; k < 2; ++k) dst[n][k] = *(const PG8_LAS bf16x8*)(lds + PG8_SB(b, h) + boff + n * 2048 + k * 1024); } } while (0)
#define PG8_MMA(ai, bj, At, Bt) do { __builtin_amdgcn_s_setprio(1); if constexpr (MX) { _Pragma("unroll") for (int m = 0; m < 4; ++m) _Pragma("unroll") for (int n = 0; n < 2; ++n) \
        asm volatile("v_mfma_scale_f32_16x16x128_f8f6f4 %0, %1, %2, %0, %3, %3 op_sel_hi:[0,0,0]" : "+v"(acc[ai][bj][m][n]) : "v"(Bt##X[n]), "v"(At##X[m]), "v"(mxs)); }     \
        else { _Pragma("unroll") for (int m = 0; m < 4; ++m) _Pragma("unroll") for (int n = 0; n < 2; ++n) _Pragma("unroll") for (int k = 0; k < 2; ++k) \
        acc[ai][bj][m][n] = __builtin_amdgcn_mfma_f32_16x16x32_bf16(Bt[n][k], At[m][k], acc[ai][bj][m][n], 0, 0, 0); } __builtin_amdgcn_s_setprio(0); } while (0)
#define PG8_WAIT_V(n) asm volatile("s_waitcnt vmcnt(" #n ")" ::: "memory")
#define PG8_WAIT_L(n) asm volatile("s_waitcnt lgkmcnt(" #n ")" ::: "memory")
#define PG8_BAR __builtin_amdgcn_s_barrier()
#define PG8_SCHED __builtin_amdgcn_sched_barrier(0)
    Unit cur, nxt; int ui = 0;
    if (!S.next(0, cur)) return;
    f32x4 acc[2][2][4][2];
#pragma unroll
    for (int a = 0; a < 2; ++a)
#pragma unroll
        for (int b = 0; b < 2; ++b)
#pragma unroll
            for (int m = 0; m < 4; ++m)
#pragma unroll
                for (int n = 0; n < 2; ++n) acc[a][b][m][n] = (f32x4){0.f, 0.f, 0.f, 0.f};
    bf16x8 At[4][2], B0[2][2], B1[2][2];
    i32x8 AtX[4], B0X[2], B1X[2];
    int mxs = 0x7f7f7f7f; asm volatile("" : "+v"(mxs));
    unsigned cG[2][2], nG[2][2]; int gR[2], gC[2];
    if constexpr (GA) {
#pragma unroll
        for (int i = 0; i < 2; ++i) { int R, C; stage_rc(tid * 16 + i * 8192, R, C); gR[i] = R; gC[i] = C; }
#pragma unroll
        for (int h = 0; h < 2; ++h)
#pragma unroll
            for (int i = 0; i < 2; ++i) { const int tok = g.glist[h * HALF + gR[i]]; cG[h][i] = (unsigned)(((cur.pm % g.grp_tiles) * g.gather_T + tok) * g.lda + gC[i]) * 2u; nG[h][i] = cG[h][i]; }
    }
    const char* cA = (const char*)g.A + (size_t)cur.pm * tstepA + S.a_off(cur); const char* cB = (const char*)g.Bt + (size_t)(cur.pm / g.grp_tiles) * g.grp_stride + (size_t)cur.pn * tstepB;
    const char* cA2 = (const char*)g.A2 + (size_t)cur.pm * 2 * hstepA2;
    S.a_ready(cur);
    if constexpr (SP2) {
        PG8_STAGE(PG8_SB(0, 0), cB, voffB); PG8_STAGE(PG8_SB(0, 1), cB + hstepB, voffB); PG8_STAGE_A(PG8_SA(0, 0), cA, 0, false, false); PG8_STAGE_A(PG8_SA(0, 1), cA, 1, false, false);
        if (wr == 1) PG8_BAR;
        PG8_WAIT_V(2); PG8_BAR;
        PG8_STAGE(PG8_SB(1, 0), cB + kstep, voffB); PG8_STAGE_A(PG8_SA(1, 0), cA + kstep, 0, false, false); PG8_STAGE(PG8_SB(1, 1), cB + hstepB + kstep, voffB);
        PG8_WAIT_V(6); PG8_BAR;
    } else {
        PG8_STAGE(PG8_SB(0, 0), cB, voffB); PG8_STAGE_A(PG8_SA(0, 0), cA, 0, false, false); PG8_STAGE(PG8_SB(0, 1), cB + hstepB, voffB); PG8_STAGE_A(PG8_SA(0, 1), cA, 1, false, false);
        if (wr == 1) PG8_BAR;
        PG8_WAIT_V(4); PG8_BAR;
        PG8_STAGE(PG8_SB(1, 0), cB + kstep, voffB); PG8_STAGE_A(PG8_SA(1, 0), cA + kstep, 0, false, false); PG8_STAGE(PG8_SB(1, 1), cB + hstepB + kstep, voffB);
        PG8_WAIT_V(6); PG8_BAR;
    }
    for (;;) {
        const bool has_next = S.next(ui + 1, nxt);
        if constexpr (GA) { if (has_next) {
#pragma unroll
            for (int h = 0; h < 2; ++h)
#pragma unroll
                for (int i = 0; i < 2; ++i) { const int tok = g.glist[(ui + 1) * 256 + h * HALF + gR[i]]; nG[h][i] = (unsigned)(((nxt.pm % g.grp_tiles) * g.gather_T + tok) * g.lda + gC[i]) * 2u; } } }
        const char* nA = has_next ? (const char*)g.A + (size_t)nxt.pm * tstepA + S.a_off(nxt) : cA; const char* nB = has_next ? (const char*)g.Bt + (size_t)(nxt.pm / g.grp_tiles) * g.grp_stride + (size_t)nxt.pn * tstepB : cB;
        for (int t = 0; t < nt; t += 2) {
            const bool last = (t == nt - 2); const bool usen = last && has_next;
            const bool s1 = SA2 && t >= ks, s2 = SA2 && !last && (t + 2 >= ks);
            const char* a1 = s1 ? cA2 + (size_t)(t + 1 - ks) * kstep : cA + (size_t)(t + 1) * kstep;
            const char* a2 = last ? nA : (s2 ? cA2 + (size_t)(t + 2 - ks) * kstep : cA + (size_t)(t + 2) * kstep); const char* b2 = last ? nB : cB + (size_t)(t + 2) * kstep;
            const char* a3 = a2 + kstep; const char* b3 = b2 + kstep;
            if (last && has_next) S.a_ready(nxt);
            if constexpr (SA2) { if (t == ks) E.mid(acc, cur, wr, wc, fr, fq); }
            if constexpr (SP2) {
            PG8_LDB(B0, 0, 0); PG8_LDB(B1, 0, 1); PG8_SCHED; PG8_LDA(At, 0, 0); PG8_STAGE_A(PG8_SA(1, 1), a1, 1, false, s1);
            PG8_WAIT_V(8); PG8_WAIT_L(0); PG8_BAR; PG8_MMA(0, 0, At, B0); PG8_MMA(0, 1, At, B1); PG8_BAR; PG8_SCHED;
            PG8_LDA(At, 0, 1); PG8_STAGE(PG8_SB(0, 0), b2, voffB); PG8_STAGE(PG8_SB(0, 1), b2 + hstepB, voffB); PG8_STAGE_A(PG8_SA(0, 0), a2, 0, usen, s2);
            PG8_WAIT_V(8); PG8_WAIT_L(0); PG8_BAR; PG8_MMA(1, 0, At, B0); PG8_MMA(1, 1, At, B1); PG8_BAR; PG8_SCHED;
            PG8_LDB(B0, 1, 0); PG8_LDB(B1, 1, 1); PG8_SCHED; PG8_LDA(At, 1, 0); PG8_STAGE_A(PG8_SA(0, 1), a2, 1, usen, s2);
            PG8_WAIT_V(8); PG8_WAIT_L(0); PG8_BAR; PG8_MMA(0, 0, At, B0); PG8_MMA(0, 1, At, B1); PG8_BAR; PG8_SCHED;
            PG8_LDA(At, 1, 1); PG8_STAGE(PG8_SB(1, 0), b3, voffB); PG8_STAGE(PG8_SB(1, 1), b3 + hstepB, voffB); PG8_STAGE_A(PG8_SA(1, 0), a3, 0, usen, s2);
            PG8_WAIT_V(8); PG8_WAIT_L(0); PG8_BAR; PG8_MMA(1, 0, At, B0); PG8_MMA(1, 1, At, B1); PG8_BAR; PG8_SCHED;
            } else {
            PG8_LDB(B0, 0, 0); PG8_SCHED; PG8_LDA(At, 0, 0); PG8_STAGE_A(PG8_SA(1, 1), a1, 1, false, s1);
            PG8_WAIT_L(8); PG8_BAR; PG8_WAIT_L(0); PG8_MMA(0, 0, At, B0); PG8_BAR; PG8_SCHED;
            PG8_LDB(B1, 0, 1); PG8_STAGE(PG8_SB(0, 0), b2, voffB);
            PG8_BAR; PG8_WAIT_L(0); PG8_MMA(0, 1, At, B1); PG8_BAR;
            PG8_LDA(At, 0, 1); PG8_STAGE_A(PG8_SA(0, 0), a2, 0, usen, s2);
            PG8_BAR; PG8_WAIT_L(0); PG8_MMA(1, 0, At, B0); PG8_BAR; PG8_SCHED;
            PG8_STAGE(PG8_SB(0, 1), b2 + hstepB, voffB);
            PG8_WAIT_V(6); PG8_BAR; PG8_MMA(1, 1, At, B1); PG8_BAR;
            PG8_LDB(B0, 1, 0); PG8_SCHED; PG8_LDA(At, 1, 0); PG8_STAGE_A(PG8_SA(0, 1), a2, 1, usen, s2);
            PG8_WAIT_L(8); PG8_BAR; PG8_WAIT_L(0); PG8_MMA(0, 0, At, B0); PG8_BAR; PG8_SCHED;
            PG8_LDB(B1, 1, 1); PG8_STAGE(PG8_SB(1, 0), b3, voffB);
            PG8_BAR; PG8_WAIT_L(0); PG8_MMA(0, 1, At, B1); PG8_BAR;
            PG8_LDA(At, 1, 1); PG8_STAGE_A(PG8_SA(1, 0), a3, 0, usen, s2);
            PG8_BAR; PG8_WAIT_L(0); PG8_MMA(1, 0, At, B0); PG8_BAR; PG8_SCHED;
            PG8_STAGE(PG8_SB(1, 1), b3 + hstepB, voffB);
            PG8_WAIT_V(6); PG8_BAR; PG8_MMA(1, 1, At, B1); PG8_BAR;
            }
        }
        if constexpr (ALIGN_EPI) { if (wr == 0) PG8_BAR; }
        if constexpr (MX) asm volatile("s_nop 15\n\ts_nop 15" ::: "memory");
#ifdef PG8_EPI_TWICE
        if constexpr (!Epi::AFTER_DRAIN) { E(acc, cur, wr, wc, fr, fq); asm volatile("" ::: "memory"); }
#endif
        if constexpr (!Epi::AFTER_DRAIN) { E(acc, cur, wr, wc, fr, fq); S.done(cur); }
        if (!has_next) break;
#pragma unroll
        for (int a = 0; a < 2; ++a)
#pragma unroll
            for (int b = 0; b < 2; ++b)
#pragma unroll
                for (int m = 0; m < 4; ++m)
#pragma unroll
                    for (int n = 0; n < 2; ++n) acc[a][b][m][n] = (f32x4){0.f, 0.f, 0.f, 0.f};
        cur = nxt; cA = nA; cB = nB; ++ui; cA2 = (const char*)g.A2 + (size_t)cur.pm * 2 * hstepA2;
        if constexpr (GA) { _Pragma("unroll") for (int h = 0; h < 2; ++h) _Pragma("unroll") for (int i = 0; i < 2; ++i) cG[h][i] = nG[h][i]; }
        if constexpr (ALIGN_EPI) { if (wr == 1) PG8_BAR; }
    }
    PG8_WAIT_V(0);
    if constexpr (!ALIGN_EPI) { if (wr == 0) PG8_BAR; }
    PG8_BAR;
    if constexpr (Epi::AFTER_DRAIN) { E.fused(acc, cur, wr, wc, fr, fq, lds, wid, lane); S.done(cur); }
#undef PG8_SA
#undef PG8_SB
#undef PG8_STAGE
#undef PG8_LDA
#undef PG8_LDB
#undef PG8_MMA
#undef PG8_WAIT_V
#undef PG8_WAIT_L
#undef PG8_BAR
#undef PG8_SCHED
}
}

#ifndef PG8_SP2
#define PG8_SP2 true
#endif
#ifndef PG8_ALIGN
#define PG8_ALIGN true
#endif

#define DI __device__ __forceinline__
#define LAS __attribute__((address_space(3)))
typedef unsigned short bf16;
typedef _Float16 f16;
typedef unsigned v4u __attribute__((ext_vector_type(4)));
typedef unsigned v2u __attribute__((ext_vector_type(2)));
typedef float f32x4 __attribute__((ext_vector_type(4)));
typedef float f32x2 __attribute__((ext_vector_type(2)));
typedef float f32x16 __attribute__((ext_vector_type(16)));
typedef short bf16x8 __attribute__((ext_vector_type(8)));
typedef _Float16 f16x8 __attribute__((ext_vector_type(8)));
typedef _Float16 f16x4 __attribute__((ext_vector_type(4)));
typedef __bf16 bf16x2_t __attribute__((ext_vector_type(2)));

constexpr int NB = 32, T = 2048, D = 1024, M = NB * T;
constexpr int RC = 1920, NQKV = 768, NGATE = 2048, NIN = 4736, NINP = 4864;
constexpr int RD = 512, NH = 8, HS = 64;
constexpr int NLK = 384, NLN = 2560;
constexpr int NE = 16, CAP = 256, FF = 1024, MS = NB * NE * CAP;
constexpr float DECAY_SCALE = 0.60653065971263342f;
constexpr float LNX_EPS = 64e-5f, NORM_EPS = 1e-6f;
constexpr int NWAVES = 8, NTHREADS = 512;

constexpr size_t MiB = 1u << 20;
constexpr size_t WS_CTL = 0;
constexpr size_t WS_KN = 1 * MiB;
constexpr size_t WS_AFFT = 5 * MiB;
constexpr size_t WS_SEL = 9 * MiB;
constexpr size_t WS_VAL = 13 * MiB;
constexpr size_t WS_RSTD = 13 * MiB + 768 * 1024;
constexpr size_t WS_LBIAS = 13 * MiB + 512 * 1024;
constexpr size_t WS_VT = 14 * MiB;
constexpr size_t WS_WIN = 30 * MiB;
constexpr size_t WS_WG8 = 36 * MiB;
constexpr size_t WS_WPR = 40 * MiB;
constexpr size_t WS_WPA = 41 * MiB;
constexpr size_t WS_WOUT = 42 * MiB;
constexpr size_t WS_WLORA = 44 * MiB;
constexpr size_t WS_WGU = 46 * MiB;
constexpr size_t WS_WD = 110 * MiB;
constexpr size_t WS_UR = 142 * MiB;
constexpr size_t WS_G = 606 * MiB;
constexpr size_t WS_YF = 206 * MiB;
constexpr size_t WS_YB = 270 * MiB;
constexpr size_t WS_HID = 142 * MiB;
constexpr size_t WS_QKV = 382 * MiB;
constexpr size_t WS_GATES = 478 * MiB;
constexpr size_t WS_XG = 478 * MiB;
constexpr size_t WS_YS = 478 * MiB;
constexpr size_t WS_RKV = 734 * MiB;
constexpr size_t WS_AP = 926 * MiB;
constexpr size_t WS_MERGED = 734 * MiB;
constexpr size_t WS_X1B = 862 * MiB;
constexpr size_t WS_END = 1024 * MiB;
constexpr size_t OUT_AW = 64 * MiB;

constexpr int LDS_BYTES = 151552;

#define LDS_WAIT() asm volatile("s_waitcnt lgkmcnt(0)" ::: "memory")
DI unsigned f2bf(float f) { unsigned u = __builtin_bit_cast(unsigned, f); return (u + 0x7fffu + ((u >> 16) & 1u)) >> 16; }
DI unsigned pk2(float lo, float hi) { f32x2 v = {lo, hi}; bf16x2_t b = __builtin_convertvector(v, bf16x2_t); return __builtin_bit_cast(unsigned, b); }
DI float bflo(unsigned w) { return __builtin_bit_cast(float, w << 16); }
DI float bfhi(unsigned w) { return __builtin_bit_cast(float, w & 0xffff0000u); }
DI float bf2f(bf16 b) { return __builtin_bit_cast(float, (unsigned)b << 16); }
DI float sigmoidf_(float x) { return __builtin_amdgcn_rcpf(1.0f + __expf(-x)); }
DI float wave_sum(float v) {
#pragma unroll
    for (int o = 1; o < 64; o <<= 1) v += __shfl_xor(v, o);
    return v;
}
DI float wave_max(float v) {
#pragma unroll
    for (int o = 1; o < 64; o <<= 1) v = fmaxf(v, __shfl_xor(v, o));
    return v;
}

struct Args { const float* in[29]; float* out; unsigned char* ws; int ph_lo, ph_hi; };
struct KIn { DI const float* operator[](int i) const { return ((const float* const*)__builtin_amdgcn_kernarg_segment_ptr())[i]; } };
struct DArgs { KIn in; float* out; unsigned char* ws; };

enum { I_X = 0, I_NMG, I_WIN, I_MUP, I_MUN, I_W0F, I_WUPF, I_W0B, I_WUPB, I_A0F, I_AUPF, I_A0B, I_AUPB, I_GUP, I_KK, I_KA, I_RK, I_LNW, I_LNB, I_SINK,
       I_WPR, I_WPA, I_WOUT, I_NFG, I_WR, I_EG, I_EU, I_ED, I_NFINAL };

DI void transpose_item(const float* __restrict__ W, int ldw, int k0, int n0, bf16* WT, size_t drow0, int ldt, int dk0, LAS float* scr, int lane) {
    f32x4 t[8];
#pragma unroll
    for (int i = 0; i < 8; ++i) t[i] = *(const f32x4*)(W + (size_t)(k0 + 8 * i + (lane >> 3)) * ldw + n0 + 4 * (lane & 7));
#pragma unroll
    for (int i = 0; i < 8; ++i) { LAS float* d = scr + (8 * i + (lane >> 3)) * 33 + 4 * (lane & 7); d[0] = t[i][0]; d[1] = t[i][1]; d[2] = t[i][2]; d[3] = t[i][3]; }
    LDS_WAIT(); asm volatile("" ::: "memory");
    const int c = lane & 7;
#pragma unroll
    for (int j = 0; j < 4; ++j) { const int n = (lane >> 3) + 8 * j; const LAS float* s = scr + (8 * c) * 33 + n;
        v4u o; o.x = pk2(s[0 * 33], s[1 * 33]); o.y = pk2(s[2 * 33], s[3 * 33]); o.z = pk2(s[4 * 33], s[5 * 33]); o.w = pk2(s[6 * 33], s[7 * 33]);
        *(v4u*)(WT + (drow0 + n) * (size_t)ldt + dk0 + 8 * c) = o; }
    LDS_WAIT(); asm volatile("" ::: "memory");
}

DI unsigned pk4_fp8(float a, float b, float c, float d) { unsigned w = 0; w = __builtin_amdgcn_cvt_pk_fp8_f32(a, b, w, false); w = __builtin_amdgcn_cvt_pk_fp8_f32(c, d, w, true); return w; }
DI void transpose_item_f8(const float* __restrict__ W, int ldw, int k0, int n0, unsigned char* WT, size_t drow0, int ldt, int dk0, LAS float* scr, int lane, float scale) {
    f32x4 t[8];
#pragma unroll
    for (int i = 0; i < 8; ++i) t[i] = *(const f32x4*)(W + (size_t)(k0 + 8 * i + (lane >> 3)) * ldw + n0 + 4 * (lane & 7));
#pragma unroll
    for (int i = 0; i < 8; ++i) { LAS float* d = scr + (8 * i + (lane >> 3)) * 33 + 4 * (lane & 7); d[0] = t[i][0] * scale; d[1] = t[i][1] * scale; d[2] = t[i][2] * scale; d[3] = t[i][3] * scale; }
    LDS_WAIT(); asm volatile("" ::: "memory");
    const int c = lane & 7;
#pragma unroll
    for (int j = 0; j < 4; ++j) { const int n = (lane >> 3) + 8 * j; const LAS float* s = scr + (8 * c) * 33 + n;
        v2u o; o.x = pk4_fp8(s[0 * 33], s[1 * 33], s[2 * 33], s[3 * 33]); o.y = pk4_fp8(s[4 * 33], s[5 * 33], s[6 * 33], s[7 * 33]);
        *(v2u*)(WT + (drow0 + n) * (size_t)ldt + dk0 + 8 * c) = o; }
    LDS_WAIT(); asm volatile("" ::: "memory");
}

DI void phase0(const DArgs& a, LAS unsigned char* lds, int G, int vcu) {
    const int tid = threadIdx.x, lane = tid & 63, wave = __builtin_amdgcn_readfirstlane(tid >> 6);
    LAS float* scr = (LAS float*)(lds + wave * 16384);
    const int gw = vcu * NWAVES + wave, NGW = G * NWAVES;
    unsigned char* ws = a.ws;
    constexpr int J1 = 16 * 148, J2 = 8 * 32, J3 = J2, J4 = 16 * 32, JE = 16 * 32, J5 = NE * JE;
    constexpr int NITEMS = J1 + J2 + J3 + J4 + 3 * J5;
    for (int it = gw; it < NITEMS; it += NGW) {
        int r = it;
        if (r < J1) { const int kb = r / 148, nb = r % 148;
            if (nb < 84) transpose_item(a.in[I_WIN], NIN, 64 * kb, 32 * nb, (bf16*)(ws + WS_WIN), 32 * nb, D, 64 * kb, scr, lane);
            else transpose_item_f8(a.in[I_WIN], NIN, 64 * kb, 32 * nb, (unsigned char*)(ws + WS_WG8), 32 * nb - 2688, D, 64 * kb, scr, lane, 32.0f);
            continue; } r -= J1;
        if (r < J2) { const int kb = r / 32, nb = r % 32; transpose_item(a.in[I_WPR], D, 64 * kb, 32 * nb, (bf16*)(ws + WS_WPR), 32 * nb, D, 64 * kb, scr, lane); continue; } r -= J2;
        if (r < J3) { const int kb = r / 32, nb = r % 32; transpose_item(a.in[I_WPA], D, 64 * kb, 32 * nb, (bf16*)(ws + WS_WPR), 32 * nb, D, 512 + 64 * kb, scr, lane); continue; } r -= J3;
        if (r < J4) { const int kb = r / 32, nb = r % 32; transpose_item(a.in[I_WOUT], D, 64 * kb, 32 * nb, (bf16*)(ws + WS_WOUT), 32 * nb, D, 64 * kb, scr, lane); continue; } r -= J4;
        if (r < J5) { const int e = r / JE, q = r % JE, kb = q / 32, nb = q % 32, n0 = 32 * nb;
            transpose_item_f8(a.in[I_EG] + (size_t)e * D * FF, FF, 64 * kb, n0, (unsigned char*)(ws + WS_WGU) + (size_t)e * 2048 * D, (n0 / 128) * 256 + (n0 % 128), D, 64 * kb, scr, lane, 32.0f); continue; } r -= J5;
        if (r < J5) { const int e = r / JE, q = r % JE, kb = q / 32, nb = q % 32, n0 = 32 * nb;
            transpose_item_f8(a.in[I_EU] + (size_t)e * D * FF, FF, 64 * kb, n0, (unsigned char*)(ws + WS_WGU) + (size_t)e * 2048 * D, (n0 / 128) * 256 + 128 + (n0 % 128), D, 64 * kb, scr, lane, 32.0f); continue; } r -= J5;
        { const int e = r / JE, q = r % JE, kb = q / 32, nb = q % 32;
            transpose_item_f8(a.in[I_ED] + (size_t)e * FF * D, D, 64 * kb, 32 * nb, (unsigned char*)(ws + WS_WD) + (size_t)e * D * FF, 32 * nb, FF, 64 * kb, scr, lane, 32.0f); }
    }
    {
        bf16* WL = (bf16*)(ws + WS_WLORA);
        const int gt = vcu * NTHREADS + tid, NGT = G * NTHREADS;
        for (int idx = gt; idx < 2560 * 16; idx += NGT) {
            const int n = idx >> 4, k = (idx & 15) * 8;
            const float* src = nullptr; int nn = n, koff = 0, klen = 128;
            if (n < 512) { src = a.in[I_GUP]; }
            else if (n < 1024) { src = a.in[I_WUPF]; nn = n - 512; klen = 64; }
            else if (n < 1536) { src = a.in[I_WUPB]; nn = n - 1024; koff = 64; klen = 64; }
            else if (n < 2048) { src = a.in[I_AUPF]; nn = n - 1536; klen = 64; }
            else { src = a.in[I_AUPB]; nn = n - 2048; koff = 64; klen = 64; }
            float v[8];
#pragma unroll
            for (int j = 0; j < 8; ++j) { const int kk = k + j - koff; v[j] = (kk >= 0 && kk < klen) ? src[(size_t)kk * 512 + nn] : 0.f; }
            v4u o; o.x = pk2(v[0], v[1]); o.y = pk2(v[2], v[3]); o.z = pk2(v[4], v[5]); o.w = pk2(v[6], v[7]);
            *(v4u*)(WL + (size_t)n * 128 + k) = o;
        }
    }
    if (vcu == 0) {
        float* LB = (float*)(ws + WS_LBIAS);
        LB[tid] = a.in[I_W0F][tid]; LB[512 + tid] = a.in[I_W0B][tid]; LB[1024 + tid] = a.in[I_A0F][tid]; LB[1536 + tid] = a.in[I_A0B][tid];
    }
    {
        bf16* H = (bf16*)a.out; unsigned char* H8 = (unsigned char*)a.out + 128 * MiB; const float* x = a.in[I_X]; const float* g = a.in[I_NMG];
        f32x4 gv[4];
#pragma unroll
        for (int j = 0; j < 4; ++j) gv[j] = *(const f32x4*)(g + 4 * lane + 256 * j);
        for (int m = gw * 2; m < M; m += NGW * 2) {
            const f32x4* xr = (const f32x4*)(x + (size_t)m * D) + lane;
            f32x4 v[4], u[4]; float s = 0.f, s2 = 0.f;
#pragma unroll
            for (int j = 0; j < 4; ++j) { v[j] = xr[64 * j]; u[j] = xr[64 * j + D / 4]; }
#pragma unroll
            for (int j = 0; j < 4; ++j) { s += (v[j].x * v[j].x + v[j].y * v[j].y) + (v[j].z * v[j].z + v[j].w * v[j].w); s2 += (u[j].x * u[j].x + u[j].y * u[j].y) + (u[j].z * u[j].z + u[j].w * u[j].w); }
            const float rstd = rsqrtf(wave_sum(s) * (1.f / D) + NORM_EPS), rstd2 = rsqrtf(wave_sum(s2) * (1.f / D) + NORM_EPS);
            v2u* o = (v2u*)(H + (size_t)m * D) + lane; unsigned* o8 = (unsigned*)(H8 + (size_t)m * D) + lane;
#pragma unroll
            for (int j = 0; j < 4; ++j) { const f32x4 h1 = v[j] * rstd * gv[j], h2 = u[j] * rstd2 * gv[j];
                v2u w; w.x = pk2(h1.x, h1.y); w.y = pk2(h1.z, h1.w); o[64 * j] = w; o8[64 * j] = pk4_fp8(h1.x, h1.y, h1.z, h1.w);
                v2u w2; w2.x = pk2(h2.x, h2.y); w2.y = pk2(h2.z, h2.w); o[64 * j + D / 4] = w2; o8[64 * j + D / 4] = pk4_fp8(h2.x, h2.y, h2.z, h2.w); }
        }
    }
}

using pg8::Unit;
struct EpiA {
    static constexpr bool PERM = true, AFTER_DRAIN = false;
    bf16* UR; bf16* QKV; bf16* GATES;
    DI void operator()(const f32x4 (&acc)[2][2][4][2], const Unit& u, int wr, int wc, int fr, int fq) const {
        const int row0 = u.pm * 256 + wr * 64 + fr;
#pragma unroll
        for (int bj = 0; bj < 2; ++bj) {
            const int cb = u.pn * 2 + bj;
            if (cb >= 21) continue;
            bf16* base; int ld, colb, mode;
            if (cb < 15) { base = UR; ld = RC; colb = cb * 128; mode = 0; }
            else if (cb < 21) { base = QKV; ld = NQKV; colb = (cb - 15) * 128; mode = (cb < 19) ? 1 : 0; }
            else { base = GATES; ld = NGATE; colb = (cb - 21) * 128; mode = 2; }
            const int col = colb + wc * 32 + 8 * fq;
#pragma unroll
            for (int ai = 0; ai < 2; ++ai)
#pragma unroll
                for (int m = 0; m < 4; ++m) {
                    f32x4 v0 = acc[ai][bj][m][0], v1 = acc[ai][bj][m][1];
                    if (mode == 1) { v0 = v0 * 0.125f; v1 = v1 * 0.125f; }
                    else if (mode == 2) {
#pragma unroll
                        for (int i = 0; i < 4; ++i) { v0[i] = sigmoidf_(v0[i]); v1[i] = sigmoidf_(v1[i]); }
                    }
                    if (mode == 2) {
                        unsigned q[8];
#pragma unroll
                        for (int i = 0; i < 4; ++i) { q[i] = (unsigned)(v0[i] * 255.0f + 0.5f); q[4 + i] = (unsigned)(v1[i] * 255.0f + 0.5f); }
                        v2u w; w.x = q[0] | (q[1] << 8) | (q[2] << 16) | (q[3] << 24); w.y = q[4] | (q[5] << 8) | (q[6] << 16) | (q[7] << 24);
                        *(v2u*)((unsigned char*)GATES + (size_t)(row0 + ai * 128 + m * 16) * NGATE + col) = w;
                    } else {
                        v4u w; w.x = pk2(v0[0], v0[1]); w.y = pk2(v0[2], v0[3]); w.z = pk2(v1[0], v1[1]); w.w = pk2(v1[2], v1[3]);
                        *(v4u*)(base + (size_t)(row0 + ai * 128 + m * 16) * ld + col) = w;
                    }
                }
        }
    }
};
struct EpiGates {
    static constexpr bool PERM = true, AFTER_DRAIN = false;
    unsigned char* GATES;
    DI void operator()(const f32x4 (&acc)[2][2][4][2], const Unit& u, int wr, int wc, int fr, int fq) const {
        asm volatile("" : "+v"(fr), "+v"(fq));
        const int row0 = u.pm * 256 + wr * 64 + fr;
#pragma unroll
        for (int bj = 0; bj < 2; ++bj) {
            const int col = u.pn * 256 + bj * 128 + wc * 32 + 8 * fq;
#pragma unroll
            for (int ai = 0; ai < 2; ++ai)
#pragma unroll
                for (int m = 0; m < 4; ++m) {
                    unsigned q[8];
#pragma unroll
                    for (int i = 0; i < 4; ++i) { q[i] = (unsigned)(sigmoidf_(acc[ai][bj][m][0][i] * 0.03125f) * 255.0f + 0.5f); q[4 + i] = (unsigned)(sigmoidf_(acc[ai][bj][m][1][i] * 0.03125f) * 255.0f + 0.5f); }
                    v2u w; w.x = q[0] | (q[1] << 8) | (q[2] << 16) | (q[3] << 24); w.y = q[4] | (q[5] << 8) | (q[6] << 16) | (q[7] << 24);
                    *(v2u*)(GATES + (size_t)(row0 + ai * 128 + m * 16) * NGATE + col) = w;
                }
        }
    }
};
struct EpiLoraZ {
    static constexpr bool PERM = true, AFTER_DRAIN = false;
    bf16* Gout; f16* AW; const float* lbias;
    DI void operator()(const f32x4 (&acc)[2][2][4][2], const Unit& u, int wr, int wc, int fr, int fq) const {
        const int row0 = u.pm * 256 + wr * 64 + fr;
        if (u.pn < 2) {
#pragma unroll
            for (int bj = 0; bj < 2; ++bj)
#pragma unroll
                for (int ai = 0; ai < 2; ++ai)
#pragma unroll
                    for (int m = 0; m < 4; ++m) {
                        const f32x4 v0 = acc[ai][bj][m][0], v1 = acc[ai][bj][m][1];
                        v4u w; w.x = pk2(v0[0], v0[1]); w.y = pk2(v0[2], v0[3]); w.z = pk2(v1[0], v1[1]); w.w = pk2(v1[2], v1[3]);
                        *(v4u*)(Gout + (size_t)(row0 + ai * 128 + m * 16) * 512 + u.pn * 256 + bj * 128 + wc * 32 + 8 * fq) = w;
                    }
        } else {
            const int q = u.pn - 2, grp = q >> 2, half = (q >> 1) & 1, cc = (q & 1) * 256 + wc * 32 + 8 * fq;
            f16* dst = (f16*)((unsigned char*)AW + (size_t)((grp == 0 ? 2 : 0) + half) * OUT_AW);
            const float* bias = lbias + (grp * 2 + half) * 512 + cc;
            const float dsc = -DECAY_SCALE * 1.4426950408889634f;
#pragma unroll
            for (int bj = 0; bj < 2; ++bj) {
                const f32x4 b0 = *(const f32x4*)(bias + bj * 128), b1 = *(const f32x4*)(bias + bj * 128 + 4);
#pragma unroll
                for (int ai = 0; ai < 2; ++ai)
#pragma unroll
                    for (int m = 0; m < 4; ++m) {
                        f32x4 v0 = acc[ai][bj][m][0] + b0, v1 = acc[ai][bj][m][1] + b1;
                        asm volatile("" : "+v"(v0), "+v"(v1));
                        f16x8 h;
#pragma unroll
                        for (int i = 0; i < 4; ++i) {
                            float s0 = sigmoidf_(v0[i]), s1 = sigmoidf_(v1[i]);
                            if (grp == 0) { s0 = __builtin_amdgcn_exp2f(dsc * s0); s1 = __builtin_amdgcn_exp2f(dsc * s1); }
                            h[i] = (f16)s0; h[4 + i] = (f16)s1;
                        }
                        *(f16x8*)(dst + (size_t)(row0 + ai * 128 + m * 16) * 512 + cc + bj * 128) = h;
                    }
            }
        }
    }
};
struct EpiMerge2 {
    static constexpr bool PERM = true, AFTER_DRAIN = false;
    bf16* MG; const unsigned char* GATES;
#define EPI_MEMBAR asm volatile("" ::: "memory")
    DI void mid(f32x4 (&acc)[2][2][4][2], const Unit& u, int wr, int wc, int fr, int fq) const {
        const int row0 = u.pm * 256 + wr * 64 + fr;
        v2u gr[2][2][4], ga[2][2][4];
#pragma unroll
        for (int bj = 0; bj < 2; ++bj) {
            const int col = u.pn * 256 + bj * 128 + wc * 32 + 8 * fq;
#pragma unroll
            for (int ai = 0; ai < 2; ++ai)
#pragma unroll
                for (int m = 0; m < 4; ++m) {
                    const size_t row = (size_t)(row0 + ai * 128 + m * 16);
                    gr[bj][ai][m] = *(const v2u*)(GATES + row * NGATE + col); ga[bj][ai][m] = *(const v2u*)(GATES + row * NGATE + 1024 + col);
                }
        }
        EPI_MEMBAR;
#pragma unroll
        for (int bj = 0; bj < 2; ++bj)
#pragma unroll
            for (int ai = 0; ai < 2; ++ai)
#pragma unroll
                for (int m = 0; m < 4; ++m) {
                    const unsigned grw[2] = {gr[bj][ai][m].x, gr[bj][ai][m].y}, gaw[2] = {ga[bj][ai][m].x, ga[bj][ai][m].y};
#pragma unroll
                    for (int n = 0; n < 2; ++n)
#pragma unroll
                        for (int i = 0; i < 4; ++i) {
                            const float fr_ = (float)((grw[n] >> (8 * i)) & 0xffu), fa_ = fmaxf((float)((gaw[n] >> (8 * i)) & 0xffu), 0.25f);
                            acc[ai][bj][m][n][i] *= fr_ * __builtin_amdgcn_rcpf(fa_);
                        }
                }
    }
    DI void operator()(const f32x4 (&acc)[2][2][4][2], const Unit& u, int wr, int wc, int fr, int fq) const {
        const int row0 = u.pm * 256 + wr * 64 + fr;
        v2u ga[2][2][4];
#pragma unroll
        for (int bj = 0; bj < 2; ++bj) {
            const int col = u.pn * 256 + bj * 128 + wc * 32 + 8 * fq;
#pragma unroll
            for (int ai = 0; ai < 2; ++ai)
#pragma unroll
                for (int m = 0; m < 4; ++m) ga[bj][ai][m] = *(const v2u*)(GATES + (size_t)(row0 + ai * 128 + m * 16) * NGATE + 1024 + col);
        }
        EPI_MEMBAR;
#pragma unroll
        for (int bj = 0; bj < 2; ++bj) {
            const int col = u.pn * 256 + bj * 128 + wc * 32 + 8 * fq;
#pragma unroll
            for (int ai = 0; ai < 2; ++ai)
#pragma unroll
                for (int m = 0; m < 4; ++m) {
                    const size_t row = (size_t)(row0 + ai * 128 + m * 16);
                    const unsigned gaw[2] = {ga[bj][ai][m].x, ga[bj][ai][m].y};
                    float o[8];
#pragma unroll
                    for (int n = 0; n < 2; ++n)
#pragma unroll
                        for (int i = 0; i < 4; ++i) o[4 * n + i] = acc[ai][bj][m][n][i] * (fmaxf((float)((gaw[n] >> (8 * i)) & 0xffu), 0.25f) * (1.0f / 255.0f));
                    v4u w; w.x = pk2(o[0], o[1]); w.y = pk2(o[2], o[3]); w.z = pk2(o[4], o[5]); w.w = pk2(o[6], o[7]);
                    *(v4u*)(MG + row * D + col) = w;
                }
        }
    }
};
struct EpiResid {
    static constexpr bool PERM = true, AFTER_DRAIN = false;
    const float* X; bf16* O;
    DI void operator()(const f32x4 (&acc)[2][2][4][2], const Unit& u, int wr, int wc, int fr, int fq) const {
        const int row0 = u.pm * 256 + wr * 64 + fr, col0 = u.pn * 256 + wc * 32 + 8 * fq;
        f32x4 xa[2][2][2], xb[2][2][2];
#define EPIR_LOAD(xv, b) do { _Pragma("unroll") for (int mm = 0; mm < 2; ++mm) { const size_t off = (size_t)(row0 + ((b) >> 1) * 128 + (((b) & 1) * 2 + mm) * 16) * D + col0; \
            _Pragma("unroll") for (int bj = 0; bj < 2; ++bj) { xv[mm][bj][0] = *(const f32x4*)(X + off + bj * 128); xv[mm][bj][1] = *(const f32x4*)(X + off + bj * 128 + 4); } } } while (0)
#define EPIR_PROC(xv, b) do { _Pragma("unroll") for (int mm = 0; mm < 2; ++mm) { const int ai = (b) >> 1, m = ((b) & 1) * 2 + mm; const size_t off = (size_t)(row0 + ai * 128 + m * 16) * D + col0; \
            _Pragma("unroll") for (int bj = 0; bj < 2; ++bj) { const f32x4 v0 = xv[mm][bj][0] + acc[ai][bj][m][0], v1 = xv[mm][bj][1] + acc[ai][bj][m][1]; \
                v4u w; w.x = pk2(v0[0], v0[1]); w.y = pk2(v0[2], v0[3]); w.z = pk2(v1[0], v1[1]); w.w = pk2(v1[2], v1[3]); *(v4u*)(O + off + bj * 128) = w; } } } while (0)
        EPIR_LOAD(xa, 0); EPIR_LOAD(xb, 1); EPI_MEMBAR;
        EPIR_PROC(xa, 0); EPI_MEMBAR; EPIR_LOAD(xa, 2); EPI_MEMBAR;
        EPIR_PROC(xb, 1); EPI_MEMBAR; EPIR_LOAD(xb, 3); EPI_MEMBAR;
        EPIR_PROC(xa, 2); EPI_MEMBAR;
        EPIR_PROC(xb, 3);
#undef EPIR_LOAD
#undef EPIR_PROC
    }
};
struct EpiSwiglu {
    static constexpr bool PERM = true, AFTER_DRAIN = false;
    unsigned char* HID;
    DI void operator()(const f32x4 (&acc)[2][2][4][2], const Unit& u, int wr, int wc, int fr, int fq) const {
        asm volatile("" : "+v"(fr), "+v"(fq));
        const int row0 = u.pm * 256 + wr * 64 + fr, col = u.pn * 128 + wc * 32 + 8 * fq;
#pragma unroll
        for (int ai = 0; ai < 2; ++ai)
#pragma unroll
            for (int m = 0; m < 4; ++m) {
                float o[8];
#pragma unroll
                for (int n = 0; n < 2; ++n)
#pragma unroll
                    for (int i = 0; i < 4; ++i) { const float gt = acc[ai][0][m][n][i] * 0.03125f, up = acc[ai][1][m][n][i] * 0.03125f; o[4 * n + i] = gt * sigmoidf_(gt) * up; }
                v2u w; w.x = pk4_fp8(o[0], o[1], o[2], o[3]); w.y = pk4_fp8(o[4], o[5], o[6], o[7]);
                *(v2u*)(HID + (size_t)(row0 + ai * 128 + m * 16) * FF + col) = w;
            }
    }
};
struct EpiYs {
    static constexpr bool PERM = true, AFTER_DRAIN = false;
    bf16* YS; const float* VAL;
    DI void operator()(const f32x4 (&acc)[2][2][4][2], const Unit& u, int wr, int wc, int fr, int fq) const {
        asm volatile("" : "+v"(fr), "+v"(fq));
        const int row0 = u.pm * 256 + wr * 64 + fr;
        float svv[2][4];
#pragma unroll
        for (int ai = 0; ai < 2; ++ai)
#pragma unroll
            for (int m = 0; m < 4; ++m) svv[ai][m] = VAL[(size_t)(row0 + ai * 128 + m * 16)];
        EPI_MEMBAR;
#pragma unroll
        for (int ai = 0; ai < 2; ++ai)
#pragma unroll
            for (int m = 0; m < 4; ++m) {
                const size_t row = (size_t)(row0 + ai * 128 + m * 16);
                const float sv = svv[ai][m] * 0.03125f;
#pragma unroll
                for (int bj = 0; bj < 2; ++bj) {
                    const int col = u.pn * 256 + bj * 128 + wc * 32 + 8 * fq;
                    const f32x4 v0 = acc[ai][bj][m][0] * sv, v1 = acc[ai][bj][m][1] * sv;
                    v4u w; w.x = pk2(v0[0], v0[1]); w.y = pk2(v0[2], v0[3]); w.z = pk2(v1[0], v1[1]); w.w = pk2(v1[2], v1[3]);
                    *(v4u*)(YS + row * D + col) = w;
                }
            }
    }
};

DI void phaseP1(const DArgs& a, LAS unsigned char* lds, int own) {
    const int tid = threadIdx.x, lane = tid & 63, wave = __builtin_amdgcn_readfirstlane(tid >> 6);
    unsigned char* ws = a.ws;
    const bf16* UR = (const bf16*)(ws + WS_UR);
    f16* RKV = (f16*)(ws + WS_RKV); bf16* AP = (bf16*)(ws + WS_AP);
    float mp[4][8], mn[4][8], kc[8];
#pragma unroll
    for (int i = 0; i < 4; ++i) { const int cidx = lane + 64 * i; const int col = (cidx < RC / 8 ? cidx : 0) * 8;
#pragma unroll
        for (int j = 0; j < 8; ++j) { mp[i][j] = a.in[I_MUP][col + j]; mn[i][j] = a.in[I_MUN][col + j]; } }
#pragma unroll
    for (int j = 0; j < 8; ++j) kc[j] = a.in[I_KK][lane * 8 + j];
    const bool act3 = lane + 192 < RC / 8;
#define P1_LOADROW(dst, rowp) do { _Pragma("unroll") for (int i_ = 0; i_ < 4; ++i_) { if (i_ < 3 || act3) dst[i_] = *(const v4u*)((rowp) + (lane + 64 * i_) * 8); else dst[i_] = (v4u){0u, 0u, 0u, 0u}; } } while (0)
    { const int r0 = own * 256 + wave * 32;
        const int t0 = r0 & (T - 1);
        const bf16* rp = UR + (size_t)r0 * RC;
        v4u prev[4], cur[4], nxt[4], nn[4];
        if (t0 > 0) P1_LOADROW(prev, rp - RC); else { _Pragma("unroll") for (int i = 0; i < 4; ++i) prev[i] = (v4u){0u, 0u, 0u, 0u}; }
        P1_LOADROW(cur, rp); P1_LOADROW(nxt, rp + RC);
#pragma unroll 1
        for (int r = 0; r < 32; ++r) {
            const int m = r0 + r, t = t0 + r;
            if (t + 2 < T) P1_LOADROW(nn, rp + (size_t)(r + 2) * RC); else { _Pragma("unroll") for (int i = 0; i < 4; ++i) nn[i] = (v4u){0u, 0u, 0u, 0u}; }
#pragma unroll
            for (int i = 0; i < 4; ++i) {
                if (i < 3 || act3) {
                    const int col = (lane + 64 * i) * 8;
                    float o[8];
                    const unsigned ucw[4] = {cur[i].x, cur[i].y, cur[i].z, cur[i].w}, upw[4] = {prev[i].x, prev[i].y, prev[i].z, prev[i].w}, unw[4] = {nxt[i].x, nxt[i].y, nxt[i].z, nxt[i].w};
#pragma unroll
                    for (int j = 0; j < 4; ++j) {
                        const float c0 = bflo(ucw[j]), c1 = bfhi(ucw[j]), p0 = bflo(upw[j]), p1 = bfhi(upw[j]), n0 = bflo(unw[j]), n1 = bfhi(unw[j]);
                        o[2 * j] = c0 + mp[i][2 * j] * (p0 - c0) + mn[i][2 * j] * (n0 - c0);
                        o[2 * j + 1] = c1 + mp[i][2 * j + 1] * (p1 - c1) + mn[i][2 * j + 1] * (n1 - c1);
                    }
                    if (i == 1) {
                        float ssq = 0.f;
#pragma unroll
                        for (int j = 0; j < 8; ++j) { const float e0 = o[j] * kc[j]; ssq += e0 * e0; }
                        ssq += __shfl_xor(ssq, 1); ssq += __shfl_xor(ssq, 2); ssq += __shfl_xor(ssq, 4);
                        if ((lane & 7) == 0) ((float*)(ws + WS_KN))[(size_t)m * 8 + (lane >> 3)] = 1.0f / fmaxf(sqrtf(ssq), 1e-12f);
                    }
                    if (i < 3) {
                        f16x8 h;
#pragma unroll
                        for (int j = 0; j < 8; ++j) h[j] = (f16)o[j];
                        *(f16x8*)(RKV + (size_t)i * ((size_t)M * 512) + (size_t)m * 512 + lane * 8) = h;
                    } else {
                        const int ac = lane * 8;
                        if (ac < 128) {
#pragma unroll
                            for (int j = 0; j < 8; ++j) o[j] = sigmoidf_(o[j]);
                        } else if (ac < 256) {
#pragma unroll
                            for (int j = 0; j < 8; ++j) o[j] = tanhf(o[j]);
                        }
                        v4u w; w.x = pk2(o[0], o[1]); w.y = pk2(o[2], o[3]); w.z = pk2(o[4], o[5]); w.w = pk2(o[6], o[7]);
                        *(v4u*)(AP + (size_t)m * NLK + ac) = w;
                    }
                }
            }
#pragma unroll
            for (int i = 0; i < 4; ++i) { prev[i] = cur[i]; cur[i] = nxt[i]; nxt[i] = nn[i]; }
        }
    }
#undef P1_LOADROW
    {
        const bf16* QKV = (const bf16*)(ws + WS_QKV); bf16* VT = (bf16*)(ws + WS_VT);
        LAS bf16* tile = (LAS bf16*)lds;
        for (int tl = own * 4; tl < own * 4 + 4; ++tl) {
            const int m0 = tl * 64, b = m0 / T, t0 = m0 % T;
            __syncthreads();
#pragma unroll
            for (int i = 0; i < 2; ++i) { const int ch = tid + 512 * i, r = ch >> 4, c8 = (ch & 15) * 8;
                const v4u v = *(const v4u*)(QKV + (size_t)(m0 + r) * NQKV + 640 + c8);
                *(LAS v4u*)(tile + r * 136 + c8) = v; }
            __syncthreads();
#pragma unroll
            for (int i = 0; i < 2; ++i) { const int ch = tid + 512 * i, dcol = ch >> 3, tq = (ch & 7) * 8;
                unsigned short e[8];
#pragma unroll
                for (int j = 0; j < 8; ++j) e[j] = tile[(tq + j) * 136 + dcol];
                v4u w; w.x = e[0] | ((unsigned)e[1] << 16); w.y = e[2] | ((unsigned)e[3] << 16); w.z = e[4] | ((unsigned)e[5] << 16); w.w = e[6] | ((unsigned)e[7] << 16);
                *(v4u*)(VT + ((size_t)(b * 2 + (dcol >> 6)) * 64 + (dcol & 63)) * T + t0 + tq) = w; }
        }
        __syncthreads();
    }
}

DI f32x16 mfma32(const bf16x8 a, const bf16x8 b, const f32x16 c) { return __builtin_amdgcn_mfma_f32_32x32x16_bf16(a, b, c, 0, 0, 0); }
DI bf16x8 packlo(const f32x16& x) { v4u p; p.x = pk2(x[0], x[1]); p.y = pk2(x[2], x[3]); p.z = pk2(x[4], x[5]); p.w = pk2(x[6], x[7]); return __builtin_bit_cast(bf16x8, p); }
DI bf16x8 packhi(const f32x16& x) { v4u p; p.x = pk2(x[8], x[9]); p.y = pk2(x[10], x[11]); p.z = pk2(x[12], x[13]); p.w = pk2(x[14], x[15]); return __builtin_bit_cast(bf16x8, p); }
DI f32x16 zero16() { f32x16 z;
#pragma unroll
    for (int i = 0; i < 16; ++i) z[i] = 0.f;
    return z; }
DI int crow(int reg, int hh) { return (reg & 3) + 8 * (reg >> 2) + 4 * hh; }
DI bf16x8 ldperm(const LAS bf16* rowp, int ks, int hh) {
    const v2u lo = *(const LAS v2u*)(rowp + 16 * ks + 4 * hh), hi = *(const LAS v2u*)(rowp + 16 * ks + 8 + 4 * hh);
    v4u w; w.x = lo.x; w.y = lo.y; w.z = hi.x; w.w = hi.y; return __builtin_bit_cast(bf16x8, w);
}
#define SCAN_DEP(cv, val) asm volatile("" : "+v"(cv) : "v"(val))
constexpr int TJS = 72, JSS = 40;
constexpr int CH_TJ = 0, CH_JS = 18432, CH_JSB = 20480, CH_GL = CH_JS + 2 * CH_JSB, CH_FLAG = CH_GL + 512, CHAIN_LDS = CH_FLAG + 128;
DI int ld_flag(volatile LAS int* p) { return *p; }
constexpr int CH_RAW = CH_FLAG + 128, RAW_SLOT = 5 * 1024 + 256, CH_YT = CH_RAW + 2 * RAW_SLOT, YT_RS = 144, CHAIN_LDS2 = CH_YT + 32 * YT_RS;
DI void scan_dma_block(const DArgs& a, LAS unsigned char* slotp, int blk, int dir, size_t rowbase, int h, unsigned lane_off, unsigned lane_off_kn) {
    unsigned char* ws = a.ws;
    const int p0 = blk * 8, tl = dir ? T - 1 - p0 - 7 : p0;
#pragma unroll
    for (int arr = 0; arr < 5; ++arr) {
        const unsigned char* base = arr < 3 ? (const unsigned char*)(ws + WS_RKV) + (size_t)arr * ((size_t)M * 512 * 2)
                                            : (const unsigned char*)a.out + (size_t)((arr == 3 ? 0 : 2) + dir) * OUT_AW;
        const unsigned char* ub = base + ((rowbase + tl) * 512 + h * 64) * 2;
        __builtin_amdgcn_global_load_lds((const unsigned*)(ub + lane_off), (LAS unsigned*)(slotp + arr * 1024), 16, 0, 0);
    }
    { const unsigned char* ub = (const unsigned char*)(ws + WS_KN) + ((rowbase + tl) * 8 + h) * 4;
      __builtin_amdgcn_global_load_lds((const unsigned*)(ub + lane_off_kn), (LAS unsigned*)(slotp + 5 * 1024), 4, 0, 0); }
}
DI void scan_producer(const DArgs& a, LAS unsigned char* cl, int chain, int lane) {
    const int dir = chain & 1, h = (chain >> 1) & 7, b = chain >> 4;
    const size_t rowbase = (size_t)b * T;
    LAS bf16* Qh = (LAS bf16*)(cl + CH_TJ); LAS bf16* Rh = Qh + 32 * TJS; LAS bf16* Bc = Rh + 32 * TJS; LAS bf16* Kc = Bc + 32 * TJS;
    volatile LAS int* flag = (volatile LAS int*)(cl + CH_FLAG);
    const int chn = h * 64 + lane;
    const float kkc = a.in[I_KK][chn], kac = a.in[I_KA][chn];
    const unsigned lane_off = (unsigned)((dir ? 7 - (lane >> 3) : (lane >> 3)) * 1024 + (lane & 7) * 16);
    const unsigned lane_off_kn = (unsigned)((dir ? 7 - (lane & 7) : (lane & 7)) * 32);
    asm volatile("s_waitcnt vmcnt(0)" ::: "memory");
    scan_dma_block(a, cl + CH_RAW, 0, dir, rowbase, h, lane_off, lane_off_kn);
    scan_dma_block(a, cl + CH_RAW + RAW_SLOT, 1, dir, rowbase, h, lane_off, lane_off_kn);
    for (int chunk = 0; chunk < T / 32; ++chunk) {
        const int buf = chunk & 1;
        LAS bf16* QhT = (LAS bf16*)(cl + CH_JS + buf * CH_JSB); LAS bf16* BcT = QhT + 64 * JSS; LAS bf16* KcT = BcT + 64 * JSS; LAS bf16* VT = KcT + 64 * JSS;
        LAS float* GL = (LAS float*)(cl + CH_GL + buf * 256);
        while (ld_flag(flag + 1) < chunk || ld_flag(flag + 2) < chunk - 1) __builtin_amdgcn_s_sleep(2);
        asm volatile("" ::: "memory");
        float g = 1.f;
#pragma unroll 1
        for (int tb = 0; tb < 4; ++tb) {
            const int blk = chunk * 4 + tb;
            LAS unsigned char* slotp = cl + CH_RAW + (tb & 1) * RAW_SLOT;
            const LAS f16* RAW = (const LAS f16*)slotp; const LAS float* KNL = (const LAS float*)(slotp + 5 * 1024);
            if (blk + 1 < T / 8) asm volatile("s_waitcnt vmcnt(6)" ::: "memory"); else asm volatile("s_waitcnt vmcnt(0)" ::: "memory");
            unsigned qw[4], bw[4], kw[4], vw[4];
            f16 rraw[8], kraw[8], vraw[8], araw[8], wraw[8]; float knv[8];
#pragma unroll
            for (int u = 0; u < 8; ++u) { rraw[u] = RAW[0 * 512 + u * 64 + lane]; kraw[u] = RAW[1 * 512 + u * 64 + lane]; vraw[u] = RAW[2 * 512 + u * 64 + lane]; araw[u] = RAW[3 * 512 + u * 64 + lane]; wraw[u] = RAW[4 * 512 + u * 64 + lane]; }
            { const f32x4 k0_ = *(const LAS f32x4*)KNL, k1_ = *(const LAS f32x4*)(KNL + 4);
#pragma unroll
              for (int u = 0; u < 4; ++u) { knv[u] = k0_[u]; knv[4 + u] = k1_[u]; } }
            LDS_WAIT(); asm volatile("" ::: "memory");
            if (blk + 2 < T / 8) { unsigned lo1 = lane_off, lo2 = lane_off_kn; asm volatile("" : "+v"(lo1), "+v"(lo2));
                scan_dma_block(a, slotp, blk + 2, dir, rowbase, h, lo1, lo2); }
#pragma unroll
            for (int u2 = 0; u2 < 4; ++u2) {
                float qv[2], rv[2], bv[2], kv[2], vv[2];
#pragma unroll
                for (int e = 0; e < 2; ++e) {
                    const int u = 2 * u2 + e;
                    const float r = (float)rraw[u], k = (float)kraw[u], v = (float)vraw[u];
                    const float av = (float)araw[u], w = (float)wraw[u];
                    const float invn = knv[u];
                    const float gprev = g; g *= w; const float ginv = __builtin_amdgcn_rcpf(g);
                    const float kk = k * kkc * invn, kt = k * (1.0f + (av - 1.0f) * kac), bb = av * kk;
                    qv[e] = kk * gprev; rv[e] = r * g; bv[e] = bb * ginv; kv[e] = kt * ginv; vv[e] = v;
                }
                const int tau = 8 * tb + 2 * u2;
                const unsigned q2 = pk2(qv[0], qv[1]), r2 = pk2(rv[0], rv[1]), b2 = pk2(bv[0], bv[1]), k2 = pk2(kv[0], kv[1]);
                Qh[tau * TJS + lane] = (bf16)(q2 & 0xffffu); Qh[(tau + 1) * TJS + lane] = (bf16)(q2 >> 16);
                Rh[tau * TJS + lane] = (bf16)(r2 & 0xffffu); Rh[(tau + 1) * TJS + lane] = (bf16)(r2 >> 16);
                Bc[tau * TJS + lane] = (bf16)(b2 & 0xffffu); Bc[(tau + 1) * TJS + lane] = (bf16)(b2 >> 16);
                Kc[tau * TJS + lane] = (bf16)(k2 & 0xffffu); Kc[(tau + 1) * TJS + lane] = (bf16)(k2 >> 16);
                qw[u2] = q2 ^ 0x80008000u; bw[u2] = b2; kw[u2] = k2; vw[u2] = pk2(vv[0], vv[1]);
            }
            *(LAS v4u*)(QhT + lane * JSS + 8 * tb) = (v4u){qw[0], qw[1], qw[2], qw[3]};
            *(LAS v4u*)(BcT + lane * JSS + 8 * tb) = (v4u){bw[0], bw[1], bw[2], bw[3]};
            *(LAS v4u*)(KcT + lane * JSS + 8 * tb) = (v4u){kw[0], kw[1], kw[2], kw[3]};
            *(LAS v4u*)(VT + lane * JSS + 8 * tb) = (v4u){vw[0], vw[1], vw[2], vw[3]};
        }
        GL[lane] = g;
        LDS_WAIT(); asm volatile("" ::: "memory");
        if (lane == 0) flag[0] = chunk + 1;
        asm volatile("" ::: "memory");
    }
}
template <int DIR> DI void scan_consumer(const DArgs& a, LAS unsigned char* cl, int chain, int lane) {
    unsigned char* ws = a.ws;
    const int h = (chain >> 1) & 7, b = chain >> 4;
    const int c = lane & 31, hh = lane >> 5;
    const size_t rowbase = (size_t)b * T;
    const LAS bf16* Qh = (const LAS bf16*)(cl + CH_TJ); const LAS bf16* Rh = Qh + 32 * TJS; const LAS bf16* Bc = Rh + 32 * TJS; const LAS bf16* Kc = Bc + 32 * TJS;
    volatile LAS int* flag = (volatile LAS int*)(cl + CH_FLAG);
    f16* Y = (f16*)(ws + (DIR ? WS_YB : WS_YF));
    bf16x8 xs[2][2][2];
#pragma unroll
    for (int q = 0; q < 8; ++q) xs[q >> 2][(q >> 1) & 1][q & 1] = (bf16x8){0, 0, 0, 0, 0, 0, 0, 0};
    f32x16 eye;
#pragma unroll
    for (int i = 0; i < 16; ++i) eye[i] = (crow(i, hh) == c) ? 1.f : 0.f;
    LAS unsigned char* YT = cl + CH_YT;
    LAS unsigned char* ytw = YT + c * YT_RS + 8 * hh;
    const LAS unsigned char* ytr = YT + (lane >> 3) * YT_RS + (lane & 7) * 16;
    f16* ybase = Y + (rowbase + (DIR ? T - 1 - (lane >> 3) : (lane >> 3))) * 512 + h * 64 + (lane & 7) * 8;
    for (int chunk = 0; chunk < T / 32; ++chunk) {
        const int buf = chunk & 1;
        const LAS bf16* QhT = (const LAS bf16*)(cl + CH_JS + buf * CH_JSB); const LAS bf16* BcT = QhT + 64 * JSS; const LAS bf16* KcT = BcT + 64 * JSS; const LAS bf16* VT = KcT + 64 * JSS;
        const LAS float* GL = (const LAS float*)(cl + CH_GL + buf * 256);
        while (ld_flag(flag) < chunk + 1) __builtin_amdgcn_s_sleep(1);
        asm volatile("" ::: "memory");
        f32x16 nN = zero16(), nT = zero16(), akT = zero16(), rbT = zero16(), rkT = zero16();
        v2u rhc[2][4];
        {
            bf16x8 fq[4], fb[4], fk[4], fr[4];
#pragma unroll
            for (int ks = 0; ks < 4; ++ks) {
                fq[ks] = *(const LAS bf16x8*)(Qh + c * TJS + 16 * ks + 8 * hh); fb[ks] = *(const LAS bf16x8*)(Bc + c * TJS + 16 * ks + 8 * hh);
                fk[ks] = *(const LAS bf16x8*)(Kc + c * TJS + 16 * ks + 8 * hh); fr[ks] = *(const LAS bf16x8*)(Rh + c * TJS + 16 * ks + 8 * hh);
            }
#pragma unroll
            for (int jb = 0; jb < 2; ++jb)
#pragma unroll
                for (int g4 = 0; g4 < 4; ++g4) rhc[jb][g4] = *(const LAS v2u*)(Rh + c * TJS + 32 * jb + 8 * g4 + 4 * hh);
            v4u yq[4];
            if (chunk > 0) {
#pragma unroll
                for (int j = 0; j < 4; ++j) yq[j] = *(const LAS v4u*)(ytr + 8 * j * YT_RS);
            }
            LDS_WAIT(); asm volatile("" ::: "memory");
            if (lane == 0) flag[1] = chunk + 1;
            asm volatile("" ::: "memory");
            if (chunk > 0) {
                f16* yp = ybase + (DIR ? -((chunk - 1) * 32 * 512) : (chunk - 1) * 32 * 512);
#pragma unroll
                for (int j = 0; j < 4; ++j) *(v4u*)(yp + (DIR ? -(8 * j * 512) : 8 * j * 512)) = yq[j];
            }
#pragma unroll
            for (int ks = 0; ks < 4; ++ks) {
                nN = mfma32(fq[ks], fb[ks], nN); nT = mfma32(fb[ks], fq[ks], nT); akT = mfma32(fk[ks], fq[ks], akT); rbT = mfma32(fb[ks], fr[ks], rbT); rkT = mfma32(fk[ks], fr[ks], rkT);
            }
        }
        __builtin_amdgcn_sched_barrier(0);
        f32x16 TT;
#pragma unroll
        for (int i = 0; i < 16; ++i) { const int rw = crow(i, hh);
            nN[i] = (c < rw) ? nN[i] : 0.f; nT[i] = (rw < c) ? nT[i] : 0.f; akT[i] = (rw < c) ? -akT[i] : 0.f;
            rbT[i] = (rw <= c) ? rbT[i] : 0.f; rkT[i] = (rw <= c) ? rkT[i] : 0.f; TT[i] = eye[i] - nT[i]; }
        bf16x8 pN0 = packlo(nN), pN1 = packhi(nN), pNT0 = packlo(nT), pNT1 = packhi(nT);
        const bf16x8 pAK0 = packlo(akT), pAK1 = packhi(akT), pRB0 = packlo(rbT), pRB1 = packhi(rbT), pRK0 = packlo(rkT), pRK1 = packhi(rkT);
        __builtin_amdgcn_sched_barrier(0);
#pragma unroll
        for (int lvl = 1; lvl <= 4; ++lvl) {
            f32x16 n2 = mfma32(pNT0, pN0, zero16()); n2 = mfma32(pNT1, pN1, n2);
            if (lvl < 4) { f32x16 n2T = mfma32(pN0, pNT0, zero16()); n2T = mfma32(pN1, pNT1, n2T); pNT0 = packlo(n2T); pNT1 = packhi(n2T); }
            pN0 = packlo(n2); pN1 = packhi(n2);
            const bf16x8 pT0 = packlo(TT), pT1 = packhi(TT);
            TT = mfma32(pN0, pT0, TT); TT = mfma32(pN1, pT1, TT);
            __builtin_amdgcn_sched_barrier(0);
        }
        const bf16x8 pTT0 = packlo(TT), pTT1 = packhi(TT);
        __builtin_amdgcn_sched_barrier(0);
        bf16x8 pQ[2][2];
        int cq = c; SCAN_DEP(cq, TT[15]);
        float depq = 0.f;
#pragma unroll
        for (int jt = 0; jt < 2; ++jt) {
            f32x16 acc = mfma32(pTT0, ldperm(QhT + (32 * jt + cq) * JSS, 0, hh), zero16());
            acc = mfma32(pTT1, ldperm(QhT + (32 * jt + cq) * JSS, 1, hh), acc);
            pQ[jt][0] = packlo(acc); pQ[jt][1] = packhi(acc); depq = acc[15];
        }
        __builtin_amdgcn_sched_barrier(0);
        bf16x8 vtp[2][2];
        int cv = c; SCAN_DEP(cv, depq);
#pragma unroll
        for (int it = 0; it < 2; ++it) { vtp[it][0] = ldperm(VT + (32 * it + cv) * JSS, 0, hh); vtp[it][1] = ldperm(VT + (32 * it + cv) * JSS, 1, hh); }
        bf16x8 pU[2][2]; float depu = 0.f;
#pragma unroll
        for (int it = 0; it < 2; ++it) {
            f32x16 w1 = mfma32(pAK0, vtp[it][0], zero16()); w1 = mfma32(pAK1, vtp[it][1], w1);
            const bf16x8 pw0 = packlo(w1), pw1 = packhi(w1);
            f32x16 u0 = mfma32(pTT0, pw0, zero16()); u0 = mfma32(pTT1, pw1, u0);
            pU[it][0] = packlo(u0); pU[it][1] = packhi(u0); depu = u0[15];
            __builtin_amdgcn_sched_barrier(0);
        }
        bf16x8 pR[2][2]; float depr = 0.f;
#pragma unroll
        for (int jb = 0; jb < 2; ++jb) {
            f32x16 rt;
#pragma unroll
            for (int g4 = 0; g4 < 4; ++g4) { const v2u rr = rhc[jb][g4]; rt[4 * g4] = bflo(rr.x); rt[4 * g4 + 1] = bfhi(rr.x); rt[4 * g4 + 2] = bflo(rr.y); rt[4 * g4 + 3] = bfhi(rr.y); }
            rt = mfma32(pQ[jb][0], pRB0, rt); rt = mfma32(pQ[jb][1], pRB1, rt);
            pR[jb][0] = packlo(rt); pR[jb][1] = packhi(rt); depr = rt[15];
            __builtin_amdgcn_sched_barrier(0);
        }
        bf16x8 pP[2][2][2]; float depp = 0.f;
        bf16x8 bcp[2][2];
        {
            int cp = c; SCAN_DEP(cp, depr);
#pragma unroll
            for (int jb = 0; jb < 2; ++jb) { bcp[jb][0] = ldperm(BcT + (32 * jb + cp) * JSS, 0, hh); bcp[jb][1] = ldperm(BcT + (32 * jb + cp) * JSS, 1, hh); }
#pragma unroll
            for (int jb = 0; jb < 2; ++jb)
#pragma unroll
                for (int jpb = 0; jpb < 2; ++jpb) {
                    f32x16 m = mfma32(pQ[jb][0], bcp[jpb][0], jb == jpb ? eye : zero16()); m = mfma32(pQ[jb][1], bcp[jpb][1], m);
                    pP[jb][jpb][0] = packlo(m); pP[jb][jpb][1] = packhi(m); depp = m[15];
                    __builtin_amdgcn_sched_barrier(0);
                }
        }
#pragma unroll
        for (int ib = 0; ib < 2; ++ib) {
            const bf16x8 x0l = xs[ib][0][0], x0h = xs[ib][0][1], x1l = xs[ib][1][0], x1h = xs[ib][1][1];
            {
                f32x16 y = mfma32(pU[ib][0], pRB0, zero16()); y = mfma32(pU[ib][1], pRB1, y);
                y = mfma32(vtp[ib][0], pRK0, y); y = mfma32(vtp[ib][1], pRK1, y);
                y = mfma32(x0l, pR[0][0], y); y = mfma32(x0h, pR[0][1], y);
                y = mfma32(x1l, pR[1][0], y); y = mfma32(x1h, pR[1][1], y);
#pragma unroll
                for (int g4 = 0; g4 < 4; ++g4) { const f16x4 hv = {(f16)y[4 * g4], (f16)y[4 * g4 + 1], (f16)y[4 * g4 + 2], (f16)y[4 * g4 + 3]}; *(LAS f16x4*)(ytw + 64 * ib + 16 * g4) = hv; }
                __builtin_amdgcn_sched_barrier(0);
            }
            f32x16 accn[2];
#pragma unroll
            for (int jpb = 0; jpb < 2; ++jpb) {
                int ch2 = c, hh2 = hh; SCAN_DEP(ch2, depp); SCAN_DEP(hh2, depp);
                f32x16 acc = mfma32(bcp[jpb][0], pU[ib][0], zero16()); acc = mfma32(bcp[jpb][1], pU[ib][1], acc);
                acc = mfma32(ldperm(KcT + (32 * jpb + ch2) * JSS, 0, hh2), vtp[ib][0], acc); acc = mfma32(ldperm(KcT + (32 * jpb + ch2) * JSS, 1, hh2), vtp[ib][1], acc);
                acc = mfma32(pP[0][jpb][0], x0l, acc); acc = mfma32(pP[0][jpb][1], x0h, acc);
                acc = mfma32(pP[1][jpb][0], x1l, acc); acc = mfma32(pP[1][jpb][1], x1h, acc);
#pragma unroll
                for (int g4 = 0; g4 < 4; ++g4) { const f32x4 gl = *(const LAS f32x4*)(GL + 32 * jpb + 8 * g4 + 4 * hh2);
                    acc[4 * g4] *= gl[0]; acc[4 * g4 + 1] *= gl[1]; acc[4 * g4 + 2] *= gl[2]; acc[4 * g4 + 3] *= gl[3]; }
                accn[jpb] = acc; depp = acc[15];
                __builtin_amdgcn_sched_barrier(0);
            }
            xs[ib][0][0] = packlo(accn[0]); xs[ib][0][1] = packhi(accn[0]); xs[ib][1][0] = packlo(accn[1]); xs[ib][1][1] = packhi(accn[1]);
        }
        LDS_WAIT(); asm volatile("" ::: "memory");
        if (lane == 0) flag[2] = chunk + 1;
        asm volatile("" ::: "memory");
    }
    {
        v4u yq[4];
#pragma unroll
        for (int j = 0; j < 4; ++j) yq[j] = *(const LAS v4u*)(ytr + 8 * j * YT_RS);
        LDS_WAIT();
        f16* yp = ybase + (DIR ? -((T / 32 - 1) * 32 * 512) : (T / 32 - 1) * 32 * 512);
#pragma unroll
        for (int j = 0; j < 4; ++j) *(v4u*)(yp + (DIR ? -(8 * j * 512) : 8 * j * 512)) = yq[j];
    }
}
DI void phaseScan(const DArgs& a, LAS unsigned char* lds, int G, int vcu, int wave, int lane) {
    const int slot = wave & 1;
    LAS unsigned char* cl = lds + slot * CHAIN_LDS2;
    for (int chain = vcu * 2 + slot; chain < NB * NH * 2; chain += G * 2) {
        if (wave < 2) { __builtin_amdgcn_s_setprio(3); if (chain & 1) scan_consumer<1>(a, cl, chain, lane); else scan_consumer<0>(a, cl, chain, lane); __builtin_amdgcn_s_setprio(0); }
        else { __builtin_amdgcn_s_setprio(2); scan_producer(a, cl, chain, lane); __builtin_amdgcn_s_setprio(0); }
    }
}

DI void phaseAttn(const DArgs& a, LAS int* qctr, int vcu, int lane) {
    unsigned char* ws = a.ws;
    bf16* QKV = (bf16*)(ws + WS_QKV); const bf16* VT = (const bf16*)(ws + WS_VT);
    const int r32 = lane & 31, hh = lane >> 5;
    for (;;) {
        int idx = 0;
        if (lane == 0) idx = __hip_atomic_fetch_add(qctr, 1, __ATOMIC_RELAXED, __HIP_MEMORY_SCOPE_WORKGROUP);
        idx = __builtin_amdgcn_readfirstlane(idx);
        if (idx >= 64) break;
        const int unit = vcu * 64 + idx;
        const int qt = unit & 63, hq = (unit >> 6) & 7, b = unit >> 9, kvh = hq >> 2, q0 = qt * 32;
        const float slope = exp2f(-(float)(hq + 1)), sink = a.in[I_SINK][hq];
        const size_t rowb = (size_t)b * T;
        bf16x8 qf[4];
        { const bf16* qp = QKV + (rowb + q0 + r32) * NQKV + hq * 64 + 8 * hh;
#pragma unroll
          for (int s = 0; s < 4; ++s) qf[s] = *(const bf16x8*)(qp + 16 * s); }
        float mrun = sink, lrun = 0.f;
        f32x16 o0, o1;
#pragma unroll
        for (int i = 0; i < 16; ++i) { o0[i] = 0.f; o1[i] = 0.f; }
        const int tq = q0 + r32;
        for (int kt = 0; kt < 9; ++kt) {
            const int k0 = q0 - 128 + 32 * kt;
            if (k0 < 0 || k0 >= T) continue;
            f32x16 st;
#pragma unroll
            for (int i = 0; i < 16; ++i) st[i] = 0.f;
            v2u vlo[2][2], vhi[2][2];
#pragma unroll
            for (int s = 0; s < 2; ++s)
#pragma unroll
                for (int db = 0; db < 2; ++db) { const bf16* vp = VT + ((size_t)(b * 2 + kvh) * 64 + 32 * db + r32) * T + k0 + 16 * s + 4 * hh; vlo[s][db] = *(const v2u*)vp; vhi[s][db] = *(const v2u*)(vp + 8); }
            asm volatile("" ::: "memory");
            { const bf16* kp = QKV + (rowb + k0 + r32) * NQKV + 512 + kvh * 64 + 8 * hh;
#pragma unroll
              for (int s = 0; s < 4; ++s) { const bf16x8 kf = *(const bf16x8*)(kp + 16 * s); st = __builtin_amdgcn_mfma_f32_32x32x16_bf16(kf, qf[s], st, 0, 0, 0); } }
            float tmax = -1e30f;
            if (kt == 0 || kt == 4 || kt == 8) {
#pragma unroll
                for (int i = 0; i < 16; ++i) { const int sk = k0 + crow(i, hh); int dd = sk - tq; dd = dd < 0 ? -dd : dd;
                    const float sc = (dd <= 128) ? st[i] - slope * (float)dd : -1e30f; st[i] = sc; tmax = fmaxf(tmax, sc); }
            } else {
                const float sg = kt < 4 ? slope : -slope;
                const float b0 = sg * (float)(k0 + 4 * hh - tq);
#pragma unroll
                for (int i = 0; i < 16; ++i) { const float sc = st[i] + fmaf(sg, (float)crow(i, 0), b0); st[i] = sc; tmax = fmaxf(tmax, sc); }
            }
            tmax = fmaxf(tmax, __shfl_xor(tmax, 32));
            const float mnew = fmaxf(mrun, tmax), alpha = __expf(mrun - mnew);
            mrun = mnew;
            float ps = 0.f;
#pragma unroll
            for (int i = 0; i < 16; ++i) { const float p = __expf(st[i] - mnew); st[i] = p; ps += p; }
            lrun = lrun * alpha + ps;
#pragma unroll
            for (int i = 0; i < 16; ++i) { o0[i] *= alpha; o1[i] *= alpha; }
#pragma unroll
            for (int s = 0; s < 2; ++s) {
                v4u pw; pw.x = pk2(st[8 * s], st[8 * s + 1]); pw.y = pk2(st[8 * s + 2], st[8 * s + 3]); pw.z = pk2(st[8 * s + 4], st[8 * s + 5]); pw.w = pk2(st[8 * s + 6], st[8 * s + 7]);
                const bf16x8 pf = __builtin_bit_cast(bf16x8, pw);
#pragma unroll
                for (int db = 0; db < 2; ++db) {
                    const v2u lo = vlo[s][db], hi = vhi[s][db];
                    v4u vw; vw.x = lo.x; vw.y = lo.y; vw.z = hi.x; vw.w = hi.y;
                    const bf16x8 vf = __builtin_bit_cast(bf16x8, vw);
                    if (db == 0) o0 = __builtin_amdgcn_mfma_f32_32x32x16_bf16(vf, pf, o0, 0, 0, 0);
                    else o1 = __builtin_amdgcn_mfma_f32_32x32x16_bf16(vf, pf, o1, 0, 0, 0);
                }
            }
        }
        const float ltot = lrun + __shfl_xor(lrun, 32);
        const float inv = 1.0f / (ltot + __expf(sink - mrun));
        bf16* op = QKV + (rowb + q0 + r32) * NQKV + hq * 64;
#pragma unroll
        for (int g4 = 0; g4 < 4; ++g4) {
            v2u w0, w1;
            w0.x = pk2(o0[4 * g4] * inv, o0[4 * g4 + 1] * inv); w0.y = pk2(o0[4 * g4 + 2] * inv, o0[4 * g4 + 3] * inv);
            w1.x = pk2(o1[4 * g4] * inv, o1[4 * g4 + 1] * inv); w1.y = pk2(o1[4 * g4 + 2] * inv, o1[4 * g4 + 3] * inv);
            *(v2u*)(op + 8 * g4 + 4 * hh) = w0;
            *(v2u*)(op + 32 + 8 * g4 + 4 * hh) = w1;
        }
    }
}

DI float red8(float v) { v += __shfl_xor(v, 1); v += __shfl_xor(v, 2); v += __shfl_xor(v, 4); return v; }
DI void phasePost(const DArgs& a, int own) {
    const int tid = threadIdx.x, lane = tid & 63, wave = __builtin_amdgcn_readfirstlane(tid >> 6);
    unsigned char* ws = a.ws;
    f16* YF = (f16*)(ws + WS_YF); const f16* YB = (const f16*)(ws + WS_YB);
    const f16* Rr = (const f16*)(ws + WS_RKV); const f16* Kr = Rr + (size_t)M * 512; const f16* Vr = Kr + (size_t)M * 512; const bf16* Gg = (const bf16*)(ws + WS_G);
    const f16* AF = (const f16*)a.out; const f16* AB = (const f16*)((const unsigned char*)a.out + OUT_AW);
    const int ch0 = lane * 8;
    float rkc[8], kac[8], lw[8], lb[8];
#pragma unroll
    for (int j = 0; j < 8; ++j) { rkc[j] = a.in[I_RK][ch0 + j]; kac[j] = a.in[I_KA][ch0 + j]; lw[j] = a.in[I_LNW][ch0 + j]; lb[j] = a.in[I_LNB][ch0 + j]; }
    for (int m = own * 256 + wave; m < own * 256 + 256; m += NWAVES) {
        const size_t o = (size_t)m * 512 + ch0;
        const f16x8 yf = *(const f16x8*)(YF + o), yb = *(const f16x8*)(YB + o), r8 = *(const f16x8*)(Rr + o), k8 = *(const f16x8*)(Kr + o), v8 = *(const f16x8*)(Vr + o);
        const f16x8 af = *(const f16x8*)(AF + o), ab = *(const f16x8*)(AB + o);
        const v4u gq = *(const v4u*)(Gg + o);
        float wkv[8], s1 = 0.f, bs = 0.f;
#pragma unroll
        for (int j = 0; j < 8; ++j) { wkv[j] = (float)yf[j] + (float)yb[j]; s1 += wkv[j];
            bs += (float)r8[j] * (float)k8[j] * rkc[j] * (2.0f + ((float)af[j] + (float)ab[j] - 2.0f) * kac[j]); }
        const float mean = red8(s1) * (1.f / 64.f);
        float s2 = 0.f;
#pragma unroll
        for (int j = 0; j < 8; ++j) { wkv[j] -= mean; s2 += wkv[j] * wkv[j]; }
        const float rstd = rsqrtf(red8(s2) * (1.f / 64.f) + LNX_EPS);
        const float bsum = red8(bs);
        const unsigned gw4[4] = {gq.x, gq.y, gq.z, gq.w};
        float y[8];
#pragma unroll
        for (int j = 0; j < 8; ++j) { const float gj = (j & 1) ? bfhi(gw4[j >> 1]) : bflo(gw4[j >> 1]); y[j] = (wkv[j] * rstd * lw[j] + lb[j] + bsum * (float)v8[j]) * gj; }
        v4u w; w.x = pk2(y[0], y[1]); w.y = pk2(y[2], y[3]); w.z = pk2(y[4], y[5]); w.w = pk2(y[6], y[7]);
        *(v4u*)((bf16*)YF + o) = w;
    }
}

DI void phaseRouter(const DArgs& a, LAS unsigned char* lds, int own) {
    const int tid = threadIdx.x, lane = tid & 63, wave = __builtin_amdgcn_readfirstlane(tid >> 6);
    unsigned char* ws = a.ws;
    LAS float* wf = (LAS float*)lds;
    __syncthreads();
    { const float* g = a.in[I_NFG]; const float* wr = a.in[I_WR];
      for (int idx = tid; idx < 256 * 64; idx += NTHREADS) { const int s_ = (idx >> 8) * 4 + (idx & 3), ln = (idx >> 2) & 63, cc = 32 * (s_ >> 3) + 8 * (ln >> 4) + (s_ & 7); wf[idx] = g[cc] * wr[cc * NE + (ln & 15)]; } }
    __syncthreads();
    const bf16* x1 = (const bf16*)(ws + WS_X1B); float* AFFT = (float*)(ws + WS_AFFT); float* RSTD = (float*)(ws + WS_RSTD);
    const int r = lane & 15, q = lane >> 4;
    v4u bufA[16], bufB[16];
    f32x4 acc; float ss;
#define RT_ROW(t) ((const v4u*)(x1 + (size_t)((own * 16 + wave + 8 * (t)) * 16 + r) * D) + q)
#define RT_LOAD(buf, t, h) do { const v4u* xp_ = RT_ROW(t); _Pragma("unroll") for (int i_ = 0; i_ < 16; ++i_) buf[i_] = xp_[4 * ((h) * 16 + i_)]; } while (0)
#define RT_COMP(buf, h) do { _Pragma("unroll") for (int i_ = 0; i_ < 16; ++i_) { const v4u xw_ = buf[i_]; \
        const float xv_[8] = {bflo(xw_.x), bfhi(xw_.x), bflo(xw_.y), bfhi(xw_.y), bflo(xw_.z), bfhi(xw_.z), bflo(xw_.w), bfhi(xw_.w)}; \
        ss += ((xv_[0] * xv_[0] + xv_[1] * xv_[1]) + (xv_[2] * xv_[2] + xv_[3] * xv_[3])) + ((xv_[4] * xv_[4] + xv_[5] * xv_[5]) + (xv_[6] * xv_[6] + xv_[7] * xv_[7])); \
        const int c8_ = (h) * 16 + i_; const f32x4 w0_ = *(const LAS f32x4*)(wf + ((c8_ * 2) * 64 + lane) * 4), w1_ = *(const LAS f32x4*)(wf + ((c8_ * 2 + 1) * 64 + lane) * 4); \
        _Pragma("unroll") for (int j_ = 0; j_ < 4; ++j_) acc = __builtin_amdgcn_mfma_f32_16x16x4f32(xv_[j_], w0_[j_], acc, 0, 0, 0); \
        _Pragma("unroll") for (int j_ = 0; j_ < 4; ++j_) acc = __builtin_amdgcn_mfma_f32_16x16x4f32(xv_[4 + j_], w1_[j_], acc, 0, 0, 0); } } while (0)
#define RT_FINISH(t) do { const int row0 = (own * 16 + wave + 8 * (t)) * 16; \
        ss += __shfl_xor(ss, 16); ss += __shfl_xor(ss, 32); \
        const float rstd = rsqrtf(ss * (1.f / D) + NORM_EPS);               \
        if (q == 0) RSTD[row0 + r] = rstd; \
        f32x4 p; \
        _Pragma("unroll") for (int i = 0; i < 4; ++i) { \
            const float lg = acc[i] * __shfl(rstd, 4 * q + i);               \
            float mx = lg; \
            mx = fmaxf(mx, __shfl_xor(mx, 1)); mx = fmaxf(mx, __shfl_xor(mx, 2)); mx = fmaxf(mx, __shfl_xor(mx, 4)); mx = fmaxf(mx, __shfl_xor(mx, 8)); \
            const float ex = expf(lg - mx); \
            float sm = ex; sm += __shfl_xor(sm, 1); sm += __shfl_xor(sm, 2); sm += __shfl_xor(sm, 4); sm += __shfl_xor(sm, 8); \
            p[i] = ex / sm; } \
        const int b = row0 / T, t0 = row0 % T; \
        *(f32x4*)(AFFT + ((size_t)b * NE + r) * T + t0 + 4 * q) = p; } while (0)
    RT_LOAD(bufA, 0, 0); RT_LOAD(bufB, 0, 1); EPI_MEMBAR;
    acc = (f32x4){0.f, 0.f, 0.f, 0.f}; ss = 0.f;
    RT_COMP(bufA, 0); EPI_MEMBAR; RT_LOAD(bufA, 1, 0); EPI_MEMBAR;
    RT_COMP(bufB, 1); EPI_MEMBAR; RT_LOAD(bufB, 1, 1); EPI_MEMBAR;
    RT_FINISH(0);
    acc = (f32x4){0.f, 0.f, 0.f, 0.f}; ss = 0.f;
    RT_COMP(bufA, 0); RT_COMP(bufB, 1);
    RT_FINISH(1);
#undef RT_ROW
#undef RT_LOAD
#undef RT_COMP
#undef RT_FINISH
    __syncthreads();
}

DI int block_sum8(LAS int* red, int v, int wave, int lane) {
    if (lane == 0) red[wave] = v;
    __syncthreads();
    int t = 0;
#pragma unroll
    for (int w = 0; w < 8; ++w) t += red[w];
    return t;
}
DI void phaseTopk(const DArgs& a, LAS unsigned char* lds, int pr) {
    const int tid = threadIdx.x, lane = tid & 63, wave = __builtin_amdgcn_readfirstlane(tid >> 6);
    unsigned char* ws = a.ws;
    const float* AFFT = (const float*)(ws + WS_AFFT); int* SEL = (int*)(ws + WS_SEL); float* VAL = (float*)(ws + WS_VAL);
    const float* RSTD = (const float*)(ws + WS_RSTD); const bf16* x1 = (const bf16*)(ws + WS_X1B); bf16* XG = (bf16*)(ws + WS_XG);
    LAS int* red = (LAS int*)lds;
    LAS int* lst = (LAS int*)(lds + 256);
    const unsigned long long lt_mask = (lane == 0) ? 0ull : (~0ull >> (64 - lane));
    const float* g = a.in[I_NFG];
    f32x4 gvv[4];
#pragma unroll
    for (int j = 0; j < 4; ++j) gvv[j] = *(const f32x4*)(g + 4 * lane + 256 * j);
    __syncthreads();
    {
        const int b = pr / NE, e = pr % NE;
        const f32x4 av = *(const f32x4*)(AFFT + (size_t)pr * T + 4 * tid);
        unsigned key[4];
#pragma unroll
        for (int j = 0; j < 4; ++j) { const float f = av[j]; key[j] = __float_as_uint(f); }
        unsigned K = 0u; int it = 0;
        for (int bit = 30; bit >= 0; --bit, ++it) {
            const unsigned cand = K | (1u << bit);
            int cw = 0;
#pragma unroll
            for (int j = 0; j < 4; ++j) cw += __builtin_popcountll(__ballot(key[j] >= cand));
            const int tot = block_sum8(red + 8 * (it & 1), cw, wave, lane);
            if (tot >= CAP) K = cand;
        }
        int cw = 0;
#pragma unroll
        for (int j = 0; j < 4; ++j) cw += __builtin_popcountll(__ballot(key[j] > K));
        const int ngt = block_sum8(red + 8 * (it & 1), cw, wave, lane); ++it;
        const int need = CAP - ngt;
        int tw = 0, tl = 0;
#pragma unroll
        for (int j = 0; j < 4; ++j) { const unsigned long long bt = __ballot(key[j] == K); tw += __builtin_popcountll(bt); tl += __builtin_popcountll(bt & lt_mask); }
        if (lane == 0) red[8 * (it & 1) + wave] = tw;
        __syncthreads();
        int tbase = tl;
#pragma unroll
        for (int w = 0; w < 8; ++w) tbase += (w < wave) ? red[8 * (it & 1) + w] : 0;
        ++it;
        bool sel[4]; int run = tbase;
#pragma unroll
        for (int j = 0; j < 4; ++j) { const bool tie = key[j] == K; sel[j] = key[j] > K || (tie && run < need); run += tie ? 1 : 0; }
        int sw = 0, sl = 0;
#pragma unroll
        for (int j = 0; j < 4; ++j) { const unsigned long long bs = __ballot(sel[j]); sw += __builtin_popcountll(bs); sl += __builtin_popcountll(bs & lt_mask); }
        if (lane == 0) red[8 * (it & 1) + wave] = sw;
        __syncthreads();
        int slot = sl;
#pragma unroll
        for (int w = 0; w < 8; ++w) slot += (w < wave) ? red[8 * (it & 1) + w] : 0;
        ++it;
        const size_t slot0 = (size_t)(e * NB + b) * CAP;
        int so[4];
#pragma unroll
        for (int j = 0; j < 4; ++j) { so[j] = sel[j] ? slot : -1; if (sel[j]) { lst[slot] = 4 * tid + j; VAL[slot0 + slot] = av[j]; ++slot; } }
#pragma unroll
        for (int j = 0; j < 4; ++j) SEL[((size_t)b * T + 4 * tid + j) * NE + e] = so[j];
        __syncthreads();
        for (int rr = wave * 8; rr < CAP; rr += NWAVES * 8) {
            v2u xv[8][4]; float rs[8];
#pragma unroll
            for (int q = 0; q < 8; ++q) { const size_t m = (size_t)b * T + lst[rr + q]; rs[q] = RSTD[m];
                const v2u* xr = (const v2u*)(x1 + m * D) + lane;
#pragma unroll
                for (int j = 0; j < 4; ++j) xv[q][j] = xr[64 * j]; }
#pragma unroll
            for (int q = 0; q < 8; ++q) { unsigned* o = (unsigned*)((unsigned char*)XG + (slot0 + rr + q) * D) + lane;
#pragma unroll
                for (int j = 0; j < 4; ++j) { const f32x4 xf = {bflo(xv[q][j].x), bfhi(xv[q][j].x), bflo(xv[q][j].y), bfhi(xv[q][j].y)}; const f32x4 hv = xf * rs[q] * gvv[j];
                    o[64 * j] = pk4_fp8(hv.x, hv.y, hv.z, hv.w); } }
        }
        __syncthreads();
    }
}

DI void final_accum(f32x4 (&v)[4], const bf16* YS, int myr, unsigned mask, int b, int lane) {
    while (mask) {
        const int e0 = __builtin_ctz(mask); mask &= mask - 1;
        const int has1 = mask != 0; const int e1 = has1 ? __builtin_ctz(mask) : e0; if (has1) mask &= mask - 1;
        const int r0 = __builtin_amdgcn_readlane(myr, e0), r1 = __builtin_amdgcn_readlane(myr, e1);
        const v2u* y0 = (const v2u*)(YS + ((size_t)(e0 * NB + b) * CAP + r0) * D) + lane;
        const v2u* y1 = (const v2u*)(YS + ((size_t)(e1 * NB + b) * CAP + r1) * D) + lane;
        v2u w0[4], w1[4];
#pragma unroll
        for (int j = 0; j < 4; ++j) { w0[j] = y0[64 * j]; w1[j] = y1[64 * j]; }
        const float s1 = has1 ? 1.f : 0.f;
#pragma unroll
        for (int j = 0; j < 4; ++j) {
            v[j].x += bflo(w0[j].x) + s1 * bflo(w1[j].x); v[j].y += bfhi(w0[j].x) + s1 * bfhi(w1[j].x);
            v[j].z += bflo(w0[j].y) + s1 * bflo(w1[j].y); v[j].w += bfhi(w0[j].y) + s1 * bfhi(w1[j].y); }
    }
}
DI void phaseFinal(const DArgs& a, int G, int vcu) {
    const int tid = threadIdx.x, lane = tid & 63, wave = __builtin_amdgcn_readfirstlane(tid >> 6);
    const int gw = vcu * NWAVES + wave, NGW = G * NWAVES;
    unsigned char* ws = a.ws;
    const int* SEL = (const int*)(ws + WS_SEL); const bf16* YS = (const bf16*)(ws + WS_YS);
    float* out = a.out; const float* g = a.in[I_NFINAL]; const bf16* X1B = (const bf16*)(ws + WS_X1B);
    f32x4 gv[4];
#pragma unroll
    for (int j = 0; j < 4; ++j) gv[j] = *(const f32x4*)(g + 4 * lane + 256 * j);
    for (int m0 = gw * 2; m0 < M; m0 += NGW * 2) {
        f32x4* xa = (f32x4*)(out + (size_t)m0 * D) + lane; f32x4* xb = xa + D / 4;
        const v2u* ia = (const v2u*)(X1B + (size_t)m0 * D) + lane; const v2u* ib = ia + D / 4;
        const int ra = SEL[(size_t)m0 * NE + (lane & 15)], rb = SEL[(size_t)(m0 + 1) * NE + (lane & 15)];
        f32x4 va[4], vb[4];
#pragma unroll
        for (int j = 0; j < 4; ++j) { const v2u wa = ia[64 * j], wb = ib[64 * j];
            va[j] = (f32x4){bflo(wa.x), bfhi(wa.x), bflo(wa.y), bfhi(wa.y)}; vb[j] = (f32x4){bflo(wb.x), bfhi(wb.x), bflo(wb.y), bfhi(wb.y)}; }
        const int b = m0 / T;
        const unsigned ma = (unsigned)(__ballot(ra >= 0) & 0xffffull), mb = (unsigned)(__ballot(rb >= 0) & 0xffffull);
        final_accum(va, YS, ra, ma, b, lane);
        final_accum(vb, YS, rb, mb, b, lane);
        float sa = 0.f, sb = 0.f;
#pragma unroll
        for (int j = 0; j < 4; ++j) { sa += (va[j].x * va[j].x + va[j].y * va[j].y) + (va[j].z * va[j].z + va[j].w * va[j].w); sb += (vb[j].x * vb[j].x + vb[j].y * vb[j].y) + (vb[j].z * vb[j].z + vb[j].w * vb[j].w); }
        const float rsa = rsqrtf(wave_sum(sa) * (1.f / D) + NORM_EPS), rsb = rsqrtf(wave_sum(sb) * (1.f / D) + NORM_EPS);
#pragma unroll
        for (int j = 0; j < 4; ++j) { xa[64 * j] = va[j] * rsa * gv[j]; xb[64 * j] = vb[j] * rsb * gv[j]; }
    }
}

typedef __attribute__((address_space(1))) unsigned gu32;
#define XB_TMO      128
#define XB_XCNT(j)  (256  + 64 * (j))
#define XB_XSUB(j)  (1280 + 64 * (j))
#define XB_XGEN(j)  (2304 + 64 * (j))
#define XB_TOP      3328
#define XB_TOPGEN   3392
#define XCD_BAR_WORDS 3456
#define XB_SPIN_CAP (1u << 18)

__device__ __forceinline__ unsigned xb_ld(unsigned* p)              { return __hip_atomic_load(p, __ATOMIC_RELAXED, __HIP_MEMORY_SCOPE_AGENT); }
__device__ __forceinline__ unsigned xb_add(unsigned* p, unsigned v) { return __hip_atomic_fetch_add(p, v, __ATOMIC_RELAXED, __HIP_MEMORY_SCOPE_AGENT); }
__device__ __forceinline__ unsigned xb_xcc_id() { return (unsigned)__builtin_amdgcn_s_getreg((3 << 11) | 20) & 0xFu; }
#define XB_SPIN(cond, bar) do { unsigned _sp = 0; while (cond) { __builtin_amdgcn_s_sleep(1); \
    if ((++_sp & 255u) == 0u) { if (xb_ld(&(bar)[XB_TMO])) break; if (_sp > XB_SPIN_CAP) { atomicAdd(&(bar)[XB_TMO], 1u); break; } } } } while (0)

struct XcdBarrier {
    unsigned* bar; unsigned x;
    volatile LAS unsigned* st;
};

__device__ __forceinline__ XcdBarrier xcd_barrier_post(unsigned* bar, volatile LAS unsigned* st) {
    XcdBarrier b; b.bar = bar; b.x = xb_xcc_id(); b.st = st;
    if (threadIdx.x == 0) (void)xb_add(&bar[XB_XCNT(b.x)], 1u);
    return b;
}
__device__ __forceinline__ void xcd_barrier_complete(unsigned* bar, unsigned x, unsigned& nloc, unsigned& nx) {
    const unsigned G = gridDim.x * gridDim.y * gridDim.z;
    unsigned sum, cnt, mine, sp = 0u;
    for (;;) {
        sum = 0u; cnt = 0u; mine = 0u;
#pragma unroll
        for (unsigned j = 0; j < 16; ++j) { const unsigned c = xb_ld(&bar[XB_XCNT(j)]); sum += c; cnt += (c > 0u) ? 1u : 0u; mine = (j == x) ? c : mine; }
        if (sum == G) break;
        __builtin_amdgcn_s_sleep(1);
        if ((++sp & 255u) == 0u) { if (xb_ld(&bar[XB_TMO])) break; if (sp > XB_SPIN_CAP) { atomicAdd(&bar[XB_TMO], 1u); break; } }
    }
    nloc = mine > 0u ? mine : 1u; nx = cnt > 0u ? cnt : 1u;
}

__device__ __forceinline__ void xcd_barrier(const XcdBarrier& b) {
    asm volatile("s_waitcnt vmcnt(0)" ::: "memory");
    __syncthreads();
    if (threadIdx.x == 0) {
        unsigned* bar = b.bar;
        __builtin_amdgcn_s_waitcnt(0);
        unsigned nloc = b.st[0], nx = b.st[1];
        if (nloc == 0u) { xcd_barrier_complete(bar, b.x, nloc, nx); b.st[0] = nloc; b.st[1] = nx; }
        const unsigned old = xb_add(&bar[XB_XSUB(b.x)], 1u);
        const unsigned gen = old / nloc;
        if (old + 1u == (gen + 1u) * nloc) {
            __builtin_amdgcn_fence(__ATOMIC_RELEASE, "agent");
            asm volatile("s_waitcnt vmcnt(0)" ::: "memory");
            const unsigned og = xb_add(&bar[XB_TOP], 1u);
            const unsigned tg = og / nx;
            if (og + 1u == (tg + 1u) * nx) xb_add(&bar[XB_TOPGEN], 1u);
            else XB_SPIN(xb_ld(&bar[XB_TOPGEN]) == tg, bar);
            __builtin_amdgcn_fence(__ATOMIC_ACQUIRE, "agent");
            xb_add(&bar[XB_XGEN(b.x)], 1u);
            asm volatile("s_waitcnt vmcnt(0)" ::: "memory");
        } else {
            XB_SPIN(xb_ld(&bar[XB_XGEN(b.x)]) == gen, bar);
            __builtin_amdgcn_fence(__ATOMIC_ACQUIRE, "agent");
            asm volatile("s_waitcnt vmcnt(0)" ::: "memory");
        }
    }
    __syncthreads();
}


constexpr int NPHASE = 13;
#ifndef MK_ONE_LAUNCH
#define MK_ONE_LAUNCH 1
#endif
__global__ void __launch_bounds__(NTHREADS, 2) fwd_kernel(Args args) {
    extern __shared__ __attribute__((aligned(16))) unsigned char lds_raw[];
    LAS unsigned char* lds = (LAS unsigned char*)lds_raw;
    const int G = gridDim.x, bx = blockIdx.x;
    const int vcu = (G % 8 == 0) ? (bx % 8) * (G / 8) + bx / 8 : bx;
    const int lo = args.ph_lo, hi = args.ph_hi;
    unsigned char* ws = args.ws;
    DArgs dargs; dargs.out = args.out; dargs.ws = args.ws;
#if MK_ONE_LAUNCH
    volatile LAS unsigned* MISC = (volatile LAS unsigned*)(lds + LDS_BYTES - 128);
    if (threadIdx.x < 32) MISC[threadIdx.x] = 0u;
    __syncthreads();
    const XcdBarrier xbar = xcd_barrier_post((unsigned*)(ws + WS_CTL) + 64, MISC);
#endif
#ifndef REPEAT_MASK
#define REPEAT_MASK 0
#endif
#define IN(k) (lo <= (k) && (k) < hi)
#define REPS(k) for (int rep_ = 0; rep_ < (((REPEAT_MASK >> (k)) & 1) ? 2 : 1); ++rep_)
#if MK_ONE_LAUNCH
#define SEAM(k) do { if (IN(k) && IN((k) + 1)) { if ((k) == 0) cg::this_grid().sync(); else xcd_barrier(xbar); } } while (0)
#else
#define SEAM(k) do { } while (0)
#endif
    if (IN(0)) REPS(0) { phase0(dargs, lds, G, vcu); }
    SEAM(0);
    if (IN(1)) REPS(1) {
        { pg8::Gemm g{(const bf16*)args.out, (const bf16*)(ws + WS_WIN), M, 2816, D, D, 1 << 30, 0, nullptr, 0, nullptr, 0, 1 << 30, 0, 0};
          pg8::StaticOrder S; S.init(M, 2816, G, bx);
          EpiA E{(bf16*)(ws + WS_UR), (bf16*)(ws + WS_QKV), (bf16*)(ws + WS_GATES)};
          pg8::gemm_phase<EpiA, pg8::StaticOrder, PG8_ALIGN, PG8_SP2>(lds, g, S, E); }
        { pg8::Gemm g{(const bf16*)((const unsigned char*)args.out + 128 * MiB), (const bf16*)(ws + WS_WG8), M, NGATE, D / 2, D / 2, 1 << 30, 0, nullptr, 0, nullptr, 0, 1 << 30, 0, 0};
          pg8::StaticOrder S; S.init(M, NGATE, G, bx);
          EpiGates E{(unsigned char*)(ws + WS_GATES)};
          pg8::gemm_phase<EpiGates, pg8::StaticOrder, PG8_ALIGN, PG8_SP2, false, false, true>(lds, g, S, E); }
    }
    SEAM(1);
#define BSEAM() do { asm volatile("s_waitcnt vmcnt(0)" ::: "memory"); __syncthreads(); } while (0)
    if (IN(2)) {
        { const int own = vcu;
            phaseP1(dargs, lds, own);
            BSEAM();
            int kl = 128; asm volatile("" : "+s"(kl));
            pg8::Gemm g{(const bf16*)(ws + WS_AP), (const bf16*)(ws + WS_WLORA), M, NLN, kl, NLK, 1 << 30, 0, nullptr, 0, nullptr, 0, 1 << 30, 0, 0};
            pg8::OwnRowLoraOrder S; S.pm0 = own; S.pm1 = own; S.npm = 1; S.nN = NLN / 256;
            EpiLoraZ E{(bf16*)(ws + WS_G), (f16*)args.out, (const float*)(ws + WS_LBIAS)};
            pg8::gemm_phase<EpiLoraZ, pg8::OwnRowLoraOrder, PG8_ALIGN, PG8_SP2>(lds, g, S, E);
        }
    }
    SEAM(3);
    if (IN(4)) {
        const int lane4 = threadIdx.x & 63, wave4 = __builtin_amdgcn_readfirstlane(threadIdx.x >> 6);
        if (threadIdx.x < 64) { ((LAS int*)(lds + CH_FLAG))[threadIdx.x & 31] = 0; ((LAS int*)(lds + CHAIN_LDS2 + CH_FLAG))[threadIdx.x & 31] = 0; }
        __syncthreads();
        LAS int* qctr = (LAS int*)(lds + CH_FLAG) + 16;
        if (wave4 < 4) phaseScan(dargs, lds, G, vcu, wave4, lane4);
        phaseAttn(dargs, qctr, vcu, lane4);
    }
    SEAM(4);
    if (IN(5)) { phasePost(dargs, vcu); }
    SEAM(5);
    if (IN(6)) REPS(6) {
        pg8::Gemm g{(const bf16*)(ws + WS_YF), (const bf16*)(ws + WS_WPR), M, D, D, 512, 1 << 30, 0, nullptr, 0, (const bf16*)(ws + WS_QKV), NQKV, 8, 0, 0};
        pg8::StaticOrder S; S.init(M, D, G, bx);
        EpiMerge2 E{(bf16*)(ws + WS_MERGED), (const unsigned char*)(ws + WS_GATES)};
        pg8::gemm_phase<EpiMerge2, pg8::StaticOrder, PG8_ALIGN, PG8_SP2, false, true>(lds, g, S, E);
    }
    SEAM(6);
    if (IN(7)) REPS(7) {
        pg8::Gemm g{(const bf16*)(ws + WS_MERGED), (const bf16*)(ws + WS_WOUT), M, D, D, D, 1 << 30, 0, nullptr, 0, nullptr, 0, 1 << 30, 0, 0};
        pg8::StaticOrder S; S.init(M, D, G, bx);
        EpiResid E{dargs.in[I_X], (bf16*)(ws + WS_X1B)};
        pg8::gemm_phase<EpiResid, pg8::StaticOrder, PG8_ALIGN, PG8_SP2>(lds, g, S, E);
    }
    SEAM(7);
    if (IN(8)) { phaseRouter(dargs, lds, vcu); }
    SEAM(8);
    if (IN(9)) { phaseTopk(dargs, lds, 2 * vcu); phaseTopk(dargs, lds, 2 * vcu + 1);   }
    SEAM(9);
    if (IN(10)) REPS(10) {
        pg8::Gemm g{(const bf16*)(ws + WS_XG), (const bf16*)(ws + WS_WGU), MS, 2048, D / 2, D / 2, NB, (size_t)2048 * D, nullptr, 0, nullptr, 0, 1 << 30, 0x7f7f7f7f, 0x7a7a7a7a};
        pg8::StaticOrder S; S.init(MS, 2048, G, bx);
        EpiSwiglu E{(unsigned char*)(ws + WS_HID)};
        pg8::gemm_phase<EpiSwiglu, pg8::StaticOrder, PG8_ALIGN, PG8_SP2, false, false, true>(lds, g, S, E);
    }
    SEAM(10);
    if (IN(11)) REPS(11) {
        pg8::Gemm g{(const bf16*)(ws + WS_HID), (const bf16*)(ws + WS_WD), MS, D, FF / 2, FF / 2, NB, (size_t)D * FF, nullptr, 0, nullptr, 0, 1 << 30, 0x7f7f7f7f, 0x7a7a7a7a};
        pg8::StaticOrder S; S.init(MS, D, G, bx);
        EpiYs E{(bf16*)(ws + WS_YS), (const float*)(ws + WS_VAL)};
        pg8::gemm_phase<EpiYs, pg8::StaticOrder, PG8_ALIGN, PG8_SP2, false, false, true>(lds, g, S, E);
    }
    SEAM(11);
    if (IN(12)) { phaseFinal(dargs, G, vcu); }
#undef IN
#undef SEAM
}

extern "C" void kernel_launch(void* const* d_in, const int* in_sizes, int n_in, void* d_out, int out_size, void* d_ws, size_t ws_size, hipStream_t stream) {
    static int grid = 0;
    if (grid == 0) {
        if (n_in != 29 || out_size != M * D || ws_size < WS_END) { fprintf(stderr, "kernel_launch: unexpected shapes (n_in %d out %d ws %zu)\n", n_in, out_size, ws_size); grid = -1; return; }
        int dev = 0, cus = 0, per_cu = 0;
        hipGetDevice(&dev);
        hipDeviceGetAttribute(&cus, hipDeviceAttributeMultiprocessorCount, dev);
        hipFuncSetAttribute((const void*)fwd_kernel, hipFuncAttributeMaxDynamicSharedMemorySize, LDS_BYTES);
        hipOccupancyMaxActiveBlocksPerMultiprocessor(&per_cu, (const void*)fwd_kernel, NTHREADS, LDS_BYTES);
        (void)hipGetLastError();
        if (per_cu < 1) { fprintf(stderr, "kernel_launch: occupancy query says %d blocks per CU\n", per_cu); per_cu = 1; }
        grid = cus;
        if (grid != M / 256) { fprintf(stderr, "kernel_launch: this build needs exactly %d workgroups (one per CU of a 256-CU device), got %d\n", M / 256, grid); grid = -1; return; }
    }
    if (grid < 0) return;
    Args a{};
    for (int i = 0; i < 29; ++i) a.in[i] = (const float*)d_in[i];
    a.out = (float*)d_out; a.ws = (unsigned char*)d_ws;
#if MK_ONE_LAUNCH
    if (hipMemsetAsync((char*)d_ws + WS_CTL, 0, 16384, stream) != hipSuccess) { fprintf(stderr, "kernel_launch: memset of the barrier words failed\n"); return; }
    a.ph_lo = 0; a.ph_hi = NPHASE;
    void* kargs[] = {&a};
    hipError_t e = hipLaunchCooperativeKernel((const void*)fwd_kernel, dim3(grid), dim3(NTHREADS), kargs, LDS_BYTES, stream);
    if (e != hipSuccess) fprintf(stderr, "cooperative launch failed: %s (grid %d)\n", hipGetErrorString(e), grid);
#else
    for (int p = 0; p < NPHASE; ++p) {
        a.ph_lo = p; a.ph_hi = p + 1;
        hipLaunchKernelGGL(fwd_kernel, dim3(grid), dim3(NTHREADS), LDS_BYTES, stream, a);
    }
#endif
}
```

```cpp
#include <hip/hip_runtime.h>
#include <hip/hip_cooperative_groups.h>
#include <cstdio>
#include <cstdint>
namespace cg = cooperative_groups;
namespace pg8 {
#define PG8_LAS __attribute__((address_space(3)))
typedef unsigned short bf16_t;
typedef short bf16x8 __attribute__((ext_vector_type(8)));
typedef float f32x4 __attribute__((ext_vector_type(4)));
typedef unsigned u32x4 __attribute__((ext_vector_type(4)));
typedef int i32x8 __attribute__((ext_vector_type(8)));
typedef int i32x4 __attribute__((ext_vector_type(4)));
constexpr int BM = 256, BK = 64, HALF = 128, HTB = HALF * BK * 2  , STAGE_BYTES = 8 * HTB, NXCD = 8, WGM = 8;

__host__ __device__ __forceinline__ int lds_byte(int r, int c) { const int st = (r >> 4) * 2 + (c >> 5), rr = r & 15, cc = c & 31, ob = rr * 64 + cc * 2; return st * 1024 + (ob ^ (((ob >> 9) & 1) << 5)); }
__host__ __device__ __forceinline__ void stage_rc(int b, int& R, int& C) { const int st = b / 1024, sb = b % 1024, swz = sb ^ (((sb >> 9) & 1) << 5); R = (st >> 1) * 16 + swz / 64; C = (st & 1) * 32 + (swz % 64) / 2; }
__host__ __device__ __forceinline__ int lds_byte_mx(int r, int c) { const int st = (r >> 4) * 2 + (c >> 5), rr = r & 15, cc = c & 31, ob = rr * 64 + cc * 2; return st * 1024 + (ob ^ (((ob >> 9) & 1) << 4)); }
__host__ __device__ __forceinline__ void stage_rc_mx(int b, int& R, int& C) { const int st = b / 1024, sb = b % 1024, swz = sb ^ (((sb >> 9) & 1) << 4); R = (st >> 1) * 16 + swz / 64; C = (st & 1) * 32 + (swz % 64) / 2; }
__host__ __device__ __forceinline__ int perm32(int rho) { const int n = rho >> 4, i = rho & 15; return 8 * (i >> 2) + 4 * n + (i & 3); }

struct Unit { int pm, pn; };
struct Gemm { const bf16_t* A; const bf16_t* Bt; int M, N, K, lda; int grp_tiles; size_t grp_stride; const PG8_LAS unsigned short* glist; int gather_T; const bf16_t* A2; int lda2, ksplit; int mx_scale_a, mx_scale_b; };

struct StaticOrder {
    int nM, nN, nwg, G, c;
    __host__ __device__ void init(int M, int N, int G_, int c_) { nM = M / BM; nN = N / BM; nwg = nM * nN; G = G_; c = c_; }
    __host__ __device__ bool next(int i, Unit& u) const {
        const long L = (long)i * G + c; if (L >= nwg) return false;
        int wgid = (int)L; { const int q = nwg / NXCD, r = nwg % NXCD, xcd = wgid % NXCD, off = wgid / NXCD; wgid = (xcd < r ? xcd * (q + 1) : r * (q + 1) + (xcd - r) * q) + off; }
        const int nig = WGM * nN, gid = wgid / nig, fm = gid * WGM, gsz = (nM - fm) < WGM ? (nM - fm) : WGM;
        u.pm = fm + ((wgid % nig) % gsz); u.pn = (wgid % nig) / gsz; return true;
    }
    __device__ __forceinline__ void a_ready(const Unit&) const {}
    __device__ __forceinline__ void done(const Unit&) const {}
    __device__ __forceinline__ size_t a_off(const Unit&) const { return 0; }
};
struct OwnRowOrder {
    int pm0, pm1, npm, nN;
    __device__ __forceinline__ bool next(int i, Unit& u) const { const int r = i / nN; if (r >= npm) return false; u.pm = r == 0 ? pm0 : pm1; u.pn = i - r * nN; return true; }
    __device__ __forceinline__ void a_ready(const Unit&) const {}
    __device__ __forceinline__ void done(const Unit&) const {}
    __device__ __forceinline__ size_t a_off(const Unit&) const { return 0; }
};
struct OwnRowLoraOrder : OwnRowOrder {
    __device__ __forceinline__ size_t a_off(const Unit& u) const { return u.pn < 2 ? 0 : (u.pn < 6 ? 256 : 512); }
};
struct LoraOrder : StaticOrder {
    __device__ __forceinline__ size_t a_off(const Unit& u) const { return u.pn < 2 ? 0 : (u.pn < 6 ? 256 : 512); }
};
template <class Epi, class Sched, bool ALIGN_EPI = false, bool SP2 = false, bool GA = false, bool SA2 = false, bool MX = false>
__device__ __forceinline__ void gemm_phase(PG8_LAS unsigned char* lds, const Gemm g, const Sched& S, const Epi& E) {
    const int tid = threadIdx.x, wid = __builtin_amdgcn_readfirstlane(tid >> 6), lane = tid & 63, wr = wid >> 2, wc = wid & 3, fr = lane & 15, fq = lane >> 4;
    const int K = g.K, nt = K / BK;
    unsigned voffA[2], voffB[2], voffA2[2];
#pragma unroll
    for (int i = 0; i < 2; ++i) { int R, C; if constexpr (MX) stage_rc_mx(tid * 16 + i * 8192, R, C); else stage_rc(tid * 16 + i * 8192, R, C); const int Rb = Epi::PERM ? ((R & ~31) + perm32(R & 31)) : R;
        voffA[i] = (unsigned)(R * g.lda + C) * 2u; voffB[i] = (unsigned)(Rb * K + C) * 2u; voffA2[i] = (unsigned)(R * g.lda2 + C) * 2u; }
    const size_t kstep = (size_t)(BK * 2);
    const size_t hstepA = (size_t)HALF * g.lda * 2, hstepB = (size_t)HALF * K * 2;
    const size_t tstepA = GA ? 0 : 2 * hstepA, tstepB = 2 * hstepB;
    const size_t hstepA2 = (size_t)HALF * g.lda2 * 2; const int ks = g.ksplit;
    const unsigned ldsw = (unsigned)wid * 1024u;
    const int aoff = lds_byte(wr * 64 + fr, fq * 8), boff = lds_byte(wc * 32 + fr, fq * 8);
    const int aoffx0 = lds_byte_mx(wr * 64 + fr, 16 * fq), aoffx1 = lds_byte_mx(wr * 64 + fr, 16 * fq + 8), boffx0 = lds_byte_mx(wc * 32 + fr, 16 * fq), boffx1 = lds_byte_mx(wc * 32 + fr, 16 * fq + 8);
#define PG8_SA(b, h) (((b) * 2 + (h)) * HTB)
#define PG8_SB(b, h) ((4 + (b) * 2 + (h)) * HTB)
#define PG8_STAGE(bufoff, gbase, voff) do { _Pragma("unroll") for (int _i = 0; _i < 2; ++_i) { unsigned vo1_ = (voff)[_i]; if constexpr (MX) asm volatile("" : "+v"(vo1_));     \
        __builtin_amdgcn_global_load_lds((const unsigned*)((const char*)(gbase) + vo1_), (PG8_LAS unsigned*)(lds + (bufoff) + ldsw + _i * 8192), 16, 0, 0); } } while (0)
#define PG8_STAGE_A(bufoff, base, half, usenext, side) do { if constexpr (GA) { unsigned vo_[2]; _Pragma("unroll") for (int q_ = 0; q_ < 2; ++q_) vo_[q_] = (usenext) ? nG[half][q_] : cG[half][q_]; PG8_STAGE(bufoff, base, vo_); } \
        else if constexpr (SA2) { if (side) { PG8_STAGE(bufoff, (base) + (half) * hstepA2, voffA2); } else { PG8_STAGE(bufoff, (base) + (half) * hstepA, voffA); } } \
        else { PG8_STAGE(bufoff, (base) + (half) * hstepA, voffA); } } while (0)
#define PG8_LDA(dst, b, h) do { if constexpr (MX) { _Pragma("unroll") for (int m = 0; m < 4; ++m) { const i32x4 lo_ = *(const PG8_LAS i32x4*)(lds + PG8_SA(b, h) + aoffx0 + m * 2048), hi_ = *(const PG8_LAS i32x4*)(lds + PG8_SA(b, h) + aoffx1 + m * 2048); \
            dst##X[m] = __builtin_shufflevector(lo_, hi_, 0, 1, 2, 3, 4, 5, 6, 7); } } \
        else { _Pragma("unroll") for (int m = 0; m < 4; ++m) _Pragma("unroll") for (int k = 0; k < 2; ++k) dst[m][k] = *(const PG8_LAS bf16x8*)(lds + PG8_SA(b, h) + aoff + m * 2048 + k * 1024); } } while (0)
#define PG8_LDB(dst, b, h) do { if constexpr (MX) { _Pragma("unroll") for (int n = 0; n < 2; ++n) { const i32x4 lo_ = *(const PG8_LAS i32x4*)(lds + PG8_SB(b, h) + boffx0 + n * 2048), hi_ = *(const PG8_LAS i32x4*)(lds + PG8_SB(b, h) + boffx1 + n * 2048); \
            dst##X[n] = __builtin_shufflevector(lo_, hi_, 0, 1, 2, 3, 4, 5, 6, 7); } } \
        else { _Pragma("unroll") for (int n = 0; n < 2; ++n) _Pragma("unroll") for (int k = 0; k < 2; ++k) dst[n][k] = *(const PG8_LAS bf16x8*)(lds + PG8_SB(b, h) + boff + n * 2048 + k * 1024); } } while (0)
#define PG8_MMA(ai, bj, At, Bt) do { __builtin_amdgcn_s_setprio(1); if constexpr (MX) { _Pragma("unroll") for (int m = 0; m < 4; ++m) _Pragma("unroll") for (int n = 0; n < 2; ++n) \
        asm volatile("v_mfma_scale_f32_16x16x128_f8f6f4 %0, %1, %2, %0, %3, %3 op_sel_hi:[0,0,0]" : "+v"(acc[ai][bj][m][n]) : "v"(Bt##X[n]), "v"(At##X[m]), "v"(mxs)); }     \
        else { _Pragma("unroll") for (int m = 0; m < 4; ++m) _Pragma("unroll") for (int n = 0; n < 2; ++n) _Pragma("unroll") for (int k = 0; k < 2; ++k) \
        acc[ai][bj][m][n] = __builtin_amdgcn_mfma_f32_16x16x32_bf16(Bt[n][k], At[m][k], acc[ai][bj][m][n], 0, 0, 0); } __builtin_amdgcn_s_setprio(0); } while (0)
#define PG8_WAIT_V(n) asm volatile("s_waitcnt vmcnt(" #n ")" ::: "memory")
#define PG8_WAIT_L(n) asm volatile("s_waitcnt lgkmcnt(" #n ")" ::: "memory")
#define PG8_BAR __builtin_amdgcn_s_barrier()
#define PG8_SCHED __builtin_amdgcn_sched_barrier(0)
    Unit cur, nxt; int ui = 0;
    if (!S.next(0, cur)) return;
    f32x4 acc[2][2][4][2];
#pragma unroll
    for (int a = 0; a < 2; ++a)
#pragma unroll
        for (int b = 0; b < 2; ++b)
#pragma unroll
            for (int m = 0; m < 4; ++m)
#pragma unroll
                for (int n = 0; n < 2; ++n) acc[a][b][m][n] = (f32x4){0.f, 0.f, 0.f, 0.f};
    bf16x8 At[4][2], B0[2][2], B1[2][2];
    i32x8 AtX[4], B0X[2], B1X[2];
    int mxs = 0x7f7f7f7f; asm volatile("" : "+v"(mxs));
    unsigned cG[2][2], nG[2][2]; int gR[2], gC[2];
    if constexpr (GA) {
#pragma unroll
        for (int i = 0; i < 2; ++i) { int R, C; stage_rc(tid * 16 + i * 8192, R, C); gR[i] = R; gC[i] = C; }
#pragma unroll
        for (int h = 0; h < 2; ++h)
#pragma unroll
            for (int i = 0; i < 2; ++i) { const int tok = g.glist[h * HALF + gR[i]]; cG[h][i] = (unsigned)(((cur.pm % g.grp_tiles) * g.gather_T + tok) * g.lda + gC[i]) * 2u; nG[h][i] = cG[h][i]; }
    }
    const char* cA = (const char*)g.A + (size_t)cur.pm * tstepA + S.a_off(cur); const char* cB = (const char*)g.Bt + (size_t)(cur.pm / g.grp_tiles) * g.grp_stride + (size_t)cur.pn * tstepB;
    const char* cA2 = (const char*)g.A2 + (size_t)cur.pm * 2 * hstepA2;
    S.a_ready(cur);
    if constexpr (SP2) {
        PG8_STAGE(PG8_SB(0, 0), cB, voffB); PG8_STAGE(PG8_SB(0, 1), cB + hstepB, voffB); PG8_STAGE_A(PG8_SA(0, 0), cA, 0, false, false); PG8_STAGE_A(PG8_SA(0, 1), cA, 1, false, false);
        if (wr == 1) PG8_BAR;
        PG8_WAIT_V(2); PG8_BAR;
        PG8_STAGE(PG8_SB(1, 0), cB + kstep, voffB); PG8_STAGE_A(PG8_SA(1, 0), cA + kstep, 0, false, false); PG8_STAGE(PG8_SB(1, 1), cB + hstepB + kstep, voffB);
        PG8_WAIT_V(6); PG8_BAR;
    } else {
        PG8_STAGE(PG8_SB(0, 0), cB, voffB); PG8_STAGE_A(PG8_SA(0, 0), cA, 0, false, false); PG8_STAGE(PG8_SB(0, 1), cB + hstepB, voffB); PG8_STAGE_A(PG8_SA(0, 1), cA, 1, false, false);
        if (wr == 1) PG8_BAR;
        PG8_WAIT_V(4); PG8_BAR;
        PG8_STAGE(PG8_SB(1, 0), cB + kstep, voffB); PG8_STAGE_A(PG8_SA(1, 0), cA + kstep, 0, false, false); PG8_STAGE(PG8_SB(1, 1), cB + hstepB + kstep, voffB);
        PG8_WAIT_V(6); PG8_BAR;
    }
    for (;;) {
        const bool has_next = S.next(ui + 1, nxt);
        if constexpr (GA) { if (has_next) {
#pragma unroll
            for (int h = 0; h < 2; ++h)
#pragma unroll
                for (int i = 0; i < 2; ++i) { const int tok = g.glist[(ui + 1) * 256 + h * HALF + gR[i]]; nG[h][i] = (unsigned)(((nxt.pm % g.grp_tiles) * g.gather_T + tok) * g.lda + gC[i]) * 2u; } } }
        const char* nA = has_next ? (const char*)g.A + (size_t)nxt.pm * tstepA + S.a_off(nxt) : cA; const char* nB = has_next ? (const char*)g.Bt + (size_t)(nxt.pm / g.grp_tiles) * g.grp_stride + (size_t)nxt.pn * tstepB : cB;
        for (int t = 0; t < nt; t += 2) {
            const bool last = (t == nt - 2); const bool usen = last && has_next;
            const bool s1 = SA2 && t >= ks, s2 = SA2 && !last && (t + 2 >= ks);
            const char* a1 = s1 ? cA2 + (size_t)(t + 1 - ks) * kstep : cA + (size_t)(t + 1) * kstep;
            const char* a2 = last ? nA : (s2 ? cA2 + (size_t)(t + 2 - ks) * kstep : cA + (size_t)(t + 2) * kstep); const char* b2 = last ? nB : cB + (size_t)(t + 2) * kstep;
            const char* a3 = a2 + kstep; const char* b3 = b2 + kstep;
            if (last && has_next) S.a_ready(nxt);
            if constexpr (SA2) { if (t == ks) E.mid(acc, cur, wr, wc, fr, fq); }
            if constexpr (SP2) {
            PG8_LDB(B0, 0, 0); PG8_LDB(B1, 0, 1); PG8_SCHED; PG8_LDA(At, 0, 0); PG8_STAGE_A(PG8_SA(1, 1), a1, 1, false, s1);
            PG8_WAIT_V(8); PG8_WAIT_L(0); PG8_BAR; PG8_MMA(0, 0, At, B0); PG8_MMA(0, 1, At, B1); PG8_BAR; PG8_SCHED;
            PG8_LDA(At, 0, 1); PG8_STAGE(PG8_SB(0, 0), b2, voffB); PG8_STAGE(PG8_SB(0, 1), b2 + hstepB, voffB); PG8_STAGE_A(PG8_SA(0, 0), a2, 0, usen, s2);
            PG8_WAIT_V(8); PG8_WAIT_L(0); PG8_BAR; PG8_MMA(1, 0, At, B0); PG8_MMA(1, 1, At, B1); PG8_BAR; PG8_SCHED;
            PG8_LDB(B0, 1, 0); PG8_LDB(B1, 1, 1); PG8_SCHED; PG8_LDA(At, 1, 0); PG8_STAGE_A(PG8_SA(0, 1), a2, 1, usen, s2);
            PG8_WAIT_V(8); PG8_WAIT_L(0); PG8_BAR; PG8_MMA(0, 0, At, B0); PG8_MMA(0, 1, At, B1); PG8_BAR; PG8_SCHED;
            PG8_LDA(At, 1, 1); PG8_STAGE(PG8_SB(1, 0), b3, voffB); PG8_STAGE(PG8_SB(1, 1), b3 + hstepB, voffB); PG8_STAGE_A(PG8_SA(1, 0), a3, 0, usen, s2);
            PG8_WAIT_V(8); PG8_WAIT_L(0); PG8_BAR; PG8_MMA(1, 0, At, B0); PG8_MMA(1, 1, At, B1); PG8_BAR; PG8_SCHED;
            } else {
            PG8_LDB(B0, 0, 0); PG8_SCHED; PG8_LDA(At, 0, 0); PG8_STAGE_A(PG8_SA(1, 1), a1, 1, false, s1);
            PG8_WAIT_L(8); PG8_BAR; PG8_WAIT_L(0); PG8_MMA(0, 0, At, B0); PG8_BAR; PG8_SCHED;
            PG8_LDB(B1, 0, 1); PG8_STAGE(PG8_SB(0, 0), b2, voffB);
            PG8_BAR; PG8_WAIT_L(0); PG8_MMA(0, 1, At, B1); PG8_BAR;
            PG8_LDA(At, 0, 1); PG8_STAGE_A(PG8_SA(0, 0), a2, 0, usen, s2);
            PG8_BAR; PG8_WAIT_L(0); PG8_MMA(1, 0, At, B0); PG8_BAR; PG8_SCHED;
            PG8_STAGE(PG8_SB(0, 1), b2 + hstepB, voffB);
            PG8_WAIT_V(6); PG8_BAR; PG8_MMA(1, 1, At, B1); PG8_BAR;
            PG8_LDB(B0, 1, 0); PG8_SCHED; PG8_LDA(At, 1, 0); PG8_STAGE_A(PG8_SA(0, 1), a2, 1, usen, s2);
            PG8_WAIT_L(8); PG8_BAR; PG8_WAIT_L(0); PG8_MMA(0, 0, At, B0); PG8_BAR; PG8_SCHED;
            PG8_LDB(B1, 1, 1); PG8_STAGE(PG8_SB(1, 0), b3, voffB);
            PG8_BAR; PG8_WAIT_L(0); PG8_MMA(0, 1, At, B1); PG8_BAR;
            PG8_LDA(At, 1, 1); PG8_STAGE_A(PG8_SA(1, 0), a3, 0, usen, s2);
            PG8_BAR; PG8_WAIT_L(0); PG8_MMA(1, 0, At, B0); PG8_BAR; PG8_SCHED;
            PG8_STAGE(PG8_SB(1, 1), b3 + hstepB, voffB);
            PG8_WAIT_V(6); PG8_BAR; PG8_MMA(1, 1, At, B1); PG8_BAR;
            }
        }
        if constexpr (ALIGN_EPI) { if (wr == 0) PG8_BAR; }
        if constexpr (MX) asm volatile("s_nop 15\n\ts_nop 15" ::: "memory");
#ifdef PG8_EPI_TWICE
        if constexpr (!Epi::AFTER_DRAIN) { E(acc, cur, wr, wc, fr, fq); asm volatile("" ::: "memory"); }
#endif
        if constexpr (!Epi::AFTER_DRAIN) { E(acc, cur, wr, wc, fr, fq); S.done(cur); }
        if (!has_next) break;
#pragma unroll
        for (int a = 0; a < 2; ++a)
#pragma unroll
            for (int b = 0; b < 2; ++b)
#pragma unroll
                for (int m = 0; m < 4; ++m)
#pragma unroll
                    for (int n = 0; n < 2; ++n) acc[a][b][m][n] = (f32x4){0.f, 0.f, 0.f, 0.f};
        cur = nxt; cA = nA; cB = nB; ++ui; cA2 = (const char*)g.A2 + (size_t)cur.pm * 2 * hstepA2;
        if constexpr (GA) { _Pragma("unroll") for (int h = 0; h < 2; ++h) _Pragma("unroll") for (int i = 0; i < 2; ++i) cG[h][i] = nG[h][i]; }
        if constexpr (ALIGN_EPI) { if (wr == 1) PG8_BAR; }
    }
    PG8_WAIT_V(0);
    if constexpr (!ALIGN_EPI) { if (wr == 0) PG8_BAR; }
    PG8_BAR;
    if constexpr (Epi::AFTER_DRAIN) { E.fused(acc, cur, wr, wc, fr, fq, lds, wid, lane); S.done(cur); }
#undef PG8_SA
#undef PG8_SB
#undef PG8_STAGE
#undef PG8_LDA
#undef PG8_LDB
#undef PG8_MMA
#undef PG8_WAIT_V
#undef PG8_WAIT_L
#undef PG8_BAR
#undef PG8_SCHED
}
}

#ifndef PG8_SP2
#define PG8_SP2 true
#endif
#ifndef PG8_ALIGN
#define PG8_ALIGN true
#endif

#define DI __device__ __forceinline__
#define LAS __attribute__((address_space(3)))
typedef unsigned short bf16;
typedef _Float16 f16;
typedef unsigned v4u __attribute__((ext_vector_type(4)));
typedef unsigned v2u __attribute__((ext_vector_type(2)));
typedef float f32x4 __attribute__((ext_vector_type(4)));
typedef float f32x2 __attribute__((ext_vector_type(2)));
typedef float f32x16 __attribute__((ext_vector_type(16)));
typedef short bf16x8 __attribute__((ext_vector_type(8)));
typedef _Float16 f16x8 __attribute__((ext_vector_type(8)));
typedef _Float16 f16x4 __attribute__((ext_vector_type(4)));
typedef __bf16 bf16x2_t __attribute__((ext_vector_type(2)));

constexpr int NB = 32, T = 2048, D = 1024, M = NB * T;
constexpr int RC = 1920, NQKV = 768, NGATE = 2048, NIN = 4736, NINP = 4864;
constexpr int RD = 512, NH = 8, HS = 64;
constexpr int NLK = 384, NLN = 2560;
constexpr int NE = 16, CAP = 256, FF = 1024, MS = NB * NE * CAP;
constexpr float DECAY_SCALE = 0.60653065971263342f;
constexpr float LNX_EPS = 64e-5f, NORM_EPS = 1e-6f;
constexpr int NWAVES = 8, NTHREADS = 512;

constexpr size_t MiB = 1u << 20;
constexpr size_t WS_CTL = 0;
constexpr size_t WS_KN = 1 * MiB;
constexpr size_t WS_AFFT = 5 * MiB;
constexpr size_t WS_SEL = 9 * MiB;
constexpr size_t WS_VAL = 13 * MiB;
constexpr size_t WS_RSTD = 13 * MiB + 768 * 1024;
constexpr size_t WS_LBIAS = 13 * MiB + 512 * 1024;
constexpr size_t WS_VT = 14 * MiB;
constexpr size_t WS_WIN = 30 * MiB;
constexpr size_t WS_WG8 = 36 * MiB;
constexpr size_t WS_WPR = 40 * MiB;
constexpr size_t WS_WPA = 41 * MiB;
constexpr size_t WS_WOUT = 42 * MiB;
constexpr size_t WS_WLORA = 44 * MiB;
constexpr size_t WS_WGU = 46 * MiB;
constexpr size_t WS_WD = 110 * MiB;
constexpr size_t WS_UR = 142 * MiB;
constexpr size_t WS_G = 606 * MiB;
constexpr size_t WS_YF = 206 * MiB;
constexpr size_t WS_YB = 270 * MiB;
constexpr size_t WS_HID = 142 * MiB;
constexpr size_t WS_QKV = 382 * MiB;
constexpr size_t WS_GATES = 478 * MiB;
constexpr size_t WS_XG = 606 * MiB;
constexpr size_t WS_YS = 478 * MiB;
constexpr size_t WS_RKV = 734 * MiB;
constexpr size_t WS_AP = 926 * MiB;
constexpr size_t WS_MERGED = 734 * MiB;
constexpr size_t WS_X1B = 862 * MiB;
constexpr size_t WS_END = 1024 * MiB;
constexpr size_t OUT_AW = 64 * MiB;

constexpr int LDS_BYTES = 151552;

#define LDS_WAIT() asm volatile("s_waitcnt lgkmcnt(0)" ::: "memory")
DI unsigned f2bf(float f) { unsigned u = __builtin_bit_cast(unsigned, f); return (u + 0x7fffu + ((u >> 16) & 1u)) >> 16; }
DI unsigned pk2(float lo, float hi) { f32x2 v = {lo, hi}; bf16x2_t b = __builtin_convertvector(v, bf16x2_t); return __builtin_bit_cast(unsigned, b); }
DI float bflo(unsigned w) { return __builtin_bit_cast(float, w << 16); }
DI float bfhi(unsigned w) { return __builtin_bit_cast(float, w & 0xffff0000u); }
DI float bf2f(bf16 b) { return __builtin_bit_cast(float, (unsigned)b << 16); }
DI float sigmoidf_(float x) { return __builtin_amdgcn_rcpf(1.0f + __expf(-x)); }
DI float wave_sum(float v) {
#pragma unroll
    for (int o = 1; o < 64; o <<= 1) v += __shfl_xor(v, o);
    return v;
}
DI float wave_max(float v) {
#pragma unroll
    for (int o = 1; o < 64; o <<= 1) v = fmaxf(v, __shfl_xor(v, o));
    return v;
}

struct Args { const float* in[29]; float* out; unsigned char* ws; int ph_lo, ph_hi; };
struct KIn { DI const float* operator[](int i) const { return ((const float* const*)__builtin_amdgcn_kernarg_segment_ptr())[i]; } };
struct DArgs { KIn in; float* out; unsigned char* ws; };

enum { I_X = 0, I_NMG, I_WIN, I_MUP, I_MUN, I_W0F, I_WUPF, I_W0B, I_WUPB, I_A0F, I_AUPF, I_A0B, I_AUPB, I_GUP, I_KK, I_KA, I_RK, I_LNW, I_LNB, I_SINK,
       I_WPR, I_WPA, I_WOUT, I_NFG, I_WR, I_EG, I_EU, I_ED, I_NFINAL };

DI void transpose_item(const float* __restrict__ W, int ldw, int k0, int n0, bf16* WT, size_t drow0, int ldt, int dk0, LAS float* scr, int lane) {
    f32x4 t[8];
#pragma unroll
    for (int i = 0; i < 8; ++i) t[i] = *(const f32x4*)(W + (size_t)(k0 + 8 * i + (lane >> 3)) * ldw + n0 + 4 * (lane & 7));
#pragma unroll
    for (int i = 0; i < 8; ++i) { LAS float* d = scr + (8 * i + (lane >> 3)) * 33 + 4 * (lane & 7); d[0] = t[i][0]; d[1] = t[i][1]; d[2] = t[i][2]; d[3] = t[i][3]; }
    LDS_WAIT(); asm volatile("" ::: "memory");
    const int c = lane & 7;
#pragma unroll
    for (int j = 0; j < 4; ++j) { const int n = (lane >> 3) + 8 * j; const LAS float* s = scr + (8 * c) * 33 + n;
        v4u o; o.x = pk2(s[0 * 33], s[1 * 33]); o.y = pk2(s[2 * 33], s[3 * 33]); o.z = pk2(s[4 * 33], s[5 * 33]); o.w = pk2(s[6 * 33], s[7 * 33]);
        *(v4u*)(WT + (drow0 + n) * (size_t)ldt + dk0 + 8 * c) = o; }
    LDS_WAIT(); asm volatile("" ::: "memory");
}

DI unsigned pk4_fp8(float a, float b, float c, float d) { unsigned w = 0; w = __builtin_amdgcn_cvt_pk_fp8_f32(a, b, w, false); w = __builtin_amdgcn_cvt_pk_fp8_f32(c, d, w, true); return w; }
DI void transpose_item_f8(const float* __restrict__ W, int ldw, int k0, int n0, unsigned char* WT, size_t drow0, int ldt, int dk0, LAS float* scr, int lane, float scale) {
    f32x4 t[8];
#pragma unroll
    for (int i = 0; i < 8; ++i) t[i] = *(const f32x4*)(W + (size_t)(k0 + 8 * i + (lane >> 3)) * ldw + n0 + 4 * (lane & 7));
#pragma unroll
    for (int i = 0; i < 8; ++i) { LAS float* d = scr + (8 * i + (lane >> 3)) * 33 + 4 * (lane & 7); d[0] = t[i][0] * scale; d[1] = t[i][1] * scale; d[2] = t[i][2] * scale; d[3] = t[i][3] * scale; }
    LDS_WAIT(); asm volatile("" ::: "memory");
    const int c = lane & 7;
#pragma unroll
    for (int j = 0; j < 4; ++j) { const int n = (lane >> 3) + 8 * j; const LAS float* s = scr + (8 * c) * 33 + n;
        v2u o; o.x = pk4_fp8(s[0 * 33], s[1 * 33], s[2 * 33], s[3 * 33]); o.y = pk4_fp8(s[4 * 33], s[5 * 33], s[6 * 33], s[7 * 33]);
        *(v2u*)(WT + (drow0 + n) * (size_t)ldt + dk0 + 8 * c) = o; }
    LDS_WAIT(); asm volatile("" ::: "memory");
}

DI void phase0(const DArgs& a, LAS unsigned char* lds, int G, int vcu) {
    const int tid = threadIdx.x, lane = tid & 63, wave = __builtin_amdgcn_readfirstlane(tid >> 6);
    LAS float* scr = (LAS float*)(lds + wave * 16384);
    const int gw = vcu * NWAVES + wave, NGW = G * NWAVES;
    unsigned char* ws = a.ws;
    constexpr int J1 = 16 * 148, J2 = 8 * 32, J3 = J2, J4 = 16 * 32, JE = 16 * 32, J5 = NE * JE;
    constexpr int NITEMS = J1 + J2 + J3 + J4 + 3 * J5;
    for (int it = gw; it < NITEMS; it += NGW) {
        int r = it;
        if (r < J1) { const int kb = r / 148, nb = r % 148;
            if (nb < 84) transpose_item(a.in[I_WIN], NIN, 64 * kb, 32 * nb, (bf16*)(ws + WS_WIN), 32 * nb, D, 64 * kb, scr, lane);
            else transpose_item_f8(a.in[I_WIN], NIN, 64 * kb, 32 * nb, (unsigned char*)(ws + WS_WG8), 32 * nb - 2688, D, 64 * kb, scr, lane, 32.0f);
            continue; } r -= J1;
        if (r < J2) { const int kb = r / 32, nb = r % 32; transpose_item(a.in[I_WPR], D, 64 * kb, 32 * nb, (bf16*)(ws + WS_WPR), 32 * nb, D, 64 * kb, scr, lane); continue; } r -= J2;
        if (r < J3) { const int kb = r / 32, nb = r % 32; transpose_item(a.in[I_WPA], D, 64 * kb, 32 * nb, (bf16*)(ws + WS_WPR), 32 * nb, D, 512 + 64 * kb, scr, lane); continue; } r -= J3;
        if (r < J4) { const int kb = r / 32, nb = r % 32; transpose_item(a.in[I_WOUT], D, 64 * kb, 32 * nb, (bf16*)(ws + WS_WOUT), 32 * nb, D, 64 * kb, scr, lane); continue; } r -= J4;
        if (r < J5) { const int e = r / JE, q = r % JE, kb = q / 32, nb = q % 32, n0 = 32 * nb;
            transpose_item_f8(a.in[I_EG] + (size_t)e * D * FF, FF, 64 * kb, n0, (unsigned char*)(ws + WS_WGU) + (size_t)e * 2048 * D, (n0 / 128) * 256 + (n0 % 128), D, 64 * kb, scr, lane, 32.0f); continue; } r -= J5;
        if (r < J5) { const int e = r / JE, q = r % JE, kb = q / 32, nb = q % 32, n0 = 32 * nb;
            transpose_item_f8(a.in[I_EU] + (size_t)e * D * FF, FF, 64 * kb, n0, (unsigned char*)(ws + WS_WGU) + (size_t)e * 2048 * D, (n0 / 128) * 256 + 128 + (n0 % 128), D, 64 * kb, scr, lane, 32.0f); continue; } r -= J5;
        { const int e = r / JE, q = r % JE, kb = q / 32, nb = q % 32;
            transpose_item_f8(a.in[I_ED] + (size_t)e * FF * D, D, 64 * kb, 32 * nb, (unsigned char*)(ws + WS_WD) + (size_t)e * D * FF, 32 * nb, FF, 64 * kb, scr, lane, 32.0f); }
    }
    {
        bf16* WL = (bf16*)(ws + WS_WLORA);
        const int gt = vcu * NTHREADS + tid, NGT = G * NTHREADS;
        for (int idx = gt; idx < 2560 * 16; idx += NGT) {
            const int n = idx >> 4, k = (idx & 15) * 8;
            const float* src = nullptr; int nn = n, koff = 0, klen = 128;
            if (n < 512) { src = a.in[I_GUP]; }
            else if (n < 1024) { src = a.in[I_WUPF]; nn = n - 512; klen = 64; }
            else if (n < 1536) { src = a.in[I_WUPB]; nn = n - 1024; koff = 64; klen = 64; }
            else if (n < 2048) { src = a.in[I_AUPF]; nn = n - 1536; klen = 64; }
            else { src = a.in[I_AUPB]; nn = n - 2048; koff = 64; klen = 64; }
            float v[8];
#pragma unroll
            for (int j = 0; j < 8; ++j) { const int kk = k + j - koff; v[j] = (kk >= 0 && kk < klen) ? src[(size_t)kk * 512 + nn] : 0.f; }
            v4u o; o.x = pk2(v[0], v[1]); o.y = pk2(v[2], v[3]); o.z = pk2(v[4], v[5]); o.w = pk2(v[6], v[7]);
            *(v4u*)(WL + (size_t)n * 128 + k) = o;
        }
    }
    if (vcu == 0) {
        float* LB = (float*)(ws + WS_LBIAS);
        LB[tid] = a.in[I_W0F][tid]; LB[512 + tid] = a.in[I_W0B][tid]; LB[1024 + tid] = a.in[I_A0F][tid]; LB[1536 + tid] = a.in[I_A0B][tid];
    }
    {
        bf16* H = (bf16*)a.out; unsigned char* H8 = (unsigned char*)a.out + 128 * MiB; const float* x = a.in[I_X]; const float* g = a.in[I_NMG];
        f32x4 gv[4];
#pragma unroll
        for (int j = 0; j < 4; ++j) gv[j] = *(const f32x4*)(g + 4 * lane + 256 * j);
        for (int m = gw * 2; m < M; m += NGW * 2) {
            const f32x4* xr = (const f32x4*)(x + (size_t)m * D) + lane;
            f32x4 v[4], u[4]; float s = 0.f, s2 = 0.f;
#pragma unroll
            for (int j = 0; j < 4; ++j) { v[j] = xr[64 * j]; u[j] = xr[64 * j + D / 4]; }
#pragma unroll
            for (int j = 0; j < 4; ++j) { s += (v[j].x * v[j].x + v[j].y * v[j].y) + (v[j].z * v[j].z + v[j].w * v[j].w); s2 += (u[j].x * u[j].x + u[j].y * u[j].y) + (u[j].z * u[j].z + u[j].w * u[j].w); }
            const float rstd = rsqrtf(wave_sum(s) * (1.f / D) + NORM_EPS), rstd2 = rsqrtf(wave_sum(s2) * (1.f / D) + NORM_EPS);
            v2u* o = (v2u*)(H + (size_t)m * D) + lane; unsigned* o8 = (unsigned*)(H8 + (size_t)m * D) + lane;
#pragma unroll
            for (int j = 0; j < 4; ++j) { const f32x4 h1 = v[j] * rstd * gv[j], h2 = u[j] * rstd2 * gv[j];
                v2u w; w.x = pk2(h1.x, h1.y); w.y = pk2(h1.z, h1.w); o[64 * j] = w; o8[64 * j] = pk4_fp8(h1.x, h1.y, h1.z, h1.w);
                v2u w2; w2.x = pk2(h2.x, h2.y); w2.y = pk2(h2.z, h2.w); o[64 * j + D / 4] = w2; o8[64 * j + D / 4] = pk4_fp8(h2.x, h2.y, h2.z, h2.w); }
        }
    }
}

using pg8::Unit;
struct EpiA {
    static constexpr bool PERM = true, AFTER_DRAIN = false;
    bf16* UR; bf16* QKV; bf16* GATES;
    DI void operator()(const f32x4 (&acc)[2][2][4][2], const Unit& u, int wr, int wc, int fr, int fq) const {
        const int row0 = u.pm * 256 + wr * 64 + fr;
#pragma unroll
        for (int bj = 0; bj < 2; ++bj) {
            const int cb = u.pn * 2 + bj;
            if (cb >= 21) continue;
            bf16* base; int ld, colb, mode;
            if (cb < 15) { base = UR; ld = RC; colb = cb * 128; mode = 0; }
            else if (cb < 21) { base = QKV; ld = NQKV; colb = (cb - 15) * 128; mode = (cb < 19) ? 1 : 0; }
            else { base = GATES; ld = NGATE; colb = (cb - 21) * 128; mode = 2; }
            const int col = colb + wc * 32 + 8 * fq;
#pragma unroll
            for (int ai = 0; ai < 2; ++ai)
#pragma unroll
                for (int m = 0; m < 4; ++m) {
                    f32x4 v0 = acc[ai][bj][m][0], v1 = acc[ai][bj][m][1];
                    if (mode == 1) { v0 = v0 * (0.125f * 1.4426950408889634f); v1 = v1 * (0.125f * 1.4426950408889634f); }
                    else if (mode == 2) {
#pragma unroll
                        for (int i = 0; i < 4; ++i) { v0[i] = sigmoidf_(v0[i]); v1[i] = sigmoidf_(v1[i]); }
                    }
                    if (mode == 2) {
                        unsigned q[8];
#pragma unroll
                        for (int i = 0; i < 4; ++i) { q[i] = (unsigned)(v0[i] * 255.0f + 0.5f); q[4 + i] = (unsigned)(v1[i] * 255.0f + 0.5f); }
                        v2u w; w.x = q[0] | (q[1] << 8) | (q[2] << 16) | (q[3] << 24); w.y = q[4] | (q[5] << 8) | (q[6] << 16) | (q[7] << 24);
                        *(v2u*)((unsigned char*)GATES + (size_t)(row0 + ai * 128 + m * 16) * NGATE + col) = w;
                    } else {
                        v4u w; w.x = pk2(v0[0], v0[1]); w.y = pk2(v0[2], v0[3]); w.z = pk2(v1[0], v1[1]); w.w = pk2(v1[2], v1[3]);
                        *(v4u*)(base + (size_t)(row0 + ai * 128 + m * 16) * ld + col) = w;
                    }
                }
        }
    }
};
struct EpiGates {
    static constexpr bool PERM = true, AFTER_DRAIN = false;
    unsigned char* GATES;
    DI void operator()(const f32x4 (&acc)[2][2][4][2], const Unit& u, int wr, int wc, int fr, int fq) const {
        asm volatile("" : "+v"(fr), "+v"(fq));
        const int row0 = u.pm * 256 + wr * 64 + fr;
#pragma unroll
        for (int bj = 0; bj < 2; ++bj) {
            const int col = u.pn * 256 + bj * 128 + wc * 32 + 8 * fq;
#pragma unroll
            for (int ai = 0; ai < 2; ++ai)
#pragma unroll
                for (int m = 0; m < 4; ++m) {
                    v2u w; w.x = 0u; w.y = 0u;
#pragma unroll
                    for (int i = 0; i < 4; ++i) {
                        const float e0 = __builtin_amdgcn_exp2f(acc[ai][bj][m][0][i] * (-1.4426950408889634f * 0.03125f)), e1 = __builtin_amdgcn_exp2f(acc[ai][bj][m][1][i] * (-1.4426950408889634f * 0.03125f));
                        w.x = __builtin_amdgcn_cvt_pk_u8_f32(__builtin_amdgcn_rcpf(fmaf(e0, 1.0f / 255.0f, 1.0f / 255.0f)), i, w.x);
                        w.y = __builtin_amdgcn_cvt_pk_u8_f32(__builtin_amdgcn_rcpf(fmaf(e1, 1.0f / 255.0f, 1.0f / 255.0f)), i, w.y); }
                    *(v2u*)(GATES + (size_t)(row0 + ai * 128 + m * 16) * NGATE + col) = w;
                }
        }
    }
};
struct EpiLoraZ {
    static constexpr bool PERM = true, AFTER_DRAIN = false;
    bf16* Gout; f16* AW; const float* lbias;
    DI void operator()(const f32x4 (&acc)[2][2][4][2], const Unit& u, int wr, int wc, int fr, int fq) const {
        const int row0 = u.pm * 256 + wr * 64 + fr;
        if (u.pn < 2) {
#pragma unroll
            for (int bj = 0; bj < 2; ++bj)
#pragma unroll
                for (int ai = 0; ai < 2; ++ai)
#pragma unroll
                    for (int m = 0; m < 4; ++m) {
                        const f32x4 v0 = acc[ai][bj][m][0], v1 = acc[ai][bj][m][1];
                        v4u w; w.x = pk2(v0[0], v0[1]); w.y = pk2(v0[2], v0[3]); w.z = pk2(v1[0], v1[1]); w.w = pk2(v1[2], v1[3]);
                        *(v4u*)(Gout + (size_t)(row0 + ai * 128 + m * 16) * 512 + u.pn * 256 + bj * 128 + wc * 32 + 8 * fq) = w;
                    }
        } else {
            const int q = u.pn - 2, grp = q >> 2, half = (q >> 1) & 1, cc = (q & 1) * 256 + wc * 32 + 8 * fq;
            f16* dst = (f16*)((unsigned char*)AW + (size_t)((grp == 0 ? 2 : 0) + half) * OUT_AW);
            const float* bias = lbias + (grp * 2 + half) * 512 + cc;
            const float dsc = -DECAY_SCALE * 1.4426950408889634f;
#pragma unroll
            for (int bj = 0; bj < 2; ++bj) {
                const f32x4 b0 = *(const f32x4*)(bias + bj * 128), b1 = *(const f32x4*)(bias + bj * 128 + 4);
#pragma unroll
                for (int ai = 0; ai < 2; ++ai)
#pragma unroll
                    for (int m = 0; m < 4; ++m) {
                        f32x4 v0 = acc[ai][bj][m][0] + b0, v1 = acc[ai][bj][m][1] + b1;
                        asm volatile("" : "+v"(v0), "+v"(v1));
                        f16x8 h;
#pragma unroll
                        for (int i = 0; i < 4; ++i) {
                            float s0 = sigmoidf_(v0[i]), s1 = sigmoidf_(v1[i]);
                            if (grp == 0) { s0 = __builtin_amdgcn_exp2f(dsc * s0); s1 = __builtin_amdgcn_exp2f(dsc * s1); }
                            h[i] = (f16)s0; h[4 + i] = (f16)s1;
                        }
                        *(f16x8*)(dst + (size_t)(row0 + ai * 128 + m * 16) * 512 + cc + bj * 128) = h;
                    }
            }
        }
    }
};
struct EpiMerge2 {
    static constexpr bool PERM = true, AFTER_DRAIN = false;
    bf16* MG; const unsigned char* GATES;
#define EPI_MEMBAR asm volatile("" ::: "memory")
    DI void mid(f32x4 (&acc)[2][2][4][2], const Unit& u, int wr, int wc, int fr, int fq) const {
        const int row0 = u.pm * 256 + wr * 64 + fr;
        v2u gr[2][2][4], ga[2][2][4];
#pragma unroll
        for (int bj = 0; bj < 2; ++bj) {
            const int col = u.pn * 256 + bj * 128 + wc * 32 + 8 * fq;
#pragma unroll
            for (int ai = 0; ai < 2; ++ai)
#pragma unroll
                for (int m = 0; m < 4; ++m) {
                    const size_t row = (size_t)(row0 + ai * 128 + m * 16);
                    gr[bj][ai][m] = *(const v2u*)(GATES + row * NGATE + col); ga[bj][ai][m] = *(const v2u*)(GATES + row * NGATE + 1024 + col);
                }
        }
        EPI_MEMBAR;
#pragma unroll
        for (int bj = 0; bj < 2; ++bj)
#pragma unroll
            for (int ai = 0; ai < 2; ++ai)
#pragma unroll
                for (int m = 0; m < 4; ++m) {
                    const unsigned grw[2] = {gr[bj][ai][m].x, gr[bj][ai][m].y}, gaw[2] = {ga[bj][ai][m].x, ga[bj][ai][m].y};
#pragma unroll
                    for (int n = 0; n < 2; ++n)
#pragma unroll
                        for (int i = 0; i < 4; ++i) {
                            const float fr_ = (float)((grw[n] >> (8 * i)) & 0xffu), fa_ = fmaxf((float)((gaw[n] >> (8 * i)) & 0xffu), 0.25f);
                            acc[ai][bj][m][n][i] *= fr_ * __builtin_amdgcn_rcpf(fa_);
                        }
                }
    }
    DI void operator()(const f32x4 (&acc)[2][2][4][2], const Unit& u, int wr, int wc, int fr, int fq) const {
        const int row0 = u.pm * 256 + wr * 64 + fr;
        v2u ga[2][2][4];
#pragma unroll
        for (int bj = 0; bj < 2; ++bj) {
            const int col = u.pn * 256 + bj * 128 + wc * 32 + 8 * fq;
#pragma unroll
            for (int ai = 0; ai < 2; ++ai)
#pragma unroll
                for (int m = 0; m < 4; ++m) ga[bj][ai][m] = *(const v2u*)(GATES + (size_t)(row0 + ai * 128 + m * 16) * NGATE + 1024 + col);
        }
        EPI_MEMBAR;
#pragma unroll
        for (int bj = 0; bj < 2; ++bj) {
            const int col = u.pn * 256 + bj * 128 + wc * 32 + 8 * fq;
#pragma unroll
            for (int ai = 0; ai < 2; ++ai)
#pragma unroll
                for (int m = 0; m < 4; ++m) {
                    const size_t row = (size_t)(row0 + ai * 128 + m * 16);
                    const unsigned gaw[2] = {ga[bj][ai][m].x, ga[bj][ai][m].y};
                    float o[8];
#pragma unroll
                    for (int n = 0; n < 2; ++n)
#pragma unroll
                        for (int i = 0; i < 4; ++i) o[4 * n + i] = acc[ai][bj][m][n][i] * (fmaxf((float)((gaw[n] >> (8 * i)) & 0xffu), 0.25f) * (1.0f / 255.0f));
                    v4u w; w.x = pk2(o[0], o[1]); w.y = pk2(o[2], o[3]); w.z = pk2(o[4], o[5]); w.w = pk2(o[6], o[7]);
                    *(v4u*)(MG + row * D + col) = w;
                }
        }
    }
};
struct EpiResid {
    static constexpr bool PERM = true, AFTER_DRAIN = false;
    const float* X; bf16* O;
    DI void operator()(const f32x4 (&acc)[2][2][4][2], const Unit& u, int wr, int wc, int fr, int fq) const {
        const int row0 = u.pm * 256 + wr * 64 + fr, col0 = u.pn * 256 + wc * 32 + 8 * fq;
        f32x4 xa[2][2][2], xb[2][2][2];
#define EPIR_LOAD(xv, b) do { _Pragma("unroll") for (int mm = 0; mm < 2; ++mm) { const size_t off = (size_t)(row0 + ((b) >> 1) * 128 + (((b) & 1) * 2 + mm) * 16) * D + col0; \
            _Pragma("unroll") for (int bj = 0; bj < 2; ++bj) { xv[mm][bj][0] = *(const f32x4*)(X + off + bj * 128); xv[mm][bj][1] = *(const f32x4*)(X + off + bj * 128 + 4); } } } while (0)
#define EPIR_PROC(xv, b) do { _Pragma("unroll") for (int mm = 0; mm < 2; ++mm) { const int ai = (b) >> 1, m = ((b) & 1) * 2 + mm; const size_t off = (size_t)(row0 + ai * 128 + m * 16) * D + col0; \
            _Pragma("unroll") for (int bj = 0; bj < 2; ++bj) { const f32x4 v0 = xv[mm][bj][0] + acc[ai][bj][m][0], v1 = xv[mm][bj][1] + acc[ai][bj][m][1]; \
                v4u w; w.x = pk2(v0[0], v0[1]); w.y = pk2(v0[2], v0[3]); w.z = pk2(v1[0], v1[1]); w.w = pk2(v1[2], v1[3]); *(v4u*)(O + off + bj * 128) = w; } } } while (0)
        EPIR_LOAD(xa, 0); EPIR_LOAD(xb, 1); EPI_MEMBAR;
        EPIR_PROC(xa, 0); EPI_MEMBAR; EPIR_LOAD(xa, 2); EPI_MEMBAR;
        EPIR_PROC(xb, 1); EPI_MEMBAR; EPIR_LOAD(xb, 3); EPI_MEMBAR;
        EPIR_PROC(xa, 2); EPI_MEMBAR;
        EPIR_PROC(xb, 3);
#undef EPIR_LOAD
#undef EPIR_PROC
    }
};
struct EpiSwiglu {
    static constexpr bool PERM = true, AFTER_DRAIN = false;
    unsigned char* HID;
    DI void operator()(const f32x4 (&acc)[2][2][4][2], const Unit& u, int wr, int wc, int fr, int fq) const {
        asm volatile("" : "+v"(fr), "+v"(fq));
        const int row0 = u.pm * 256 + wr * 64 + fr, col = u.pn * 128 + wc * 32 + 8 * fq;
#pragma unroll
        for (int ai = 0; ai < 2; ++ai)
#pragma unroll
            for (int m = 0; m < 4; ++m) {
                float o[8];
#pragma unroll
                for (int n = 0; n < 2; ++n)
#pragma unroll
                    for (int i = 0; i < 4; ++i) {
                        const float G_ = acc[ai][0][m][n][i], U_ = acc[ai][1][m][n][i];
                        const float e_ = __builtin_amdgcn_exp2f(G_ * (-1.4426950408889634f * 0.03125f));
                        o[4 * n + i] = (G_ * U_) * __builtin_amdgcn_rcpf(fmaf(e_, 1024.0f, 1024.0f)); }
                v2u w; w.x = pk4_fp8(o[0], o[1], o[2], o[3]); w.y = pk4_fp8(o[4], o[5], o[6], o[7]);
                *(v2u*)(HID + (size_t)(row0 + ai * 128 + m * 16) * FF + col) = w;
            }
    }
};
struct EpiYs {
    static constexpr bool PERM = true, AFTER_DRAIN = false;
    bf16* YS; const float* VAL;
    DI void operator()(const f32x4 (&acc)[2][2][4][2], const Unit& u, int wr, int wc, int fr, int fq) const {
        asm volatile("" : "+v"(fr), "+v"(fq));
        const int row0 = u.pm * 256 + wr * 64 + fr;
        float svv[2][4];
#pragma unroll
        for (int ai = 0; ai < 2; ++ai)
#pragma unroll
            for (int m = 0; m < 4; ++m) svv[ai][m] = VAL[(size_t)(row0 + ai * 128 + m * 16)];
        EPI_MEMBAR;
#pragma unroll
        for (int ai = 0; ai < 2; ++ai)
#pragma unroll
            for (int m = 0; m < 4; ++m) {
                const size_t row = (size_t)(row0 + ai * 128 + m * 16);
                const float sv = svv[ai][m] * 0.03125f;
#pragma unroll
                for (int bj = 0; bj < 2; ++bj) {
                    const int col = u.pn * 256 + bj * 128 + wc * 32 + 8 * fq;
                    const f32x4 v0 = acc[ai][bj][m][0] * sv, v1 = acc[ai][bj][m][1] * sv;
                    v4u w; w.x = pk2(v0[0], v0[1]); w.y = pk2(v0[2], v0[3]); w.z = pk2(v1[0], v1[1]); w.w = pk2(v1[2], v1[3]);
                    *(v4u*)(YS + row * D + col) = w;
                }
            }
    }
};

DI void phaseP1(const DArgs& a, LAS unsigned char* lds, int own) {
    const int tid = threadIdx.x, lane = tid & 63, wave = __builtin_amdgcn_readfirstlane(tid >> 6);
    unsigned char* ws = a.ws;
    const bf16* UR = (const bf16*)(ws + WS_UR);
    f16* RKV = (f16*)(ws + WS_RKV); bf16* AP = (bf16*)(ws + WS_AP);
    float mp[4][8], mn[4][8], kc[8];
#pragma unroll
    for (int i = 0; i < 4; ++i) { const int cidx = lane + 64 * i; const int col = (cidx < RC / 8 ? cidx : 0) * 8;
#pragma unroll
        for (int j = 0; j < 8; ++j) { mp[i][j] = a.in[I_MUP][col + j]; mn[i][j] = a.in[I_MUN][col + j]; } }
#pragma unroll
    for (int j = 0; j < 8; ++j) kc[j] = a.in[I_KK][lane * 8 + j];
    const bool act3 = lane + 192 < RC / 8;
#define P1_LOADROW(dst, rowp) do { _Pragma("unroll") for (int i_ = 0; i_ < 4; ++i_) { if (i_ < 3 || act3) dst[i_] = *(const v4u*)((rowp) + (lane + 64 * i_) * 8); else dst[i_] = (v4u){0u, 0u, 0u, 0u}; } } while (0)
    { const int r0 = own * 256 + wave * 32;
        const int t0 = r0 & (T - 1);
        const bf16* rp = UR + (size_t)r0 * RC;
        v4u prev[4], cur[4], nxt[4], nn[4];
        if (t0 > 0) P1_LOADROW(prev, rp - RC); else { _Pragma("unroll") for (int i = 0; i < 4; ++i) prev[i] = (v4u){0u, 0u, 0u, 0u}; }
        P1_LOADROW(cur, rp); P1_LOADROW(nxt, rp + RC);
#pragma unroll 1
        for (int r = 0; r < 32; ++r) {
            const int m = r0 + r, t = t0 + r;
            if (t + 2 < T) P1_LOADROW(nn, rp + (size_t)(r + 2) * RC); else { _Pragma("unroll") for (int i = 0; i < 4; ++i) nn[i] = (v4u){0u, 0u, 0u, 0u}; }
#pragma unroll
            for (int i = 0; i < 4; ++i) {
                if (i < 3 || act3) {
                    const int col = (lane + 64 * i) * 8;
                    float o[8];
                    const unsigned ucw[4] = {cur[i].x, cur[i].y, cur[i].z, cur[i].w}, upw[4] = {prev[i].x, prev[i].y, prev[i].z, prev[i].w}, unw[4] = {nxt[i].x, nxt[i].y, nxt[i].z, nxt[i].w};
#pragma unroll
                    for (int j = 0; j < 4; ++j) {
                        const float c0 = bflo(ucw[j]), c1 = bfhi(ucw[j]), p0 = bflo(upw[j]), p1 = bfhi(upw[j]), n0 = bflo(unw[j]), n1 = bfhi(unw[j]);
                        o[2 * j] = c0 + mp[i][2 * j] * (p0 - c0) + mn[i][2 * j] * (n0 - c0);
                        o[2 * j + 1] = c1 + mp[i][2 * j + 1] * (p1 - c1) + mn[i][2 * j + 1] * (n1 - c1);
                    }
                    if (i == 1) {
                        float ssq = 0.f;
#pragma unroll
                        for (int j = 0; j < 8; ++j) { const float e0 = o[j] * kc[j]; ssq += e0 * e0; }
                        ssq += __shfl_xor(ssq, 1); ssq += __shfl_xor(ssq, 2); ssq += __shfl_xor(ssq, 4);
                        if ((lane & 7) == 0) ((float*)(ws + WS_KN))[(size_t)m * 8 + (lane >> 3)] = 1.0f / fmaxf(sqrtf(ssq), 1e-12f);
                    }
                    if (i < 3) {
                        f16x8 h;
#pragma unroll
                        for (int j = 0; j < 8; ++j) h[j] = (f16)o[j];
                        *(f16x8*)(RKV + (size_t)i * ((size_t)M * 512) + (size_t)m * 512 + lane * 8) = h;
                    } else {
                        const int ac = lane * 8;
                        if (ac < 128) {
#pragma unroll
                            for (int j = 0; j < 8; ++j) o[j] = sigmoidf_(o[j]);
                        } else if (ac < 256) {
#pragma unroll
                            for (int j = 0; j < 8; ++j) o[j] = tanhf(o[j]);
                        }
                        v4u w; w.x = pk2(o[0], o[1]); w.y = pk2(o[2], o[3]); w.z = pk2(o[4], o[5]); w.w = pk2(o[6], o[7]);
                        *(v4u*)(AP + (size_t)m * NLK + ac) = w;
                    }
                }
            }
#pragma unroll
            for (int i = 0; i < 4; ++i) { prev[i] = cur[i]; cur[i] = nxt[i]; nxt[i] = nn[i]; }
        }
    }
#undef P1_LOADROW
    {
        const bf16* QKV = (const bf16*)(ws + WS_QKV); bf16* VT = (bf16*)(ws + WS_VT);
        LAS bf16* tile = (LAS bf16*)lds;
        for (int tl = own * 4; tl < own * 4 + 4; ++tl) {
            const int m0 = tl * 64, b = m0 / T, t0 = m0 % T;
            __syncthreads();
#pragma unroll
            for (int i = 0; i < 2; ++i) { const int ch = tid + 512 * i, r = ch >> 4, c8 = (ch & 15) * 8;
                const v4u v = *(const v4u*)(QKV + (size_t)(m0 + r) * NQKV + 640 + c8);
                *(LAS v4u*)(tile + r * 136 + c8) = v; }
            __syncthreads();
#pragma unroll
            for (int i = 0; i < 2; ++i) { const int ch = tid + 512 * i, dcol = ch >> 3, tq = (ch & 7) * 8;
                unsigned short e[8];
#pragma unroll
                for (int j = 0; j < 8; ++j) e[j] = tile[(tq + j) * 136 + dcol];
                v4u w; w.x = e[0] | ((unsigned)e[1] << 16); w.y = e[2] | ((unsigned)e[3] << 16); w.z = e[4] | ((unsigned)e[5] << 16); w.w = e[6] | ((unsigned)e[7] << 16);
                *(v4u*)(VT + ((size_t)(b * 2 + (dcol >> 6)) * 64 + (dcol & 63)) * T + t0 + tq) = w; }
        }
        __syncthreads();
    }
}

DI f32x16 mfma32(const bf16x8 a, const bf16x8 b, const f32x16 c) { return __builtin_amdgcn_mfma_f32_32x32x16_bf16(a, b, c, 0, 0, 0); }
DI bf16x8 packlo(const f32x16& x) { v4u p; p.x = pk2(x[0], x[1]); p.y = pk2(x[2], x[3]); p.z = pk2(x[4], x[5]); p.w = pk2(x[6], x[7]); return __builtin_bit_cast(bf16x8, p); }
DI bf16x8 packhi(const f32x16& x) { v4u p; p.x = pk2(x[8], x[9]); p.y = pk2(x[10], x[11]); p.z = pk2(x[12], x[13]); p.w = pk2(x[14], x[15]); return __builtin_bit_cast(bf16x8, p); }
DI f32x16 zero16() { f32x16 z;
#pragma unroll
    for (int i = 0; i < 16; ++i) z[i] = 0.f;
    return z; }
DI int crow(int reg, int hh) { return (reg & 3) + 8 * (reg >> 2) + 4 * hh; }
DI bf16x8 ldperm(const LAS bf16* rowp, int ks, int hh) {
    const v2u lo = *(const LAS v2u*)(rowp + 16 * ks + 4 * hh), hi = *(const LAS v2u*)(rowp + 16 * ks + 8 + 4 * hh);
    v4u w; w.x = lo.x; w.y = lo.y; w.z = hi.x; w.w = hi.y; return __builtin_bit_cast(bf16x8, w);
}
#define SCAN_DEP(cv, val) asm volatile("" : "+v"(cv) : "v"(val))
constexpr int TJS = 72, JSS = 40;
constexpr int CH_TJ = 0, CH_JS = 18432, CH_JSB = 20480, CH_GL = CH_JS + 2 * CH_JSB, CH_FLAG = CH_GL + 512, CHAIN_LDS = CH_FLAG + 128;
DI int ld_flag(volatile LAS int* p) { return *p; }
constexpr int CH_RAW = CH_FLAG + 128, RAW_SLOT = 5 * 1024 + 256, CH_YT = CH_RAW + 2 * RAW_SLOT, YT_RS = 144, CHAIN_LDS2 = CH_YT + 32 * YT_RS;
DI void scan_dma_block(const DArgs& a, LAS unsigned char* slotp, int blk, int dir, size_t rowbase, int h, unsigned lane_off, unsigned lane_off_kn) {
    unsigned char* ws = a.ws;
    const int p0 = blk * 8, tl = dir ? T - 1 - p0 - 7 : p0;
#pragma unroll
    for (int arr = 0; arr < 5; ++arr) {
        const unsigned char* base = arr < 3 ? (const unsigned char*)(ws + WS_RKV) + (size_t)arr * ((size_t)M * 512 * 2)
                                            : (const unsigned char*)a.out + (size_t)((arr == 3 ? 0 : 2) + dir) * OUT_AW;
        const unsigned char* ub = base + ((rowbase + tl) * 512 + h * 64) * 2;
        __builtin_amdgcn_global_load_lds((const unsigned*)(ub + lane_off), (LAS unsigned*)(slotp + arr * 1024), 16, 0, 0);
    }
    { const unsigned char* ub = (const unsigned char*)(ws + WS_KN) + ((rowbase + tl) * 8 + h) * 4;
      __builtin_amdgcn_global_load_lds((const unsigned*)(ub + lane_off_kn), (LAS unsigned*)(slotp + 5 * 1024), 4, 0, 0); }
}
DI void scan_producer(const DArgs& a, LAS unsigned char* cl, int chain, int lane) {
    const int dir = chain & 1, h = (chain >> 1) & 7, b = chain >> 4;
    const size_t rowbase = (size_t)b * T;
    LAS bf16* Qh = (LAS bf16*)(cl + CH_TJ); LAS bf16* Rh = Qh + 32 * TJS; LAS bf16* Bc = Rh + 32 * TJS; LAS bf16* Kc = Bc + 32 * TJS;
    volatile LAS int* flag = (volatile LAS int*)(cl + CH_FLAG);
    const int chn = h * 64 + lane;
    const float kkc = a.in[I_KK][chn], kac = a.in[I_KA][chn];
    const unsigned lane_off = (unsigned)((dir ? 7 - (lane >> 3) : (lane >> 3)) * 1024 + (lane & 7) * 16);
    const unsigned lane_off_kn = (unsigned)((dir ? 7 - (lane & 7) : (lane & 7)) * 32);
    asm volatile("s_waitcnt vmcnt(0)" ::: "memory");
    scan_dma_block(a, cl + CH_RAW, 0, dir, rowbase, h, lane_off, lane_off_kn);
    scan_dma_block(a, cl + CH_RAW + RAW_SLOT, 1, dir, rowbase, h, lane_off, lane_off_kn);
    for (int chunk = 0; chunk < T / 32; ++chunk) {
        const int buf = chunk & 1;
        LAS bf16* QhT = (LAS bf16*)(cl + CH_JS + buf * CH_JSB); LAS bf16* BcT = QhT + 64 * JSS; LAS bf16* KcT = BcT + 64 * JSS; LAS bf16* VT = KcT + 64 * JSS;
        LAS float* GL = (LAS float*)(cl + CH_GL + buf * 256);
        while (ld_flag(flag + 1) < chunk || ld_flag(flag + 2) < chunk - 1) __builtin_amdgcn_s_sleep(2);
        asm volatile("" ::: "memory");
        float g = 1.f;
#pragma unroll 1
        for (int tb = 0; tb < 4; ++tb) {
            const int blk = chunk * 4 + tb;
            LAS unsigned char* slotp = cl + CH_RAW + (tb & 1) * RAW_SLOT;
            const LAS f16* RAW = (const LAS f16*)slotp; const LAS float* KNL = (const LAS float*)(slotp + 5 * 1024);
            if (blk + 1 < T / 8) asm volatile("s_waitcnt vmcnt(6)" ::: "memory"); else asm volatile("s_waitcnt vmcnt(0)" ::: "memory");
            unsigned qw[4], bw[4], kw[4], vw[4];
            f16 rraw[8], kraw[8], vraw[8], araw[8], wraw[8]; float knv[8];
#pragma unroll
            for (int u = 0; u < 8; ++u) { rraw[u] = RAW[0 * 512 + u * 64 + lane]; kraw[u] = RAW[1 * 512 + u * 64 + lane]; vraw[u] = RAW[2 * 512 + u * 64 + lane]; araw[u] = RAW[3 * 512 + u * 64 + lane]; wraw[u] = RAW[4 * 512 + u * 64 + lane]; }
            { const f32x4 k0_ = *(const LAS f32x4*)KNL, k1_ = *(const LAS f32x4*)(KNL + 4);
#pragma unroll
              for (int u = 0; u < 4; ++u) { knv[u] = k0_[u]; knv[4 + u] = k1_[u]; } }
            LDS_WAIT(); asm volatile("" ::: "memory");
            if (blk + 2 < T / 8) { unsigned lo1 = lane_off, lo2 = lane_off_kn; asm volatile("" : "+v"(lo1), "+v"(lo2));
                scan_dma_block(a, slotp, blk + 2, dir, rowbase, h, lo1, lo2); }
#pragma unroll
            for (int u2 = 0; u2 < 4; ++u2) {
                float qv[2], rv[2], bv[2], kv[2], vv[2];
#pragma unroll
                for (int e = 0; e < 2; ++e) {
                    const int u = 2 * u2 + e;
                    const float r = (float)rraw[u], k = (float)kraw[u], v = (float)vraw[u];
                    const float av = (float)araw[u], w = (float)wraw[u];
                    const float invn = knv[u];
                    const float gprev = g; g *= w; const float ginv = __builtin_amdgcn_rcpf(g);
                    const float kk = k * kkc * invn, kt = k * (1.0f + (av - 1.0f) * kac), bb = av * kk;
                    qv[e] = kk * gprev; rv[e] = r * g; bv[e] = bb * ginv; kv[e] = kt * ginv; vv[e] = v;
                }
                const int tau = 8 * tb + 2 * u2;
                const unsigned q2 = pk2(qv[0], qv[1]), r2 = pk2(rv[0], rv[1]), b2 = pk2(bv[0], bv[1]), k2 = pk2(kv[0], kv[1]);
                Qh[tau * TJS + lane] = (bf16)(q2 & 0xffffu); Qh[(tau + 1) * TJS + lane] = (bf16)(q2 >> 16);
                Rh[tau * TJS + lane] = (bf16)(r2 & 0xffffu); Rh[(tau + 1) * TJS + lane] = (bf16)(r2 >> 16);
                Bc[tau * TJS + lane] = (bf16)(b2 & 0xffffu); Bc[(tau + 1) * TJS + lane] = (bf16)(b2 >> 16);
                Kc[tau * TJS + lane] = (bf16)(k2 & 0xffffu); Kc[(tau + 1) * TJS + lane] = (bf16)(k2 >> 16);
                qw[u2] = q2 ^ 0x80008000u; bw[u2] = b2; kw[u2] = k2; vw[u2] = pk2(vv[0], vv[1]);
            }
            *(LAS v4u*)(QhT + lane * JSS + 8 * tb) = (v4u){qw[0], qw[1], qw[2], qw[3]};
            *(LAS v4u*)(BcT + lane * JSS + 8 * tb) = (v4u){bw[0], bw[1], bw[2], bw[3]};
            *(LAS v4u*)(KcT + lane * JSS + 8 * tb) = (v4u){kw[0], kw[1], kw[2], kw[3]};
            *(LAS v4u*)(VT + lane * JSS + 8 * tb) = (v4u){vw[0], vw[1], vw[2], vw[3]};
        }
        GL[lane] = g;
        LDS_WAIT(); asm volatile("" ::: "memory");
        if (lane == 0) flag[0] = chunk + 1;
        asm volatile("" ::: "memory");
    }
}
template <int DIR> DI void scan_consumer(const DArgs& a, LAS unsigned char* cl, int chain, int lane) {
    unsigned char* ws = a.ws;
    const int h = (chain >> 1) & 7, b = chain >> 4;
    const int c = lane & 31, hh = lane >> 5;
    const size_t rowbase = (size_t)b * T;
    const LAS bf16* Qh = (const LAS bf16*)(cl + CH_TJ); const LAS bf16* Rh = Qh + 32 * TJS; const LAS bf16* Bc = Rh + 32 * TJS; const LAS bf16* Kc = Bc + 32 * TJS;
    volatile LAS int* flag = (volatile LAS int*)(cl + CH_FLAG);
    f16* Y = (f16*)(ws + (DIR ? WS_YB : WS_YF));
    bf16x8 xs[2][2][2];
#pragma unroll
    for (int q = 0; q < 8; ++q) xs[q >> 2][(q >> 1) & 1][q & 1] = (bf16x8){0, 0, 0, 0, 0, 0, 0, 0};
    f32x16 eye;
#pragma unroll
    for (int i = 0; i < 16; ++i) eye[i] = (crow(i, hh) == c) ? 1.f : 0.f;
    LAS unsigned char* YT = cl + CH_YT;
    LAS unsigned char* ytw = YT + c * YT_RS + 8 * hh;
    const LAS unsigned char* ytr = YT + (lane >> 3) * YT_RS + (lane & 7) * 16;
    f16* ybase = Y + (rowbase + (DIR ? T - 1 - (lane >> 3) : (lane >> 3))) * 512 + h * 64 + (lane & 7) * 8;
    for (int chunk = 0; chunk < T / 32; ++chunk) {
        const int buf = chunk & 1;
        const LAS bf16* QhT = (const LAS bf16*)(cl + CH_JS + buf * CH_JSB); const LAS bf16* BcT = QhT + 64 * JSS; const LAS bf16* KcT = BcT + 64 * JSS; const LAS bf16* VT = KcT + 64 * JSS;
        const LAS float* GL = (const LAS float*)(cl + CH_GL + buf * 256);
        while (ld_flag(flag) < chunk + 1) __builtin_amdgcn_s_sleep(1);
        asm volatile("" ::: "memory");
        f32x16 nN = zero16(), nT = zero16(), akT = zero16(), rbT = zero16(), rkT = zero16();
        v2u rhc[2][4];
        {
            bf16x8 fq[4], fb[4], fk[4], fr[4];
#pragma unroll
            for (int ks = 0; ks < 4; ++ks) {
                fq[ks] = *(const LAS bf16x8*)(Qh + c * TJS + 16 * ks + 8 * hh); fb[ks] = *(const LAS bf16x8*)(Bc + c * TJS + 16 * ks + 8 * hh);
                fk[ks] = *(const LAS bf16x8*)(Kc + c * TJS + 16 * ks + 8 * hh); fr[ks] = *(const LAS bf16x8*)(Rh + c * TJS + 16 * ks + 8 * hh);
            }
#pragma unroll
            for (int jb = 0; jb < 2; ++jb)
#pragma unroll
                for (int g4 = 0; g4 < 4; ++g4) rhc[jb][g4] = *(const LAS v2u*)(Rh + c * TJS + 32 * jb + 8 * g4 + 4 * hh);
            v4u yq[4];
            if (chunk > 0) {
#pragma unroll
                for (int j = 0; j < 4; ++j) yq[j] = *(const LAS v4u*)(ytr + 8 * j * YT_RS);
            }
            LDS_WAIT(); asm volatile("" ::: "memory");
            if (lane == 0) flag[1] = chunk + 1;
            asm volatile("" ::: "memory");
            if (chunk > 0) {
                f16* yp = ybase + (DIR ? -((chunk - 1) * 32 * 512) : (chunk - 1) * 32 * 512);
#pragma unroll
                for (int j = 0; j < 4; ++j) *(v4u*)(yp + (DIR ? -(8 * j * 512) : 8 * j * 512)) = yq[j];
            }
#pragma unroll
            for (int ks = 0; ks < 4; ++ks) {
                nN = mfma32(fq[ks], fb[ks], nN); nT = mfma32(fb[ks], fq[ks], nT); akT = mfma32(fk[ks], fq[ks], akT); rbT = mfma32(fb[ks], fr[ks], rbT); rkT = mfma32(fk[ks], fr[ks], rkT);
            }
        }
        __builtin_amdgcn_sched_barrier(0);
        f32x16 TT;
#pragma unroll
        for (int i = 0; i < 16; ++i) { const int rw = crow(i, hh);
            nN[i] = (c < rw) ? nN[i] : 0.f; nT[i] = (rw < c) ? nT[i] : 0.f; akT[i] = (rw < c) ? -akT[i] : 0.f;
            rbT[i] = (rw <= c) ? rbT[i] : 0.f; rkT[i] = (rw <= c) ? rkT[i] : 0.f; TT[i] = eye[i] - nT[i]; }
        bf16x8 pN0 = packlo(nN), pN1 = packhi(nN), pNT0 = packlo(nT), pNT1 = packhi(nT);
        const bf16x8 pAK0 = packlo(akT), pAK1 = packhi(akT), pRB0 = packlo(rbT), pRB1 = packhi(rbT), pRK0 = packlo(rkT), pRK1 = packhi(rkT);
        __builtin_amdgcn_sched_barrier(0);
#pragma unroll
        for (int lvl = 1; lvl <= 4; ++lvl) {
            f32x16 n2 = mfma32(pNT0, pN0, zero16()); n2 = mfma32(pNT1, pN1, n2);
            if (lvl < 4) { f32x16 n2T = mfma32(pN0, pNT0, zero16()); n2T = mfma32(pN1, pNT1, n2T); pNT0 = packlo(n2T); pNT1 = packhi(n2T); }
            pN0 = packlo(n2); pN1 = packhi(n2);
            const bf16x8 pT0 = packlo(TT), pT1 = packhi(TT);
            TT = mfma32(pN0, pT0, TT); TT = mfma32(pN1, pT1, TT);
            __builtin_amdgcn_sched_barrier(0);
        }
        const bf16x8 pTT0 = packlo(TT), pTT1 = packhi(TT);
        __builtin_amdgcn_sched_barrier(0);
        bf16x8 pQ[2][2];
        int cq = c; SCAN_DEP(cq, TT[15]);
        float depq = 0.f;
#pragma unroll
        for (int jt = 0; jt < 2; ++jt) {
            f32x16 acc = mfma32(pTT0, ldperm(QhT + (32 * jt + cq) * JSS, 0, hh), zero16());
            acc = mfma32(pTT1, ldperm(QhT + (32 * jt + cq) * JSS, 1, hh), acc);
            pQ[jt][0] = packlo(acc); pQ[jt][1] = packhi(acc); depq = acc[15];
        }
        __builtin_amdgcn_sched_barrier(0);
        bf16x8 vtp[2][2];
        int cv = c; SCAN_DEP(cv, depq);
#pragma unroll
        for (int it = 0; it < 2; ++it) { vtp[it][0] = ldperm(VT + (32 * it + cv) * JSS, 0, hh); vtp[it][1] = ldperm(VT + (32 * it + cv) * JSS, 1, hh); }
        bf16x8 pU[2][2]; float depu = 0.f;
#pragma unroll
        for (int it = 0; it < 2; ++it) {
            f32x16 w1 = mfma32(pAK0, vtp[it][0], zero16()); w1 = mfma32(pAK1, vtp[it][1], w1);
            const bf16x8 pw0 = packlo(w1), pw1 = packhi(w1);
            f32x16 u0 = mfma32(pTT0, pw0, zero16()); u0 = mfma32(pTT1, pw1, u0);
            pU[it][0] = packlo(u0); pU[it][1] = packhi(u0); depu = u0[15];
            __builtin_amdgcn_sched_barrier(0);
        }
        bf16x8 pR[2][2]; float depr = 0.f;
#pragma unroll
        for (int jb = 0; jb < 2; ++jb) {
            f32x16 rt;
#pragma unroll
            for (int g4 = 0; g4 < 4; ++g4) { const v2u rr = rhc[jb][g4]; rt[4 * g4] = bflo(rr.x); rt[4 * g4 + 1] = bfhi(rr.x); rt[4 * g4 + 2] = bflo(rr.y); rt[4 * g4 + 3] = bfhi(rr.y); }
            rt = mfma32(pQ[jb][0], pRB0, rt); rt = mfma32(pQ[jb][1], pRB1, rt);
            pR[jb][0] = packlo(rt); pR[jb][1] = packhi(rt); depr = rt[15];
            __builtin_amdgcn_sched_barrier(0);
        }
        bf16x8 pP[2][2][2]; float depp = 0.f;
        bf16x8 bcp[2][2];
        {
            int cp = c; SCAN_DEP(cp, depr);
#pragma unroll
            for (int jb = 0; jb < 2; ++jb) { bcp[jb][0] = ldperm(BcT + (32 * jb + cp) * JSS, 0, hh); bcp[jb][1] = ldperm(BcT + (32 * jb + cp) * JSS, 1, hh); }
#pragma unroll
            for (int jb = 0; jb < 2; ++jb)
#pragma unroll
                for (int jpb = 0; jpb < 2; ++jpb) {
                    f32x16 m = mfma32(pQ[jb][0], bcp[jpb][0], jb == jpb ? eye : zero16()); m = mfma32(pQ[jb][1], bcp[jpb][1], m);
                    pP[jb][jpb][0] = packlo(m); pP[jb][jpb][1] = packhi(m); depp = m[15];
                    __builtin_amdgcn_sched_barrier(0);
                }
        }
#pragma unroll
        for (int ib = 0; ib < 2; ++ib) {
            const bf16x8 x0l = xs[ib][0][0], x0h = xs[ib][0][1], x1l = xs[ib][1][0], x1h = xs[ib][1][1];
            {
                f32x16 y = mfma32(pU[ib][0], pRB0, zero16()); y = mfma32(pU[ib][1], pRB1, y);
                y = mfma32(vtp[ib][0], pRK0, y); y = mfma32(vtp[ib][1], pRK1, y);
                y = mfma32(x0l, pR[0][0], y); y = mfma32(x0h, pR[0][1], y);
                y = mfma32(x1l, pR[1][0], y); y = mfma32(x1h, pR[1][1], y);
#pragma unroll
                for (int g4 = 0; g4 < 4; ++g4) { const f16x4 hv = {(f16)y[4 * g4], (f16)y[4 * g4 + 1], (f16)y[4 * g4 + 2], (f16)y[4 * g4 + 3]}; *(LAS f16x4*)(ytw + 64 * ib + 16 * g4) = hv; }
                __builtin_amdgcn_sched_barrier(0);
            }
            f32x16 accn[2];
#pragma unroll
            for (int jpb = 0; jpb < 2; ++jpb) {
                int ch2 = c, hh2 = hh; SCAN_DEP(ch2, depp); SCAN_DEP(hh2, depp);
                f32x16 acc = mfma32(bcp[jpb][0], pU[ib][0], zero16()); acc = mfma32(bcp[jpb][1], pU[ib][1], acc);
                acc = mfma32(ldperm(KcT + (32 * jpb + ch2) * JSS, 0, hh2), vtp[ib][0], acc); acc = mfma32(ldperm(KcT + (32 * jpb + ch2) * JSS, 1, hh2), vtp[ib][1], acc);
                acc = mfma32(pP[0][jpb][0], x0l, acc); acc = mfma32(pP[0][jpb][1], x0h, acc);
                acc = mfma32(pP[1][jpb][0], x1l, acc); acc = mfma32(pP[1][jpb][1], x1h, acc);
#pragma unroll
                for (int g4 = 0; g4 < 4; ++g4) { const f32x4 gl = *(const LAS f32x4*)(GL + 32 * jpb + 8 * g4 + 4 * hh2);
                    acc[4 * g4] *= gl[0]; acc[4 * g4 + 1] *= gl[1]; acc[4 * g4 + 2] *= gl[2]; acc[4 * g4 + 3] *= gl[3]; }
                accn[jpb] = acc; depp = acc[15];
                __builtin_amdgcn_sched_barrier(0);
            }
            xs[ib][0][0] = packlo(accn[0]); xs[ib][0][1] = packhi(accn[0]); xs[ib][1][0] = packlo(accn[1]); xs[ib][1][1] = packhi(accn[1]);
        }
        LDS_WAIT(); asm volatile("" ::: "memory");
        if (lane == 0) flag[2] = chunk + 1;
        asm volatile("" ::: "memory");
    }
    {
        v4u yq[4];
#pragma unroll
        for (int j = 0; j < 4; ++j) yq[j] = *(const LAS v4u*)(ytr + 8 * j * YT_RS);
        LDS_WAIT();
        f16* yp = ybase + (DIR ? -((T / 32 - 1) * 32 * 512) : (T / 32 - 1) * 32 * 512);
#pragma unroll
        for (int j = 0; j < 4; ++j) *(v4u*)(yp + (DIR ? -(8 * j * 512) : 8 * j * 512)) = yq[j];
    }
}
DI void phaseScan(const DArgs& a, LAS unsigned char* lds, int G, int vcu, int wave, int lane) {
    const int slot = wave & 1;
    LAS unsigned char* cl = lds + slot * CHAIN_LDS2;
    for (int chain = vcu * 2 + slot; chain < NB * NH * 2; chain += G * 2) {
        if (wave < 2) { __builtin_amdgcn_s_setprio(3); if (chain & 1) scan_consumer<1>(a, cl, chain, lane); else scan_consumer<0>(a, cl, chain, lane); __builtin_amdgcn_s_setprio(0); }
        else { __builtin_amdgcn_s_setprio(2); scan_producer(a, cl, chain, lane); __builtin_amdgcn_s_setprio(0); }
    }
}

DI void phaseAttn(const DArgs& a, LAS int* qctr, int vcu, int lane) {
    unsigned char* ws = a.ws;
    bf16* QKV = (bf16*)(ws + WS_QKV); const bf16* VT = (const bf16*)(ws + WS_VT);
    const int r32 = lane & 31, hh = lane >> 5;
    const int kr = (r32 & ~12) | ((r32 & 4) << 1) | ((r32 & 8) >> 1);
    for (;;) {
        int idx = 0;
        if (lane == 0) idx = __hip_atomic_fetch_add(qctr, 1, __ATOMIC_RELAXED, __HIP_MEMORY_SCOPE_WORKGROUP);
        idx = __builtin_amdgcn_readfirstlane(idx);
        if (idx >= 32) break;
        const int unit = vcu * 32 + idx;
        const int qt = unit & 63, hp = (unit >> 6) & 3, b = unit >> 8, kvh = hp >> 1, q0 = qt * 32;
        const size_t rowb = (size_t)b * T;
        float slope[2], sink[2], mrun[2], lrun[2];
        bf16x8 qf[2][4];
        f32x16 o0[2], o1[2];
#pragma unroll
        for (int hs = 0; hs < 2; ++hs) {
            const int hq = 2 * hp + hs;
            slope[hs] = exp2f(-(float)(hq + 1)) * 1.4426950408889634f; sink[hs] = a.in[I_SINK][hq] * 1.4426950408889634f; mrun[hs] = sink[hs]; lrun[hs] = 0.f;
            const bf16* qp = QKV + (rowb + q0 + r32) * NQKV + hq * 64 + 8 * hh;
#pragma unroll
            for (int s = 0; s < 4; ++s) qf[hs][s] = *(const bf16x8*)(qp + 16 * s);
#pragma unroll
            for (int i = 0; i < 16; ++i) { o0[hs][i] = 0.f; o1[hs][i] = 0.f; }
        }
        const int tq = q0 + r32;
        for (int kt = 0; kt < 9; ++kt) {
            const int k0 = q0 - 128 + 32 * kt;
            if (k0 < 0 || k0 >= T) continue;
            v4u vv[2][2]; bf16x8 kf[4];
#pragma unroll
            for (int s = 0; s < 2; ++s)
#pragma unroll
                for (int db = 0; db < 2; ++db) vv[s][db] = *(const v4u*)(VT + ((size_t)(b * 2 + kvh) * 64 + 32 * db + r32) * T + k0 + 16 * s + 8 * hh);
            { const bf16* kp = QKV + (rowb + k0 + kr) * NQKV + 512 + kvh * 64 + 8 * hh;
#pragma unroll
              for (int s = 0; s < 4; ++s) kf[s] = *(const bf16x8*)(kp + 16 * s); }
            asm volatile("" ::: "memory");
#pragma unroll
            for (int hs = 0; hs < 2; ++hs) {
                f32x16 st;
#pragma unroll
                for (int i = 0; i < 16; ++i) st[i] = 0.f;
#pragma unroll
                for (int s = 0; s < 4; ++s) st = __builtin_amdgcn_mfma_f32_32x32x16_bf16(kf[s], qf[hs][s], st, 0, 0, 0);
                float tmax = -1e30f;
                if (kt == 0 || kt == 4 || kt == 8) {
#pragma unroll
                    for (int i = 0; i < 16; ++i) { const int sk = k0 + 16 * (i >> 3) + 8 * hh + (i & 7); int dd = sk - tq; dd = dd < 0 ? -dd : dd;
                        const float sc = (dd <= 128) ? st[i] - slope[hs] * (float)dd : -1e30f; st[i] = sc; tmax = fmaxf(tmax, sc); }
                } else {
                    const float sg = kt < 4 ? slope[hs] : -slope[hs];
                    const float b0 = sg * (float)(k0 + 8 * hh - tq);
#pragma unroll
                    for (int i = 0; i < 16; ++i) { const float sc = st[i] + fmaf(sg, (float)(16 * (i >> 3) + (i & 7)), b0); st[i] = sc; tmax = fmaxf(tmax, sc); }
                }
                tmax = fmaxf(tmax, __shfl_xor(tmax, 32));
                const float mnew = fmaxf(mrun[hs], tmax), alpha = __builtin_amdgcn_exp2f(mrun[hs] - mnew);
                mrun[hs] = mnew;
                float ps = 0.f;
#pragma unroll
                for (int i = 0; i < 16; ++i) { const float p = __builtin_amdgcn_exp2f(st[i] - mnew); st[i] = p; ps += p; }
                lrun[hs] = lrun[hs] * alpha + ps;
#pragma unroll
                for (int i = 0; i < 16; ++i) { o0[hs][i] *= alpha; o1[hs][i] *= alpha; }
#pragma unroll
                for (int s = 0; s < 2; ++s) {
                    v4u pw; pw.x = pk2(st[8 * s], st[8 * s + 1]); pw.y = pk2(st[8 * s + 2], st[8 * s + 3]); pw.z = pk2(st[8 * s + 4], st[8 * s + 5]); pw.w = pk2(st[8 * s + 6], st[8 * s + 7]);
                    const bf16x8 pf = __builtin_bit_cast(bf16x8, pw);
                    o0[hs] = __builtin_amdgcn_mfma_f32_32x32x16_bf16(__builtin_bit_cast(bf16x8, vv[s][0]), pf, o0[hs], 0, 0, 0);
                    o1[hs] = __builtin_amdgcn_mfma_f32_32x32x16_bf16(__builtin_bit_cast(bf16x8, vv[s][1]), pf, o1[hs], 0, 0, 0);
                }
            }
        }
#pragma unroll
        for (int hs = 0; hs < 2; ++hs) {
            const int hq = 2 * hp + hs;
            const float ltot = lrun[hs] + __shfl_xor(lrun[hs], 32);
            const float inv = 1.0f / (ltot + __builtin_amdgcn_exp2f(sink[hs] - mrun[hs]));
            bf16* op = QKV + (rowb + q0 + r32) * NQKV + hq * 64;
#pragma unroll
            for (int db = 0; db < 2; ++db) {
                v2u w[4];
#pragma unroll
                for (int g4 = 0; g4 < 4; ++g4) { const f32x16& oo = db ? o1[hs] : o0[hs];
                    w[g4].x = pk2(oo[4 * g4] * inv, oo[4 * g4 + 1] * inv); w[g4].y = pk2(oo[4 * g4 + 2] * inv, oo[4 * g4 + 3] * inv); }
#pragma unroll
                for (int pq = 0; pq < 2; ++pq) {
                    const auto rx = __builtin_amdgcn_permlane32_swap(w[2 * pq].x, w[2 * pq + 1].x, false, false), ry = __builtin_amdgcn_permlane32_swap(w[2 * pq].y, w[2 * pq + 1].y, false, false);
                    v4u ov; ov.x = rx[0]; ov.y = ry[0]; ov.z = rx[1]; ov.w = ry[1];
                    *(v4u*)(op + 32 * db + 16 * pq + 8 * hh) = ov;
                }
            }
        }
    }
}

DI float red8(float v) { v += __shfl_xor(v, 1); v += __shfl_xor(v, 2); v += __shfl_xor(v, 4); return v; }
DI void phasePost(const DArgs& a, int own) {
    const int tid = threadIdx.x, lane = tid & 63, wave = __builtin_amdgcn_readfirstlane(tid >> 6);
    unsigned char* ws = a.ws;
    f16* YF = (f16*)(ws + WS_YF); const f16* YB = (const f16*)(ws + WS_YB);
    const f16* Rr = (const f16*)(ws + WS_RKV); const f16* Kr = Rr + (size_t)M * 512; const f16* Vr = Kr + (size_t)M * 512; const bf16* Gg = (const bf16*)(ws + WS_G);
    const f16* AF = (const f16*)a.out; const f16* AB = (const f16*)((const unsigned char*)a.out + OUT_AW);
    const int ch0 = lane * 8;
    float rkc[8], kac[8], lw[8], lb[8];
#pragma unroll
    for (int j = 0; j < 8; ++j) { rkc[j] = a.in[I_RK][ch0 + j]; kac[j] = a.in[I_KA][ch0 + j]; lw[j] = a.in[I_LNW][ch0 + j]; lb[j] = a.in[I_LNB][ch0 + j]; }
    for (int m = own * 256 + wave; m < own * 256 + 256; m += NWAVES) {
        const size_t o = (size_t)m * 512 + ch0;
        const f16x8 yf = *(const f16x8*)(YF + o), yb = *(const f16x8*)(YB + o), r8 = *(const f16x8*)(Rr + o), k8 = *(const f16x8*)(Kr + o), v8 = *(const f16x8*)(Vr + o);
        const f16x8 af = *(const f16x8*)(AF + o), ab = *(const f16x8*)(AB + o);
        const v4u gq = *(const v4u*)(Gg + o);
        float wkv[8], s1 = 0.f, bs = 0.f;
#pragma unroll
        for (int j = 0; j < 8; ++j) { wkv[j] = (float)yf[j] + (float)yb[j]; s1 += wkv[j];
            bs += (float)r8[j] * (float)k8[j] * rkc[j] * (2.0f + ((float)af[j] + (float)ab[j] - 2.0f) * kac[j]); }
        const float mean = red8(s1) * (1.f / 64.f);
        float s2 = 0.f;
#pragma unroll
        for (int j = 0; j < 8; ++j) { wkv[j] -= mean; s2 += wkv[j] * wkv[j]; }
        const float rstd = rsqrtf(red8(s2) * (1.f / 64.f) + LNX_EPS);
        const float bsum = red8(bs);
        const unsigned gw4[4] = {gq.x, gq.y, gq.z, gq.w};
        float y[8];
#pragma unroll
        for (int j = 0; j < 8; ++j) { const float gj = (j & 1) ? bfhi(gw4[j >> 1]) : bflo(gw4[j >> 1]); y[j] = (wkv[j] * rstd * lw[j] + lb[j] + bsum * (float)v8[j]) * gj; }
        v4u w; w.x = pk2(y[0], y[1]); w.y = pk2(y[2], y[3]); w.z = pk2(y[4], y[5]); w.w = pk2(y[6], y[7]);
        *(v4u*)((bf16*)YF + o) = w;
    }
}

DI void phaseRouter(const DArgs& a, LAS unsigned char* lds, int own) {
    const int tid = threadIdx.x, lane = tid & 63, wave = __builtin_amdgcn_readfirstlane(tid >> 6);
    unsigned char* ws = a.ws;
    LAS float* wf = (LAS float*)lds;
    __syncthreads();
    { const float* g = a.in[I_NFG]; const float* wr = a.in[I_WR];
      for (int idx = tid; idx < 256 * 64; idx += NTHREADS) { const int s_ = (idx >> 8) * 4 + (idx & 3), ln = (idx >> 2) & 63, cc = 32 * (s_ >> 3) + 8 * (ln >> 4) + (s_ & 7); wf[idx] = g[cc] * wr[cc * NE + (ln & 15)]; } }
    __syncthreads();
    const bf16* x1 = (const bf16*)(ws + WS_X1B); float* AFFT = (float*)(ws + WS_AFFT); float* RSTD = (float*)(ws + WS_RSTD);
    const int r = lane & 15, q = lane >> 4;
    v4u bufA[16], bufB[16];
    f32x4 acc; float ss;
#define RT_ROW(t) ((const v4u*)(x1 + (size_t)((own * 16 + wave + 8 * (t)) * 16 + r) * D) + q)
#define RT_LOAD(buf, t, h) do { const v4u* xp_ = RT_ROW(t); _Pragma("unroll") for (int i_ = 0; i_ < 16; ++i_) buf[i_] = xp_[4 * ((h) * 16 + i_)]; } while (0)
#define RT_COMP(buf, h) do { _Pragma("unroll") for (int i_ = 0; i_ < 16; ++i_) { const v4u xw_ = buf[i_]; \
        const float xv_[8] = {bflo(xw_.x), bfhi(xw_.x), bflo(xw_.y), bfhi(xw_.y), bflo(xw_.z), bfhi(xw_.z), bflo(xw_.w), bfhi(xw_.w)}; \
        ss += ((xv_[0] * xv_[0] + xv_[1] * xv_[1]) + (xv_[2] * xv_[2] + xv_[3] * xv_[3])) + ((xv_[4] * xv_[4] + xv_[5] * xv_[5]) + (xv_[6] * xv_[6] + xv_[7] * xv_[7])); \
        const int c8_ = (h) * 16 + i_; const f32x4 w0_ = *(const LAS f32x4*)(wf + ((c8_ * 2) * 64 + lane) * 4), w1_ = *(const LAS f32x4*)(wf + ((c8_ * 2 + 1) * 64 + lane) * 4); \
        _Pragma("unroll") for (int j_ = 0; j_ < 4; ++j_) acc = __builtin_amdgcn_mfma_f32_16x16x4f32(xv_[j_], w0_[j_], acc, 0, 0, 0); \
        _Pragma("unroll") for (int j_ = 0; j_ < 4; ++j_) acc = __builtin_amdgcn_mfma_f32_16x16x4f32(xv_[4 + j_], w1_[j_], acc, 0, 0, 0); } } while (0)
#define RT_FINISH(t) do { const int row0 = (own * 16 + wave + 8 * (t)) * 16; \
        ss += __shfl_xor(ss, 16); ss += __shfl_xor(ss, 32); \
        const float rstd = rsqrtf(ss * (1.f / D) + NORM_EPS);               \
        if (q == 0) RSTD[row0 + r] = rstd; \
        f32x4 p; \
        _Pragma("unroll") for (int i = 0; i < 4; ++i) { \
            const float lg = acc[i] * __shfl(rstd, 4 * q + i);               \
            float mx = lg; \
            mx = fmaxf(mx, __shfl_xor(mx, 1)); mx = fmaxf(mx, __shfl_xor(mx, 2)); mx = fmaxf(mx, __shfl_xor(mx, 4)); mx = fmaxf(mx, __shfl_xor(mx, 8)); \
            const float ex = expf(lg - mx); \
            float sm = ex; sm += __shfl_xor(sm, 1); sm += __shfl_xor(sm, 2); sm += __shfl_xor(sm, 4); sm += __shfl_xor(sm, 8); \
            p[i] = ex / sm; } \
        const int b = row0 / T, t0 = row0 % T; \
        *(f32x4*)(AFFT + ((size_t)b * NE + r) * T + t0 + 4 * q) = p; } while (0)
    RT_LOAD(bufA, 0, 0); RT_LOAD(bufB, 0, 1); EPI_MEMBAR;
    acc = (f32x4){0.f, 0.f, 0.f, 0.f}; ss = 0.f;
    RT_COMP(bufA, 0); EPI_MEMBAR; RT_LOAD(bufA, 1, 0); EPI_MEMBAR;
    RT_COMP(bufB, 1); EPI_MEMBAR; RT_LOAD(bufB, 1, 1); EPI_MEMBAR;
    RT_FINISH(0);
    acc = (f32x4){0.f, 0.f, 0.f, 0.f}; ss = 0.f;
    RT_COMP(bufA, 0); RT_COMP(bufB, 1);
    RT_FINISH(1);
#undef RT_ROW
#undef RT_LOAD
#undef RT_COMP
#undef RT_FINISH
    __syncthreads();
}

DI int block_sum8(LAS int* red, int v, int wave, int lane) {
    if (lane == 0) red[wave] = v;
    __syncthreads();
    int t = 0;
#pragma unroll
    for (int w = 0; w < 8; ++w) t += red[w];
    return t;
}
DI int half_sum4(LAS int* red, int v, int wh, int lane) {
    if (lane == 0) red[wh] = v;
    __syncthreads();
    return red[0] + red[1] + red[2] + red[3];
}
DI void phaseTopk(const DArgs& a, LAS unsigned char* lds, int pr0) {
    const int tid = threadIdx.x, lane = tid & 63, wave = __builtin_amdgcn_readfirstlane(tid >> 6);
    const int half = wave >> 2, wh = wave & 3, th = tid & 255, pr = pr0 + half;
    unsigned char* ws = a.ws;
    const float* AFFT = (const float*)(ws + WS_AFFT); int* SEL = (int*)(ws + WS_SEL); float* VAL = (float*)(ws + WS_VAL);
    const float* RSTD = (const float*)(ws + WS_RSTD); const bf16* x1 = (const bf16*)(ws + WS_X1B); bf16* XG = (bf16*)(ws + WS_XG);
    LAS int* redb = (LAS int*)lds + 4 * half;
    LAS int* lst = (LAS int*)(lds + 256) + 256 * half;
    const unsigned long long lt_mask = (lane == 0) ? 0ull : (~0ull >> (64 - lane));
    const float* g = a.in[I_NFG];
    f32x4 gvv[4];
#pragma unroll
    for (int j = 0; j < 4; ++j) gvv[j] = *(const f32x4*)(g + 4 * lane + 256 * j);
    __syncthreads();
    {
        const int b = pr / NE, e = pr % NE;
        const f32x4 av0 = *(const f32x4*)(AFFT + (size_t)pr * T + 8 * th), av1 = *(const f32x4*)(AFFT + (size_t)pr * T + 8 * th + 4);
        float avf[8]; unsigned key[8];
#pragma unroll
        for (int j = 0; j < 4; ++j) { const float f0 = av0[j], f1 = av1[j]; avf[j] = f0; avf[4 + j] = f1; key[j] = __float_as_uint(f0); key[4 + j] = __float_as_uint(f1); }
        unsigned K = 0u; int it = 0;
        for (int bit = 30; bit >= 0; --bit, ++it) {
            const unsigned cand = K | (1u << bit);
            int cw = 0;
#pragma unroll
            for (int j = 0; j < 8; ++j) cw += __builtin_popcountll(__ballot(key[j] >= cand));
            const int tot = half_sum4(redb + 8 * (it & 1), cw, wh, lane);
            if (tot >= CAP) K = cand;
        }
        int cw = 0;
#pragma unroll
        for (int j = 0; j < 8; ++j) cw += __builtin_popcountll(__ballot(key[j] > K));
        const int ngt = half_sum4(redb + 8 * (it & 1), cw, wh, lane); ++it;
        const int need = CAP - ngt;
        int tw = 0, tl = 0;
#pragma unroll
        for (int j = 0; j < 8; ++j) { const unsigned long long bt = __ballot(key[j] == K); tw += __builtin_popcountll(bt); tl += __builtin_popcountll(bt & lt_mask); }
        if (lane == 0) redb[8 * (it & 1) + wh] = tw;
        __syncthreads();
        int tbase = tl;
#pragma unroll
        for (int w = 0; w < 4; ++w) tbase += (w < wh) ? redb[8 * (it & 1) + w] : 0;
        ++it;
        bool sel[8]; int run = tbase;
#pragma unroll
        for (int j = 0; j < 8; ++j) { const bool tie = key[j] == K; sel[j] = key[j] > K || (tie && run < need); run += tie ? 1 : 0; }
        int sw = 0, sl = 0;
#pragma unroll
        for (int j = 0; j < 8; ++j) { const unsigned long long bs = __ballot(sel[j]); sw += __builtin_popcountll(bs); sl += __builtin_popcountll(bs & lt_mask); }
        if (lane == 0) redb[8 * (it & 1) + wh] = sw;
        __syncthreads();
        int slot = sl;
#pragma unroll
        for (int w = 0; w < 4; ++w) slot += (w < wh) ? redb[8 * (it & 1) + w] : 0;
        ++it;
        const size_t slot0 = (size_t)(e * NB + b) * CAP;
        int so[8];
#pragma unroll
        for (int j = 0; j < 8; ++j) { so[j] = sel[j] ? slot : -1; if (sel[j]) { lst[slot] = 8 * th + j; VAL[slot0 + slot] = avf[j]; ++slot; } }
#pragma unroll
        for (int j = 0; j < 8; ++j) SEL[((size_t)b * T + 8 * th + j) * NE + e] = so[j];
        __syncthreads();
        for (int rr = wh * 8; rr < CAP; rr += 4 * 8) {
            v2u xv[8][4]; float rs[8];
#pragma unroll
            for (int q = 0; q < 8; ++q) { const size_t m = (size_t)b * T + lst[rr + q]; rs[q] = RSTD[m];
                const v2u* xr = (const v2u*)(x1 + m * D) + lane;
#pragma unroll
                for (int j = 0; j < 4; ++j) xv[q][j] = xr[64 * j]; }
#pragma unroll
            for (int q = 0; q < 8; ++q) { unsigned* o = (unsigned*)((unsigned char*)XG + (slot0 + rr + q) * D) + lane;
#pragma unroll
                for (int j = 0; j < 4; ++j) { const f32x4 xf = {bflo(xv[q][j].x), bfhi(xv[q][j].x), bflo(xv[q][j].y), bfhi(xv[q][j].y)}; const f32x4 hv = xf * rs[q] * gvv[j];
                    o[64 * j] = pk4_fp8(hv.x, hv.y, hv.z, hv.w); } }
        }
        __syncthreads();
    }
}

DI void final_accum(f32x4 (&v)[4], const bf16* YS, int myr, unsigned mask, int b, int lane) {
    while (mask) {
        const int e0 = __builtin_ctz(mask); mask &= mask - 1;
        const int has1 = mask != 0; const int e1 = has1 ? __builtin_ctz(mask) : e0; if (has1) mask &= mask - 1;
        const int r0 = __builtin_amdgcn_readlane(myr, e0), r1 = __builtin_amdgcn_readlane(myr, e1);
        const v2u* y0 = (const v2u*)(YS + ((size_t)(e0 * NB + b) * CAP + r0) * D) + lane;
        const v2u* y1 = (const v2u*)(YS + ((size_t)(e1 * NB + b) * CAP + r1) * D) + lane;
        v2u w0[4], w1[4];
#pragma unroll
        for (int j = 0; j < 4; ++j) { w0[j] = y0[64 * j]; w1[j] = y1[64 * j]; }
        const float s1 = has1 ? 1.f : 0.f;
#pragma unroll
        for (int j = 0; j < 4; ++j) {
            v[j].x += bflo(w0[j].x) + s1 * bflo(w1[j].x); v[j].y += bfhi(w0[j].x) + s1 * bfhi(w1[j].x);
            v[j].z += bflo(w0[j].y) + s1 * bflo(w1[j].y); v[j].w += bfhi(w0[j].y) + s1 * bfhi(w1[j].y); }
    }
}
DI void phaseFinal(const DArgs& a, int G, int vcu) {
    const int tid = threadIdx.x, lane = tid & 63, wave = __builtin_amdgcn_readfirstlane(tid >> 6);
    const int gw = vcu * NWAVES + wave, NGW = G * NWAVES;
    unsigned char* ws = a.ws;
    const int* SEL = (const int*)(ws + WS_SEL); const bf16* YS = (const bf16*)(ws + WS_YS);
    float* out = a.out; const float* g = a.in[I_NFINAL]; const bf16* X1B = (const bf16*)(ws + WS_X1B);
    f32x4 gv[4];
#pragma unroll
    for (int j = 0; j < 4; ++j) gv[j] = *(const f32x4*)(g + 4 * lane + 256 * j);
    for (int m0 = gw * 2; m0 < M; m0 += NGW * 2) {
        f32x4* xa = (f32x4*)(out + (size_t)m0 * D) + lane; f32x4* xb = xa + D / 4;
        const v2u* ia = (const v2u*)(X1B + (size_t)m0 * D) + lane; const v2u* ib = ia + D / 4;
        const int ra = SEL[(size_t)m0 * NE + (lane & 15)], rb = SEL[(size_t)(m0 + 1) * NE + (lane & 15)];
        f32x4 va[4], vb[4];
#pragma unroll
        for (int j = 0; j < 4; ++j) { const v2u wa = ia[64 * j], wb = ib[64 * j];
            va[j] = (f32x4){bflo(wa.x), bfhi(wa.x), bflo(wa.y), bfhi(wa.y)}; vb[j] = (f32x4){bflo(wb.x), bfhi(wb.x), bflo(wb.y), bfhi(wb.y)}; }
        const int b = m0 / T;
        const unsigned ma = (unsigned)(__ballot(ra >= 0) & 0xffffull), mb = (unsigned)(__ballot(rb >= 0) & 0xffffull);
        final_accum(va, YS, ra, ma, b, lane);
        final_accum(vb, YS, rb, mb, b, lane);
        float sa = 0.f, sb = 0.f;
#pragma unroll
        for (int j = 0; j < 4; ++j) { sa += (va[j].x * va[j].x + va[j].y * va[j].y) + (va[j].z * va[j].z + va[j].w * va[j].w); sb += (vb[j].x * vb[j].x + vb[j].y * vb[j].y) + (vb[j].z * vb[j].z + vb[j].w * vb[j].w); }
        const float rsa = rsqrtf(wave_sum(sa) * (1.f / D) + NORM_EPS), rsb = rsqrtf(wave_sum(sb) * (1.f / D) + NORM_EPS);
#pragma unroll
        for (int j = 0; j < 4; ++j) { xa[64 * j] = va[j] * rsa * gv[j]; xb[64 * j] = vb[j] * rsb * gv[j]; }
    }
}

typedef __attribute__((address_space(1))) unsigned gu32;
#define XB_TMO      128
#define XB_XCNT(j)  (256  + 64 * (j))
#define XB_XSUB(j)  (1280 + 64 * (j))
#define XB_XGEN(j)  (2304 + 64 * (j))
#define XB_TOP      3328
#define XB_TOPGEN   3392
#define XCD_BAR_WORDS 3456
#define XB_GMASK(j) (3456 + 64 * (j))
#define XB_LSUB(j)  (3968 + 64 * (j))
#define XB_LGEN(j)  (4480 + 64 * (j))
#define XB_SPIN_CAP (1u << 18)

__device__ __forceinline__ unsigned xb_ld(unsigned* p)              { return __hip_atomic_load(p, __ATOMIC_RELAXED, __HIP_MEMORY_SCOPE_AGENT); }
__device__ __forceinline__ unsigned xb_add(unsigned* p, unsigned v) { return __hip_atomic_fetch_add(p, v, __ATOMIC_RELAXED, __HIP_MEMORY_SCOPE_AGENT); }
__device__ __forceinline__ unsigned xb_xcc_id() { return (unsigned)__builtin_amdgcn_s_getreg((3 << 11) | 20) & 0xFu; }
#define XB_SPIN(cond, bar) do { unsigned _sp = 0; while (cond) { __builtin_amdgcn_s_sleep(1); \
    if ((++_sp & 255u) == 0u) { if (xb_ld(&(bar)[XB_TMO])) break; if (_sp > XB_SPIN_CAP) { atomicAdd(&(bar)[XB_TMO], 1u); break; } } } } while (0)

struct XcdBarrier {
    unsigned* bar; unsigned x;
    volatile LAS unsigned* st;
};

__device__ __forceinline__ XcdBarrier xcd_barrier_post(unsigned* bar, volatile LAS unsigned* st) {
    XcdBarrier b; b.bar = bar; b.x = xb_xcc_id(); b.st = st;
    if (threadIdx.x == 0) { (void)xb_add(&bar[XB_XCNT(b.x)], 1u); (void)__hip_atomic_fetch_or(&bar[XB_GMASK(blockIdx.x & 7u)], 1u << b.x, __ATOMIC_RELAXED, __HIP_MEMORY_SCOPE_AGENT); }
    return b;
}
__device__ __forceinline__ void xcd_barrier_complete(unsigned* bar, unsigned x, unsigned& nloc, unsigned& nx) {
    const unsigned G = gridDim.x * gridDim.y * gridDim.z;
    unsigned sum, cnt, mine, sp = 0u;
    for (;;) {
        sum = 0u; cnt = 0u; mine = 0u;
#pragma unroll
        for (unsigned j = 0; j < 16; ++j) { const unsigned c = xb_ld(&bar[XB_XCNT(j)]); sum += c; cnt += (c > 0u) ? 1u : 0u; mine = (j == x) ? c : mine; }
        if (sum == G) break;
        __builtin_amdgcn_s_sleep(1);
        if ((++sp & 255u) == 0u) { if (xb_ld(&bar[XB_TMO])) break; if (sp > XB_SPIN_CAP) { atomicAdd(&bar[XB_TMO], 1u); break; } }
    }
    nloc = mine > 0u ? mine : 1u; nx = cnt > 0u ? cnt : 1u;
}

__device__ __forceinline__ void xcd_barrier(const XcdBarrier& b) {
    asm volatile("s_waitcnt vmcnt(0)" ::: "memory");
    __syncthreads();
    if (threadIdx.x == 0) {
        unsigned* bar = b.bar;
        __builtin_amdgcn_s_waitcnt(0);
        unsigned nloc = b.st[0], nx = b.st[1];
        if (nloc == 0u) { xcd_barrier_complete(bar, b.x, nloc, nx); b.st[0] = nloc; b.st[1] = nx; }
        const unsigned old = xb_add(&bar[XB_XSUB(b.x)], 1u);
        const unsigned gen = old / nloc;
        if (old + 1u == (gen + 1u) * nloc) {
            __builtin_amdgcn_fence(__ATOMIC_RELEASE, "agent");
            asm volatile("s_waitcnt vmcnt(0)" ::: "memory");
            const unsigned og = xb_add(&bar[XB_TOP], 1u);
            const unsigned tg = og / nx;
            if (og + 1u == (tg + 1u) * nx) xb_add(&bar[XB_TOPGEN], 1u);
            else XB_SPIN(xb_ld(&bar[XB_TOPGEN]) == tg, bar);
            __builtin_amdgcn_fence(__ATOMIC_ACQUIRE, "agent");
            xb_add(&bar[XB_XGEN(b.x)], 1u);
            asm volatile("s_waitcnt vmcnt(0)" ::: "memory");
        } else {
            XB_SPIN(xb_ld(&bar[XB_XGEN(b.x)]) == gen, bar);
            __builtin_amdgcn_fence(__ATOMIC_ACQUIRE, "agent");
            asm volatile("s_waitcnt vmcnt(0)" ::: "memory");
        }
    }
    __syncthreads();
}


__device__ __forceinline__ void group_barrier(const XcdBarrier& b) {
    asm volatile("s_waitcnt vmcnt(0)" ::: "memory");
    __syncthreads();
    if (threadIdx.x == 0) {
        unsigned* bar = b.bar;
        __builtin_amdgcn_s_waitcnt(0);
        const unsigned j = blockIdx.x & 7u, nloc = gridDim.x >> 3;
        unsigned mode = b.st[2];
        if (mode == 0u) { const unsigned mk = xb_ld(&bar[XB_GMASK(j)]); mode = (__builtin_popcount(mk) == 1) ? 1u : 2u; b.st[2] = mode; }
        if (mode == 2u) { __builtin_amdgcn_fence(__ATOMIC_RELEASE, "agent"); asm volatile("s_waitcnt vmcnt(0)" ::: "memory"); }
        const unsigned old = xb_add(&bar[XB_LSUB(j)], 1u);
        const unsigned gen = old / nloc;
        if (old + 1u == (gen + 1u) * nloc) xb_add(&bar[XB_LGEN(j)], 1u);
        else XB_SPIN(xb_ld(&bar[XB_LGEN(j)]) == gen, bar);
        __builtin_amdgcn_fence(__ATOMIC_ACQUIRE, "agent");
        asm volatile("s_waitcnt vmcnt(0)" ::: "memory");
    }
    __syncthreads();
}
DI void stagger(int ticks) {
    if (ticks > 0) { const unsigned long long t0 = __builtin_amdgcn_s_memrealtime();
        for (int i = 0; i < 256 && (long long)(__builtin_amdgcn_s_memrealtime() - t0) < (long long)ticks; ++i) __builtin_amdgcn_s_sleep(8); }
}
#ifndef STAG_TICKS
#define STAG_TICKS 0
#endif
#ifndef LOCAL_SEAMS
#define LOCAL_SEAMS 0x1C0
#endif

constexpr int NPHASE = 13;
#ifndef MK_ONE_LAUNCH
#define MK_ONE_LAUNCH 1
#endif
__global__ void __launch_bounds__(NTHREADS, 2) fwd_kernel(Args args) {
    extern __shared__ __attribute__((aligned(16))) unsigned char lds_raw[];
    LAS unsigned char* lds = (LAS unsigned char*)lds_raw;
    const int G = gridDim.x, bx = blockIdx.x;
    const int vcu = (G % 8 == 0) ? (bx % 8) * (G / 8) + bx / 8 : bx;
    const int lo = args.ph_lo, hi = args.ph_hi;
    unsigned char* ws = args.ws;
    DArgs dargs; dargs.out = args.out; dargs.ws = args.ws;
#if MK_ONE_LAUNCH
    volatile LAS unsigned* MISC = (volatile LAS unsigned*)(lds + LDS_BYTES - 128);
    if (threadIdx.x < 32) MISC[threadIdx.x] = 0u;
    __syncthreads();
    const XcdBarrier xbar = xcd_barrier_post((unsigned*)(ws + WS_CTL) + 64, MISC);
#endif
#ifndef REPEAT_MASK
#define REPEAT_MASK 0
#endif
#define IN(k) (lo <= (k) && (k) < hi)
#define REPS(k) for (int rep_ = 0; rep_ < (((REPEAT_MASK >> (k)) & 1) ? 2 : 1); ++rep_)
#if MK_ONE_LAUNCH
#define SEAM(k) do { if (IN(k) && IN((k) + 1)) { if ((k) == 0) cg::this_grid().sync(); else if ((LOCAL_SEAMS >> (k)) & 1) group_barrier(xbar); else xcd_barrier(xbar); } } while (0)
#else
#define SEAM(k) do { } while (0)
#endif
    if (IN(0)) REPS(0) { phase0(dargs, lds, G, vcu); }
    SEAM(0);
    if (IN(1)) REPS(1) {
        { pg8::Gemm g{(const bf16*)args.out, (const bf16*)(ws + WS_WIN), M, 2816, D, D, 1 << 30, 0, nullptr, 0, nullptr, 0, 1 << 30, 0, 0};
          pg8::StaticOrder S; S.init(M, 2816, G, bx);
          EpiA E{(bf16*)(ws + WS_UR), (bf16*)(ws + WS_QKV), (bf16*)(ws + WS_GATES)};
          pg8::gemm_phase<EpiA, pg8::StaticOrder, PG8_ALIGN, PG8_SP2>(lds, g, S, E); }
        { pg8::Gemm g{(const bf16*)((const unsigned char*)args.out + 128 * MiB), (const bf16*)(ws + WS_WG8), M, NGATE, D / 2, D / 2, 1 << 30, 0, nullptr, 0, nullptr, 0, 1 << 30, 0, 0};
          pg8::StaticOrder S; S.init(M, NGATE, G, bx);
          EpiGates E{(unsigned char*)(ws + WS_GATES)};
          pg8::gemm_phase<EpiGates, pg8::StaticOrder, PG8_ALIGN, PG8_SP2, false, false, true>(lds, g, S, E); }
    }
    SEAM(1);
#define BSEAM() do { asm volatile("s_waitcnt vmcnt(0)" ::: "memory"); __syncthreads(); } while (0)
    if (IN(2)) {
        { const int own = vcu;
            phaseP1(dargs, lds, own);
            BSEAM();
            int kl = 128; asm volatile("" : "+s"(kl));
            pg8::Gemm g{(const bf16*)(ws + WS_AP), (const bf16*)(ws + WS_WLORA), M, NLN, kl, NLK, 1 << 30, 0, nullptr, 0, nullptr, 0, 1 << 30, 0, 0};
            pg8::OwnRowLoraOrder S; S.pm0 = own; S.pm1 = own; S.npm = 1; S.nN = NLN / 256;
            EpiLoraZ E{(bf16*)(ws + WS_G), (f16*)args.out, (const float*)(ws + WS_LBIAS)};
            pg8::gemm_phase<EpiLoraZ, pg8::OwnRowLoraOrder, PG8_ALIGN, PG8_SP2>(lds, g, S, E);
        }
    }
    SEAM(3);
    if (IN(4)) {
        const int lane4 = threadIdx.x & 63, wave4 = __builtin_amdgcn_readfirstlane(threadIdx.x >> 6);
        if (threadIdx.x < 64) { ((LAS int*)(lds + CH_FLAG))[threadIdx.x & 31] = 0; ((LAS int*)(lds + CHAIN_LDS2 + CH_FLAG))[threadIdx.x & 31] = 0; }
        __syncthreads();
        LAS int* qctr = (LAS int*)(lds + CH_FLAG) + 16;
        if (wave4 < 4) phaseScan(dargs, lds, G, vcu, wave4, lane4);
        phaseAttn(dargs, qctr, vcu, lane4);
    }
    SEAM(4);
    if (IN(5)) { phasePost(dargs, vcu); }
    SEAM(5);
    if (IN(6)) REPS(6) {   stagger((bx & 4) ? STAG_TICKS : 0);
        pg8::Gemm g{(const bf16*)(ws + WS_YF), (const bf16*)(ws + WS_WPR), M, D, D, 512, 1 << 30, 0, nullptr, 0, (const bf16*)(ws + WS_QKV), NQKV, 8, 0, 0};
        pg8::StaticOrder S; S.init(M, D, G, bx);
        EpiMerge2 E{(bf16*)(ws + WS_MERGED), (const unsigned char*)(ws + WS_GATES)};
        pg8::gemm_phase<EpiMerge2, pg8::StaticOrder, PG8_ALIGN, PG8_SP2, false, true>(lds, g, S, E);
    }
    SEAM(6);
    if (IN(7)) REPS(7) {
        pg8::Gemm g{(const bf16*)(ws + WS_MERGED), (const bf16*)(ws + WS_WOUT), M, D, D, D, 1 << 30, 0, nullptr, 0, nullptr, 0, 1 << 30, 0, 0};
        pg8::StaticOrder S; S.init(M, D, G, bx);
        EpiResid E{dargs.in[I_X], (bf16*)(ws + WS_X1B)};
        pg8::gemm_phase<EpiResid, pg8::StaticOrder, PG8_ALIGN, PG8_SP2>(lds, g, S, E);
    }
    SEAM(7);
    if (IN(8)) { phaseRouter(dargs, lds, vcu); }
    SEAM(8);
    if (IN(9)) { phaseTopk(dargs, lds, 2 * vcu);   }
    SEAM(9);
    if (IN(10)) REPS(10) {
        pg8::Gemm g{(const bf16*)(ws + WS_XG), (const bf16*)(ws + WS_WGU), MS, 2048, D / 2, D / 2, NB, (size_t)2048 * D, nullptr, 0, nullptr, 0, 1 << 30, 0x7f7f7f7f, 0x7a7a7a7a};
        pg8::StaticOrder S; S.init(MS, 2048, G, bx);
        EpiSwiglu E{(unsigned char*)(ws + WS_HID)};
        pg8::gemm_phase<EpiSwiglu, pg8::StaticOrder, PG8_ALIGN, PG8_SP2, false, false, true>(lds, g, S, E);
    }
    SEAM(10);
    if (IN(11)) REPS(11) {
        pg8::Gemm g{(const bf16*)(ws + WS_HID), (const bf16*)(ws + WS_WD), MS, D, FF / 2, FF / 2, NB, (size_t)D * FF, nullptr, 0, nullptr, 0, 1 << 30, 0x7f7f7f7f, 0x7a7a7a7a};
        pg8::StaticOrder S; S.init(MS, D, G, bx);
        EpiYs E{(bf16*)(ws + WS_YS), (const float*)(ws + WS_VAL)};
        pg8::gemm_phase<EpiYs, pg8::StaticOrder, PG8_ALIGN, PG8_SP2, false, false, true>(lds, g, S, E);
    }
    SEAM(11);
    if (IN(12)) { phaseFinal(dargs, G, vcu); }
#undef IN
#undef SEAM
}

extern "C" void kernel_launch(void* const* d_in, const int* in_sizes, int n_in, void* d_out, int out_size, void* d_ws, size_t ws_size, hipStream_t stream) {
    static int grid = 0;
    if (grid == 0) {
        if (n_in != 29 || out_size != M * D || ws_size < WS_END) { fprintf(stderr, "kernel_launch: unexpected shapes (n_in %d out %d ws %zu)\n", n_in, out_size, ws_size); grid = -1; return; }
        int dev = 0, cus = 0, per_cu = 0;
        hipGetDevice(&dev);
        hipDeviceGetAttribute(&cus, hipDeviceAttributeMultiprocessorCount, dev);
        hipFuncSetAttribute((const void*)fwd_kernel, hipFuncAttributeMaxDynamicSharedMemorySize, LDS_BYTES);
        hipOccupancyMaxActiveBlocksPerMultiprocessor(&per_cu, (const void*)fwd_kernel, NTHREADS, LDS_BYTES);
        (void)hipGetLastError();
        if (per_cu < 1) { fprintf(stderr, "kernel_launch: occupancy query says %d blocks per CU\n", per_cu); per_cu = 1; }
        grid = cus;
        if (grid != M / 256) { fprintf(stderr, "kernel_launch: this build needs exactly %d workgroups (one per CU of a 256-CU device), got %d\n", M / 256, grid); grid = -1; return; }
    }
    if (grid < 0) return;
    Args a{};
    for (int i = 0; i < 29; ++i) a.in[i] = (const float*)d_in[i];
    a.out = (float*)d_out; a.ws = (unsigned char*)d_ws;
#if MK_ONE_LAUNCH
    if (hipMemsetAsync((char*)d_ws + WS_CTL, 0, 32768, stream) != hipSuccess) { fprintf(stderr, "kernel_launch: memset of the barrier words failed\n"); return; }
    a.ph_lo = 0; a.ph_hi = NPHASE;
    void* kargs[] = {&a};
    hipError_t e = hipLaunchCooperativeKernel((const void*)fwd_kernel, dim3(grid), dim3(NTHREADS), kargs, LDS_BYTES, stream);
    if (e != hipSuccess) fprintf(stderr, "cooperative launch failed: %s (grid %d)\n", hipGetErrorString(e), grid);
#else
    for (int p = 0; p < NPHASE; ++p) {
        a.ph_lo = p; a.ph_hi = p + 1;
        hipLaunchKernelGGL(fwd_kernel, dim3(grid), dim3(NTHREADS), LDS_BYTES, stream, a);
    }
#endif
}
```
